# Optimizing an MI355X kernel written in HIP

```python
import jax, jax.numpy as jnp
from jax import lax
import numpy as np

D_MODEL = 1024
BATCH = 16
SEQ = 2048
DEPTH = 2

CHUNK = 64
Q_BLOCK = 128
EPS = 1e-6
NEG = -1e30

A_HEADS = 6
A_NOPE = 64
A_ROPE = 32
A_V = 64
A_Q_RANK = 384
A_KV_RANK = 256
A_WIDTH = A_HEADS * A_V
ROPE_THETA = 10000.0

B_HEADS = 5
B_HD = 64
B_WIDTH = B_HEADS * B_HD
B_LEFT_CHUNKS = 8
B_BAND = (B_LEFT_CHUNKS + 1) * CHUNK
REL_CLIP = 128

C_HEADS = 5
C_HD = 64
C_WIDTH = C_HEADS * C_HD
FORGET_BIAS_INIT = 2.0

D_MIX = A_WIDTH + B_WIDTH + C_WIDTH

IN_SIZES = (A_Q_RANK, A_KV_RANK, A_ROPE, A_WIDTH,
            B_WIDTH, B_WIDTH, B_WIDTH, B_WIDTH,
            C_WIDTH, C_WIDTH, C_WIDTH, C_HEADS, C_WIDTH)
N_IN = (A_Q_RANK + A_KV_RANK + A_ROPE + A_WIDTH + 4 * B_WIDTH + 4 * C_WIDTH + C_HEADS)

kernel_name = "hybrid_mla_chunkband_fox_encoder"


def rmsnorm(x, g):
    xf = x.astype(jnp.float32)
    y = xf * lax.rsqrt(jnp.mean(xf * xf, axis=-1, keepdims=True) + EPS)
    return (y * g.astype(jnp.float32)).astype(x.dtype)


def split_cols(z, sizes):
    idx, o = [], 0
    for s in sizes[:-1]:
        o += s
        idx.append(o)
    return jnp.split(z, idx, axis=-1)


def rope_tables(positions):
    inv = ROPE_THETA ** (-jnp.arange(0, A_ROPE, 2, dtype=jnp.float32) / A_ROPE)
    ang = positions.astype(jnp.float32)[..., None] * inv
    return jnp.cos(ang), jnp.sin(ang)


def apply_rope(x, cos, sin):
    x1, x2 = jnp.split(x.astype(jnp.float32), 2, axis=-1)
    out = jnp.concatenate([x1 * cos - x2 * sin, x1 * sin + x2 * cos], axis=-1)
    return out.astype(x.dtype)


def attend(s, mask, v):
    p = jax.nn.softmax(jnp.where(mask, s, NEG), axis=-1)
    return jnp.einsum('bhqk,bhkd->bhqd', p.astype(v.dtype), v)


def mla_mixer(c_q, c_kv, k_pe, q_norm_g, w_uq, kv_norm_g, w_ukv, cos, sin):
    Bn, S, _ = c_q.shape
    q = (rmsnorm(c_q, q_norm_g) @ w_uq).reshape(Bn, S, A_HEADS, A_NOPE + A_ROPE)
    q_nope, q_pe = q[..., :A_NOPE], q[..., A_NOPE:]
    q_pe = apply_rope(q_pe, cos[:, :, None, :], sin[:, :, None, :])
    kv = (rmsnorm(c_kv, kv_norm_g) @ w_ukv).reshape(Bn, S, A_HEADS, A_NOPE + A_V)
    k_nope, v = kv[..., :A_NOPE], kv[..., A_NOPE:]
    k_pe = apply_rope(k_pe, cos, sin)
    k_pe = jnp.broadcast_to(k_pe[:, :, None, :], (Bn, S, A_HEADS, A_ROPE))
    q = jnp.concatenate([q_nope, q_pe], axis=-1).transpose(0, 2, 1, 3)
    k = jnp.concatenate([k_nope, k_pe], axis=-1).transpose(0, 2, 1, 3)
    v = v.transpose(0, 2, 1, 3)
    scale = (A_NOPE + A_ROPE) ** -0.5
    outs = []
    for i in range(S // Q_BLOCK):
        q0 = i * Q_BLOCK
        kend = q0 + Q_BLOCK
        s = jnp.einsum('bhqd,bhkd->bhqk', q[:, :, q0:kend], k[:, :, :kend],
                       preferred_element_type=jnp.float32) * scale
        q_chunk = (q0 + jnp.arange(Q_BLOCK)) // CHUNK
        k_chunk = jnp.arange(kend) // CHUNK
        mask = k_chunk[None, :] <= q_chunk[:, None]
        outs.append(attend(s, mask, v[:, :, :kend]))
    o = jnp.concatenate(outs, axis=2)
    return o.transpose(0, 2, 1, 3).reshape(Bn, S, A_WIDTH)


def chunk_band_mixer(q, k, v, rel_bias):
    Bn, S, _ = q.shape
    NC = S // CHUNK
    qc = q.reshape(Bn, NC, CHUNK, B_HEADS, B_HD)

    def band(t):
        t = t.reshape(Bn, S, B_HEADS, B_HD)
        t = jnp.pad(t, ((0, 0), (B_LEFT_CHUNKS * CHUNK, 0), (0, 0), (0, 0)))
        t = t.reshape(Bn, NC + B_LEFT_CHUNKS, CHUNK, B_HEADS, B_HD)
        t = jnp.stack([t[:, j:j + NC] for j in range(B_LEFT_CHUNKS + 1)], axis=2)
        return t.reshape(Bn, NC, B_BAND, B_HEADS, B_HD)

    kb, vb = band(k), band(v)
    s = jnp.einsum('bnqhd,bnkhd->bnhqk', qc, kb,
                   preferred_element_type=jnp.float32) * (B_HD ** -0.5)
    rel = (B_LEFT_CHUNKS * CHUNK + jnp.arange(CHUNK))[:, None] - jnp.arange(B_BAND)[None, :]
    idx = jnp.clip(rel, -REL_CLIP, REL_CLIP) + REL_CLIP
    s = s + rel_bias[:, idx].astype(jnp.float32)
    k_chunk = jnp.arange(NC)[:, None] - B_LEFT_CHUNKS + (jnp.arange(B_BAND) // CHUNK)[None, :]
    mask = (k_chunk >= 0)[None, :, None, None, :]
    p = jax.nn.softmax(jnp.where(mask, s, NEG), axis=-1)
    o = jnp.einsum('bnhqk,bnkhd->bnqhd', p.astype(vb.dtype), vb)
    return o.reshape(Bn, S, B_WIDTH)


def forgetting_mixer(q, k, v, f_logit, f_bias):
    Bn, S, _ = q.shape
    q = q.reshape(Bn, S, C_HEADS, C_HD).transpose(0, 2, 1, 3)
    k = k.reshape(Bn, S, C_HEADS, C_HD).transpose(0, 2, 1, 3)
    v = v.reshape(Bn, S, C_HEADS, C_HD).transpose(0, 2, 1, 3)
    log_f = jax.nn.log_sigmoid(f_logit.astype(jnp.float32) + f_bias.astype(jnp.float32))
    F = jnp.cumsum(log_f, axis=1).transpose(0, 2, 1)
    scale = C_HD ** -0.5
    outs = []
    for i in range(S // Q_BLOCK):
        q0 = i * Q_BLOCK
        kend = q0 + Q_BLOCK
        s = jnp.einsum('bhqd,bhkd->bhqk', q[:, :, q0:kend], k[:, :, :kend],
                       preferred_element_type=jnp.float32) * scale
        s = s + F[:, :, q0:kend, None] - F[:, :, None, :kend]
        mask = jnp.arange(kend)[None, :] <= (q0 + jnp.arange(Q_BLOCK))[:, None]
        outs.append(attend(s, mask, v[:, :, :kend]))
    o = jnp.concatenate(outs, axis=2)
    return o.transpose(0, 2, 1, 3).reshape(Bn, S, C_WIDTH)


def hybrid_layer(x, c_act, cos, sin, w_ada, b_ada, norm_g, w_in, a_q_norm_g, a_w_uq,
                 a_kv_norm_g, a_w_ukv, b_rel_bias, c_forget_b, w_out):
    mod = c_act @ w_ada + b_ada
    shift, scale, gate = jnp.split(mod, 3, axis=-1)
    h = rmsnorm(x, norm_g) * (1.0 + scale[:, None, :]) + shift[:, None, :]
    z = h @ w_in
    (a_cq, a_ckv, a_kpe, a_gate,
     b_q, b_k, b_v, b_gate,
     c_q, c_k, c_v, c_f, c_gate) = split_cols(z, IN_SIZES)
    a_out = mla_mixer(a_cq, a_ckv, a_kpe, a_q_norm_g, a_w_uq, a_kv_norm_g, a_w_ukv, cos, sin)
    b_out = chunk_band_mixer(b_q, b_k, b_v, b_rel_bias)
    c_out = forgetting_mixer(c_q, c_k, c_v, c_f, c_forget_b)
    y = jnp.concatenate([a_out * jax.nn.silu(a_gate),
                         b_out * jax.nn.silu(b_gate),
                         c_out * jax.nn.silu(c_gate)], axis=-1) @ w_out
    return x + gate[:, None, :] * y


def setup_inputs(seed: int = 0) -> dict:
    key = jax.random.key(seed)
    ks = jax.random.split(key, 16)
    f32 = jnp.float32
    x = jax.random.normal(ks[0], (BATCH, SEQ, D_MODEL), f32)
    c = jax.random.normal(ks[1], (BATCH, D_MODEL), f32)
    start = jax.random.randint(ks[2], (BATCH, 1), 0, 64, dtype=jnp.int32) * CHUNK
    positions = (start + jnp.arange(SEQ, dtype=jnp.int32)[None, :]).astype(jnp.int32)
    w_ada = jax.random.normal(ks[3], (DEPTH, D_MODEL, 3 * D_MODEL), f32) * D_MODEL ** -0.5
    b_ada = jax.random.normal(ks[4], (DEPTH, 3 * D_MODEL), f32) * 0.02
    norm_g = 1.0 + 0.02 * jax.random.normal(ks[5], (DEPTH, D_MODEL), f32)
    w_in = jax.random.normal(ks[6], (DEPTH, D_MODEL, N_IN), f32) * D_MODEL ** -0.5
    a_q_norm_g = 1.0 + 0.02 * jax.random.normal(ks[7], (DEPTH, A_Q_RANK), f32)
    a_w_uq = jax.random.normal(ks[8], (DEPTH, A_Q_RANK, A_HEADS * (A_NOPE + A_ROPE)), f32) * A_Q_RANK ** -0.5
    a_kv_norm_g = 1.0 + 0.02 * jax.random.normal(ks[9], (DEPTH, A_KV_RANK), f32)
    a_w_ukv = jax.random.normal(ks[10], (DEPTH, A_KV_RANK, A_HEADS * (A_NOPE + A_V)), f32) * A_KV_RANK ** -0.5
    b_rel_bias = 0.2 * jax.random.normal(ks[11], (DEPTH, B_HEADS, 2 * REL_CLIP + 1), f32)
    c_forget_b = FORGET_BIAS_INIT + 0.1 * jax.random.normal(ks[12], (DEPTH, C_HEADS), f32)
    w_out = jax.random.normal(ks[13], (DEPTH, D_MIX, D_MODEL), f32) * D_MIX ** -0.5
    final_g = 1.0 + 0.02 * jax.random.normal(ks[14], (D_MODEL,), f32)
    return {"x": x, "c": c, "positions": positions, "w_ada": w_ada, "b_ada": b_ada,
            "norm_g": norm_g, "w_in": w_in, "a_q_norm_g": a_q_norm_g, "a_w_uq": a_w_uq,
            "a_kv_norm_g": a_kv_norm_g, "a_w_ukv": a_w_ukv, "b_rel_bias": b_rel_bias,
            "c_forget_b": c_forget_b, "w_out": w_out, "final_g": final_g}


def reference(x, c, positions, w_ada, b_ada, norm_g, w_in, a_q_norm_g, a_w_uq,
              a_kv_norm_g, a_w_ukv, b_rel_bias, c_forget_b, w_out, final_g):
    cos, sin = rope_tables(positions)
    c_act = jax.nn.silu(c)
    for l in range(DEPTH):
        x = hybrid_layer(x, c_act, cos, sin, w_ada[l], b_ada[l], norm_g[l], w_in[l],
                         a_q_norm_g[l], a_w_uq[l], a_kv_norm_g[l], a_w_ukv[l],
                         b_rel_bias[l], c_forget_b[l], w_out[l])
    return rmsnorm(x, final_g)
```

```cpp
#include <hip/hip_runtime.h>
#include <hip/hip_cooperative_groups.h>
#include <cstdio>
#include <cstdint>
namespace cg = cooperative_groups;

#ifndef ONE_LAUNCH
#define ONE_LAUNCH 0
#endif

#define LAS __attribute__((address_space(3)))
typedef unsigned short bf16_t;
typedef short bf16x8 __attribute__((ext_vector_type(8)));
typedef short s16x4 __attribute__((ext_vector_type(4)));
typedef float f32x2 __attribute__((ext_vector_type(2)));
typedef float f32x4 __attribute__((ext_vector_type(4)));
typedef float f32x16 __attribute__((ext_vector_type(16)));
typedef unsigned u32x2 __attribute__((ext_vector_type(2)));
typedef unsigned u32x4 __attribute__((ext_vector_type(4)));
typedef __bf16 bf16x2_t __attribute__((ext_vector_type(2)));

constexpr int DM = 1024, NB = 16, SEQ = 2048, NTOK = NB * SEQ;
constexpr int NIN = 3621, NZ = 3840;
constexpr int ZC_CQ = 0, ZC_CKV = 384, ZC_KPE = 640, ZC_GATE = 672, ZC_BQ = 1696, ZC_BK = 2016, ZC_BV = 2336, ZC_CQ2 = 2656, ZC_CK = 2976, ZC_CV = 3296, ZC_CF = 3616;
constexpr int QAP = 768;
constexpr float LOG2E = 1.4426950408889634f;
constexpr float EPS = 1e-6f;

constexpr size_t MiB = 1u << 20;
constexpr size_t WS_MOD = 1 * MiB;
constexpr size_t WS_CS = 2 * MiB;
constexpr size_t WS_RQ = 6 * MiB;
constexpr size_t WS_RKV = 6 * MiB + 256 * 1024;
constexpr size_t WS_LF = 7 * MiB;
constexpr size_t WS_G = 8 * MiB;
constexpr size_t WS_WIN = 10 * MiB;
constexpr size_t WS_WUQ = 25 * MiB;
constexpr size_t WS_WUKV = 27 * MiB;
constexpr size_t WS_WOUT = 28 * MiB;
constexpr size_t WS_H = 32 * MiB;
constexpr size_t WS_QA = 96 * MiB;
constexpr size_t WS_KVA = 144 * MiB;
constexpr size_t WS_Z = 192 * MiB;
constexpr size_t WS_END = 432 * MiB;

constexpr int LDS_BYTES = 147456;
constexpr int NPHASE = 14;

__device__ __forceinline__ unsigned cvtpk(float lo, float hi) { f32x2 v = {lo, hi}; bf16x2_t b = __builtin_convertvector(v, bf16x2_t); return __builtin_bit_cast(unsigned, b); }
__device__ __forceinline__ float bf_lo(unsigned u) { return __builtin_bit_cast(float, u << 16); }
__device__ __forceinline__ float bf_hi(unsigned u) { return __builtin_bit_cast(float, u & 0xffff0000u); }
__device__ __forceinline__ float shfl_xor_l(float v, int o, int lane) { return __builtin_bit_cast(float, __builtin_amdgcn_ds_bpermute((lane ^ o) << 2, __builtin_bit_cast(int, v))); }
__device__ __forceinline__ float shfl_up_l(float v, int o, int lane) { const int src = lane >= o ? lane - o : lane; return __builtin_bit_cast(float, __builtin_amdgcn_ds_bpermute(src << 2, __builtin_bit_cast(int, v))); }
__device__ __forceinline__ int lane_now() { int l; asm volatile("v_mbcnt_lo_u32_b32 %0, -1, 0\n\tv_mbcnt_hi_u32_b32 %0, -1, %0" : "=v"(l)); return l; }
__device__ __forceinline__ float wave_sum(float v, int lane) {
#pragma unroll
    for (int o = 1; o < 64; o <<= 1) v += shfl_xor_l(v, o, lane);
    return v;
}

namespace pg8 {
constexpr int BM = 256, BK = 64, HALF = 128, HTB = HALF * BK * 2, STAGE_BYTES = 8 * HTB, NXCD = 8, WGM = 8;
__device__ __forceinline__ int lds_byte(int r, int c) { const int st = (r >> 4) * 2 + (c >> 5), rr = r & 15, cc = c & 31, ob = rr * 64 + cc * 2; return st * 1024 + (ob ^ (((ob >> 9) & 1) << 5)); }
__device__ __forceinline__ void stage_rc(int b, int& R, int& C) { const int st = b / 1024, sb = b % 1024, swz = sb ^ (((sb >> 9) & 1) << 5); R = (st >> 1) * 16 + swz / 64; C = (st & 1) * 32 + (swz % 64) / 2; }
__device__ __forceinline__ int perm32(int rho) { const int n = rho >> 4, i = rho & 15; return 8 * (i >> 2) + 4 * n + (i & 3); }

struct Unit { int pm, pn; };
struct Gemm { const bf16_t* A; const bf16_t* Bt; int M, N, K, lda, ldb; };

struct StaticOrder {
    int nM, nN, nwg, G, c;
    __device__ void init(int M, int N, int G_, int c_) { nM = M / BM; nN = N / BM; nwg = nM * nN; G = G_; c = c_; }
    __device__ bool next(int i, Unit& u) const {
        const long L = (long)i * G + c; if (L >= nwg) return false;
        int wgid = (int)L; { const int q = nwg / NXCD, r = nwg % NXCD, xcd = wgid % NXCD, off = wgid / NXCD; wgid = (xcd < r ? xcd * (q + 1) : r * (q + 1) + (xcd - r) * q) + off; }
        const int nig = WGM * nN, gid = wgid / nig, fm = gid * WGM, gsz = (nM - fm) < WGM ? (nM - fm) : WGM;
        u.pm = fm + ((wgid % nig) % gsz); u.pn = (wgid % nig) / gsz; return true;
    }
};

template <class Epi>
__device__ __forceinline__ void gemm_phase(LAS unsigned char* lds, const Gemm g, const StaticOrder& S, const Epi& E, const int wv) {
    const int lane = lane_now(), wid = wv, tid = wv * 64 + lane, wr = wid >> 2, wc = wid & 3, fr = lane & 15, fq = lane >> 4;
    const int K = g.K, nt = K / BK;
    unsigned voffA[2], voffB[2];
#pragma unroll
    for (int i = 0; i < 2; ++i) { int R, C; stage_rc(tid * 16 + i * 8192, R, C); const int Rb = Epi::PERM ? ((R & ~31) + perm32(R & 31)) : R;
        voffA[i] = (unsigned)(R * g.lda + C) * 2u; voffB[i] = (unsigned)(Rb * g.ldb + C) * 2u; }
    const size_t kstep = (size_t)(BK * 2);
    const size_t hstepA = (size_t)HALF * g.lda * 2, hstepB = (size_t)HALF * g.ldb * 2;
    const size_t tstepA = 2 * hstepA, tstepB = 2 * hstepB;
    const unsigned ldsw = (unsigned)wid * 1024u;
    const int aoff = lds_byte(wr * 64 + fr, fq * 8), boff = lds_byte(wc * 32 + fr, fq * 8);
#define PG8_SA(b, h) (((b) * 2 + (h)) * HTB)
#define PG8_SB(b, h) ((4 + (b) * 2 + (h)) * HTB)
#define PG8_STAGE(bufoff, gbase, voff) do { const char* _g = (const char*)(gbase); asm volatile("" : "+s"(_g)); _Pragma("unroll") for (int _i = 0; _i < 2; ++_i) \
        __builtin_amdgcn_global_load_lds((const unsigned*)(_g + (voff)[_i]), (LAS unsigned*)(lds + (bufoff) + ldsw + _i * 8192), 16, 0, 0); } while (0)
#define PG8_LDA(dst, b, h) do { _Pragma("unroll") for (int m = 0; m < 4; ++m) _Pragma("unroll") for (int k = 0; k < 2; ++k) dst[m][k] = *(const LAS bf16x8*)(lds + PG8_SA(b, h) + aoff + m * 2048 + k * 1024); } while (0)
#define PG8_LDB(dst, b, h) do { _Pragma("unroll") for (int n = 0; n < 2; ++n) _Pragma("unroll") for (int k = 0; k < 2; ++k) dst[n][k] = *(const LAS bf16x8*)(lds + PG8_SB(b, h) + boff + n * 2048 + k * 1024); } while (0)
#define PG8_MMA(ai, bj, At, Bt) do { __builtin_amdgcn_s_setprio(1); _Pragma("unroll") for (int m = 0; m < 4; ++m) _Pragma("unroll") for (int n = 0; n < 2; ++n) _Pragma("unroll") for (int k = 0; k < 2; ++k) \
        acc[ai][bj][m][n] = __builtin_amdgcn_mfma_f32_16x16x32_bf16(Bt[n][k], At[m][k], acc[ai][bj][m][n], 0, 0, 0); __builtin_amdgcn_s_setprio(0); } while (0)
#define PG8_WAIT_V(n) asm volatile("s_waitcnt vmcnt(" #n ")" ::: "memory")
#define PG8_WAIT_L(n) asm volatile("s_waitcnt lgkmcnt(" #n ")" ::: "memory")
#define PG8_BAR __builtin_amdgcn_s_barrier()
#define PG8_SCHED __builtin_amdgcn_sched_barrier(0)
    Unit cur, nxt; int ui = 0;
    if (!S.next(0, cur)) return;
    f32x4 acc[2][2][4][2];
#pragma unroll
    for (int a = 0; a < 2; ++a)
#pragma unroll
        for (int b = 0; b < 2; ++b)
#pragma unroll
            for (int m = 0; m < 4; ++m)
#pragma unroll
                for (int n = 0; n < 2; ++n) acc[a][b][m][n] = (f32x4){0.f, 0.f, 0.f, 0.f};
    bf16x8 At[4][2], B0[2][2], B1[2][2];
    const char* cA = (const char*)g.A + (size_t)cur.pm * tstepA; const char* cB = (const char*)g.Bt + (size_t)cur.pn * tstepB;
    PG8_STAGE(PG8_SB(0, 0), cB, voffB); PG8_STAGE(PG8_SB(0, 1), cB + hstepB, voffB); PG8_STAGE(PG8_SA(0, 0), cA, voffA); PG8_STAGE(PG8_SA(0, 1), cA + hstepA, voffA);
    if (wr == 1) PG8_BAR;
    PG8_WAIT_V(2); PG8_BAR;
    PG8_STAGE(PG8_SB(1, 0), cB + kstep, voffB); PG8_STAGE(PG8_SA(1, 0), cA + kstep, voffA); PG8_STAGE(PG8_SB(1, 1), cB + hstepB + kstep, voffB);
    PG8_WAIT_V(6); PG8_BAR;
    for (;;) {
        const bool has_next = S.next(ui + 1, nxt);
        const char* nA = has_next ? (const char*)g.A + (size_t)nxt.pm * tstepA : cA; const char* nB = has_next ? (const char*)g.Bt + (size_t)nxt.pn * tstepB : cB;
        for (int t = 0; t < nt; t += 2) {
            const bool last = (t == nt - 2);
            const char* a1 = cA + (size_t)(t + 1) * kstep;
            const char* a2 = last ? nA : cA + (size_t)(t + 2) * kstep; const char* b2 = last ? nB : cB + (size_t)(t + 2) * kstep;
            const char* a3 = a2 + kstep; const char* b3 = b2 + kstep;
            PG8_LDB(B0, 0, 0); PG8_LDB(B1, 0, 1); PG8_SCHED; PG8_LDA(At, 0, 0); PG8_STAGE(PG8_SA(1, 1), a1 + hstepA, voffA);
            PG8_WAIT_V(8); PG8_WAIT_L(0); PG8_BAR; PG8_MMA(0, 0, At, B0); PG8_MMA(0, 1, At, B1); PG8_BAR; PG8_SCHED;
            PG8_LDA(At, 0, 1); PG8_STAGE(PG8_SB(0, 0), b2, voffB); PG8_STAGE(PG8_SB(0, 1), b2 + hstepB, voffB); PG8_STAGE(PG8_SA(0, 0), a2, voffA);
            PG8_WAIT_V(8); PG8_WAIT_L(0); PG8_BAR; PG8_MMA(1, 0, At, B0); PG8_MMA(1, 1, At, B1); PG8_BAR; PG8_SCHED;
            PG8_LDB(B0, 1, 0); PG8_LDB(B1, 1, 1); PG8_SCHED; PG8_LDA(At, 1, 0); PG8_STAGE(PG8_SA(0, 1), a2 + hstepA, voffA);
            PG8_WAIT_V(8); PG8_WAIT_L(0); PG8_BAR; PG8_MMA(0, 0, At, B0); PG8_MMA(0, 1, At, B1); PG8_BAR; PG8_SCHED;
            PG8_LDA(At, 1, 1); PG8_STAGE(PG8_SB(1, 0), b3, voffB); PG8_STAGE(PG8_SB(1, 1), b3 + hstepB, voffB); PG8_STAGE(PG8_SA(1, 0), a3, voffA);
            PG8_WAIT_V(8); PG8_WAIT_L(0); PG8_BAR; PG8_MMA(1, 0, At, B0); PG8_MMA(1, 1, At, B1); PG8_BAR; PG8_SCHED;
        }
        if (wr == 0) PG8_BAR;
        { const int le = lane_now();
          E(acc, cur, wid >> 2, wid & 3, le & 15, le >> 4); }
        if (!has_next) break;
#pragma unroll
        for (int a = 0; a < 2; ++a)
#pragma unroll
            for (int b = 0; b < 2; ++b)
#pragma unroll
                for (int m = 0; m < 4; ++m)
#pragma unroll
                    for (int n = 0; n < 2; ++n) acc[a][b][m][n] = (f32x4){0.f, 0.f, 0.f, 0.f};
        cur = nxt; cA = nA; cB = nB; ++ui;
        if (wr == 1) PG8_BAR;
    }
    PG8_WAIT_V(0);
    PG8_BAR;
#undef PG8_SA
#undef PG8_SB
#undef PG8_STAGE
#undef PG8_LDA
#undef PG8_LDB
#undef PG8_MMA
#undef PG8_WAIT_V
#undef PG8_WAIT_L
#undef PG8_BAR
#undef PG8_SCHED
}

struct EpiZ {
    static constexpr bool PERM = true;
    bf16_t* Z; const float* cs; float* LF; const float* fb;
    __device__ __forceinline__ void operator()(const f32x4 (&acc)[2][2][4][2], const Unit& u, int wr, int wc, int fr, int fq) const {
        const int row0 = u.pm * BM + wr * 64 + fr;
#pragma unroll
        for (int bj = 0; bj < 2; ++bj) {
            const int colg = u.pn * BM + bj * HALF + wc * 32 + 8 * fq;
            if (colg >= ZC_CF + 8) continue;
            int type = 0;
            if (colg >= ZC_KPE && colg < ZC_GATE) type = 1; else if (colg >= ZC_GATE && colg < ZC_BQ) type = 2; else if (colg == ZC_CF) type = 3;
#pragma unroll
            for (int ai = 0; ai < 2; ++ai)
#pragma unroll
                for (int m = 0; m < 4; ++m) {
                    const int row = row0 + ai * HALF + m * 16;
                    f32x4 v0 = acc[ai][bj][m][0], v1 = acc[ai][bj][m][1];
                    if (type == 1) {
                        const int i0 = (colg - ZC_KPE) >> 1;
                        const f32x4 co = *(const f32x4*)(cs + (size_t)row * 32 + i0), si = *(const f32x4*)(cs + (size_t)row * 32 + 16 + i0);
                        f32x4 a, b;
                        a[0] = v0[0] * co[0] - v0[1] * si[0]; a[1] = v0[0] * si[0] + v0[1] * co[0];
                        a[2] = v0[2] * co[1] - v0[3] * si[1]; a[3] = v0[2] * si[1] + v0[3] * co[1];
                        b[0] = v1[0] * co[2] - v1[1] * si[2]; b[1] = v1[0] * si[2] + v1[1] * co[2];
                        b[2] = v1[2] * co[3] - v1[3] * si[3]; b[3] = v1[2] * si[3] + v1[3] * co[3];
                        v0 = a; v1 = b;
                    } else if (type == 2) {
#pragma unroll
                        for (int i = 0; i < 4; ++i) { v0[i] = v0[i] / (1.f + __expf(-v0[i])); v1[i] = v1[i] / (1.f + __expf(-v1[i])); }
                    } else if (type == 3) {
                        float y[5] = {v0[0], v0[1], v0[2], v0[3], v1[0]};
#pragma unroll
                        for (int hh = 0; hh < 5; ++hh) { const float t = y[hh] + fb[hh]; LF[(size_t)row * 8 + hh] = fminf(t, 0.f) - log1pf(__expf(-fabsf(t))); }
                        continue;
                    }
                    u32x4 w; w.x = cvtpk(v0[0], v0[1]); w.y = cvtpk(v0[2], v0[3]); w.z = cvtpk(v1[0], v1[1]); w.w = cvtpk(v1[2], v1[3]);
                    *(u32x4*)(Z + (size_t)row * NZ + colg) = w;
                    asm volatile("" ::: "memory");
                }
        }
    }
};
struct EpiQ {
    static constexpr bool PERM = true;
    bf16_t* O; const float* cs; const float* rs;
    __device__ __forceinline__ void operator()(const f32x4 (&acc)[2][2][4][2], const Unit& u, int wr, int wc, int fr, int fq) const {
        const int row0 = u.pm * BM + wr * 64 + fr;
#pragma unroll
        for (int bj = 0; bj < 2; ++bj) {
            const int colg = u.pn * BM + bj * HALF + wc * 32 + 8 * fq;
            if (colg >= 576) continue;
            const int hd = colg % 96;
#pragma unroll
            for (int ai = 0; ai < 2; ++ai)
#pragma unroll
                for (int m = 0; m < 4; ++m) {
                    const int row = row0 + ai * HALF + m * 16;
                    const float r = rs[row];
                    f32x4 v0 = acc[ai][bj][m][0] * r, v1 = acc[ai][bj][m][1] * r;
                    if (hd >= 64) {
                        const int i0 = (hd - 64) >> 1;
                        const f32x4 co = *(const f32x4*)(cs + (size_t)row * 32 + i0), si = *(const f32x4*)(cs + (size_t)row * 32 + 16 + i0);
                        f32x4 a, b;
                        a[0] = v0[0] * co[0] - v0[1] * si[0]; a[1] = v0[0] * si[0] + v0[1] * co[0];
                        a[2] = v0[2] * co[1] - v0[3] * si[1]; a[3] = v0[2] * si[1] + v0[3] * co[1];
                        b[0] = v1[0] * co[2] - v1[1] * si[2]; b[1] = v1[0] * si[2] + v1[1] * co[2];
                        b[2] = v1[2] * co[3] - v1[3] * si[3]; b[3] = v1[2] * si[3] + v1[3] * co[3];
                        v0 = a; v1 = b;
                    }
                    u32x4 w; w.x = cvtpk(v0[0], v0[1]); w.y = cvtpk(v0[2], v0[3]); w.z = cvtpk(v1[0], v1[1]); w.w = cvtpk(v1[2], v1[3]);
                    *(u32x4*)(O + (size_t)row * QAP + colg) = w;
                    asm volatile("" ::: "memory");
                }
        }
    }
};
struct EpiKV {
    static constexpr bool PERM = true;
    bf16_t* O; const float* rs;
    __device__ __forceinline__ void operator()(const f32x4 (&acc)[2][2][4][2], const Unit& u, int wr, int wc, int fr, int fq) const {
        const int row0 = u.pm * BM + wr * 64 + fr;
#pragma unroll
        for (int bj = 0; bj < 2; ++bj) {
            const int colg = u.pn * BM + bj * HALF + wc * 32 + 8 * fq;
#pragma unroll
            for (int ai = 0; ai < 2; ++ai)
#pragma unroll
                for (int m = 0; m < 4; ++m) {
                    const int row = row0 + ai * HALF + m * 16;
                    const float r = rs[row];
                    const f32x4 v0 = acc[ai][bj][m][0] * r, v1 = acc[ai][bj][m][1] * r;
                    u32x4 w; w.x = cvtpk(v0[0], v0[1]); w.y = cvtpk(v0[2], v0[3]); w.z = cvtpk(v1[0], v1[1]); w.w = cvtpk(v1[2], v1[3]);
                    *(u32x4*)(O + (size_t)row * QAP + colg) = w;
                    asm volatile("" ::: "memory");
                }
        }
    }
};
struct EpiOut {
    static constexpr bool PERM = true;
    const float* xold; float* xnew; const float* gate;
    __device__ __forceinline__ void operator()(const f32x4 (&acc)[2][2][4][2], const Unit& u, int wr, int wc, int fr, int fq) const {
        const int row0 = u.pm * BM + wr * 64 + fr;
        const int b = (u.pm * BM) / SEQ;
#pragma unroll
        for (int bj = 0; bj < 2; ++bj) {
            const int colg = u.pn * BM + bj * HALF + wc * 32 + 8 * fq;
            const f32x4 g0 = *(const f32x4*)(gate + (size_t)b * 3072 + colg), g1 = *(const f32x4*)(gate + (size_t)b * 3072 + colg + 4);
#pragma unroll
            for (int ai = 0; ai < 2; ++ai)
#pragma unroll
                for (int m = 0; m < 4; ++m) {
                    const int row = row0 + ai * HALF + m * 16;
                    const size_t off = (size_t)row * DM + colg;
                    const f32x4 x0 = *(const f32x4*)(xold + off), x1 = *(const f32x4*)(xold + off + 4);
                    *(f32x4*)(xnew + off) = x0 + g0 * acc[ai][bj][m][0];
                    *(f32x4*)(xnew + off + 4) = x1 + g1 * acc[ai][bj][m][1];
                    if (m & 1) asm volatile("" ::: "memory");
                }
        }
    }
};
}

namespace att {
constexpr int KSLOT = 12288, VSLOT = 8192;
constexpr int L_K = 0, L_V = 2 * KSLOT, L_WS = L_V + 2 * VSLOT, L_OST = L_WS + 2048, L_TB = L_OST + 8 * 4096, L_END = L_TB + 2048;
constexpr float NEG = -1e30f;
__device__ __forceinline__ s16x4 vtr(const LAS unsigned char* p) { return __builtin_bit_cast(s16x4, __builtin_amdgcn_ds_read_tr16_b64_v4i16((LAS s16x4*)p)); }

struct AP { const bf16_t* Q; int qp; const bf16_t* K; int kp; const bf16_t* K2; int k2p; const bf16_t* V; int vp; const bf16_t* gate; bf16_t* out; const float* kb; };

template <int MODE>
__device__ __forceinline__ void attn_unit(const AP P, const int qb, LAS unsigned char* lds, const int wv) {
    constexpr int DQK = (MODE == 0) ? 96 : 64, NQ = DQK / 16;
    const int lane = lane_now(), r32 = lane & 31, hi = lane >> 5;
    const int wid = wv, tid = wv * 64 + lane;
    const int q0 = qb * 256;
    const int cw = 4 * qb + (wid >> 1);
    int t0 = 0; const int t1 = 4 * qb + 4;
    if (MODE == 1) t0 = (4 * qb - 8) > 0 ? (4 * qb - 8) : 0;
    const int qrel = 32 * (wid & 1) + r32;
    bf16x8 qr[NQ];
    {
        const bf16_t* Qw = P.Q + (size_t)(q0 + wid * 32 + r32) * P.qp + hi * 8;
#pragma unroll
        for (int d0 = 0; d0 < NQ; ++d0) qr[d0] = *(const bf16x8*)(Qw + d0 * 16);
    }
    if (MODE == 1) { LAS float* tb = (LAS float*)(lds + L_TB); for (int i = tid; i < 257; i += 512) tb[i] = P.kb[i] * LOG2E; }
    const bf16_t* ksrc = P.K + (size_t)lane * P.kp + wid * 8;
    const bf16_t* k2src = (MODE == 0) ? (P.K2 + (size_t)lane * P.k2p + (wid & 3) * 8) : nullptr;
    const bf16_t* vsrc = P.V + (size_t)(16 * (wid & 3) + (lane >> 2)) * P.vp + (wid >> 2) * 32 + (lane & 3) * 8;
    const int pdst = wid * 1024 + lane * 16;
    const bool k2w = (MODE == 0) && (wid < 4);
    float m_run = NEG, l_run = 0.f;
    f32x16 o0, o1;
#pragma unroll
    for (int r = 0; r < 16; ++r) { o0[r] = 0.f; o1[r] = 0.f; }
    LAS float* wsf = (LAS float*)(lds + L_WS) + wid * 64;
    const int vboff = ((lane >> 4) & 1) * 32 + (lane & 3) * 8 + (4 * hi + ((lane & 15) >> 2)) * 64;
    {
        const u32x4 kr = *(const u32x4*)(ksrc + (size_t)t0 * 64 * P.kp);
        const u32x4 vr = *(const u32x4*)(vsrc + (size_t)t0 * 64 * P.vp);
        u32x4 k2r = {0u, 0u, 0u, 0u};
        if (k2w) k2r = *(const u32x4*)(k2src + (size_t)t0 * 64 * P.k2p);
        *(LAS u32x4*)(lds + L_K + pdst) = kr;
        if (k2w) *(LAS u32x4*)(lds + L_K + 8192 + pdst) = k2r;
        *(LAS u32x4*)(lds + L_V + pdst) = vr;
    }
    __syncthreads();
    for (int t = t0; t < t1; ++t) {
        const int cur = (t - t0) & 1;
        const bool more = (t + 1 < t1);
        u32x4 kr = {0u, 0u, 0u, 0u}, vr = {0u, 0u, 0u, 0u}, k2r = {0u, 0u, 0u, 0u};
        if (more) {
            kr = *(const u32x4*)(ksrc + (size_t)(t + 1) * 64 * P.kp);
            vr = *(const u32x4*)(vsrc + (size_t)(t + 1) * 64 * P.vp);
            if (k2w) k2r = *(const u32x4*)(k2src + (size_t)(t + 1) * 64 * P.k2p);
        }
        bool valid = (t <= cw);
        if (MODE == 1) valid = valid && (t >= cw - 8);
        if (valid) {
            const LAS unsigned char* kbp = lds + L_K + cur * KSLOT + hi * 1024 + r32 * 16;
            f32x16 p0, p1;
#pragma unroll
            for (int r = 0; r < 16; ++r) { p0[r] = 0.f; p1[r] = 0.f; }
#pragma unroll
            for (int d0 = 0; d0 < NQ; ++d0) {
                const bf16x8 b0 = *(const LAS bf16x8*)(kbp + d0 * 2048), b1 = *(const LAS bf16x8*)(kbp + d0 * 2048 + 512);
                p0 = __builtin_amdgcn_mfma_f32_32x32x16_bf16(b0, qr[d0], p0, 0, 0, 0);
                p1 = __builtin_amdgcn_mfma_f32_32x32x16_bf16(b1, qr[d0], p1, 0, 0, 0);
            }
            if (MODE == 2) {
                const float* gp = P.kb + t * 64 + 4 * hi;
#pragma unroll
                for (int g4 = 0; g4 < 4; ++g4) {
                    const f32x4 a = *(const f32x4*)(gp + 8 * g4), b = *(const f32x4*)(gp + 32 + 8 * g4);
#pragma unroll
                    for (int i = 0; i < 4; ++i) { p0[4 * g4 + i] += a[i]; p1[4 * g4 + i] += b[i]; }
                }
                if (t == cw) {
#pragma unroll
                    for (int r = 0; r < 16; ++r) { const int kj = (r & 3) + 8 * (r >> 2) + 4 * hi; if (kj > qrel) p0[r] = NEG; if (kj + 32 > qrel) p1[r] = NEG; }
                }
            }
            if (MODE == 1) {
                const LAS float* tb = (const LAS float*)(lds + L_TB);
                const int mm = cw - t;
                if (mm >= 3) {
                    const float c = tb[256];
#pragma unroll
                    for (int r = 0; r < 16; ++r) { p0[r] += c; p1[r] += c; }
                } else {
                    const int base = 64 * mm + qrel - 4 * hi;
#pragma unroll
                    for (int r = 0; r < 16; ++r) {
                        const int c0 = (r & 3) + 8 * (r >> 2);
                        int i0 = base - c0; i0 = (i0 > 128 ? 128 : i0) + 128;
                        int i1 = base - c0 - 32; i1 = (i1 > 128 ? 128 : i1) + 128;
                        p0[r] += tb[i0]; p1[r] += tb[i1];
                    }
                }
            }
            float rm = fmaxf(p0[0], p1[0]);
#pragma unroll
            for (int r = 1; r < 16; ++r) rm = fmaxf(rm, fmaxf(p0[r], p1[r]));
            rm = fmaxf(rm, shfl_xor_l(rm, 32, lane));
            const float mn = fmaxf(m_run, rm);
            const float f = __builtin_amdgcn_exp2f(m_run - mn);
            m_run = mn;
            float s = 0.f;
#pragma unroll
            for (int r = 0; r < 16; ++r) { p0[r] = __builtin_amdgcn_exp2f(p0[r] - mn); p1[r] = __builtin_amdgcn_exp2f(p1[r] - mn); s += p0[r] + p1[r]; }
            l_run = l_run * f + s;
            if (hi == 0) wsf[r32] = f;
            asm volatile("" ::: "memory");
#pragma unroll
            for (int g4 = 0; g4 < 4; ++g4) {
                const f32x4 fv = *(const LAS f32x4*)(wsf + 8 * g4 + 4 * hi);
#pragma unroll
                for (int i = 0; i < 4; ++i) { o0[4 * g4 + i] *= fv[i]; o1[4 * g4 + i] *= fv[i]; }
            }
            u32x4 pw[4];
            pw[0] = (u32x4){cvtpk(p0[0], p0[1]), cvtpk(p0[2], p0[3]), cvtpk(p0[4], p0[5]), cvtpk(p0[6], p0[7])};
            pw[1] = (u32x4){cvtpk(p0[8], p0[9]), cvtpk(p0[10], p0[11]), cvtpk(p0[12], p0[13]), cvtpk(p0[14], p0[15])};
            pw[2] = (u32x4){cvtpk(p1[0], p1[1]), cvtpk(p1[2], p1[3]), cvtpk(p1[4], p1[5]), cvtpk(p1[6], p1[7])};
            pw[3] = (u32x4){cvtpk(p1[8], p1[9]), cvtpk(p1[10], p1[11]), cvtpk(p1[12], p1[13]), cvtpk(p1[14], p1[15])};
            const LAS unsigned char* vp = lds + L_V + cur * VSLOT + vboff;
#pragma unroll
            for (int ks = 0; ks < 4; ++ks) {
                const bf16x8 pa = __builtin_bit_cast(bf16x8, pw[ks]);
                {
                    const s16x4 lo = vtr(vp + ks * 1024), hh = vtr(vp + ks * 1024 + 512);
                    const bf16x8 vf = {lo[0], lo[1], lo[2], lo[3], hh[0], hh[1], hh[2], hh[3]};
                    o0 = __builtin_amdgcn_mfma_f32_32x32x16_bf16(pa, vf, o0, 0, 0, 0);
                }
                {
                    const s16x4 lo = vtr(vp + 4096 + ks * 1024), hh = vtr(vp + 4096 + ks * 1024 + 512);
                    const bf16x8 vf = {lo[0], lo[1], lo[2], lo[3], hh[0], hh[1], hh[2], hh[3]};
                    o1 = __builtin_amdgcn_mfma_f32_32x32x16_bf16(pa, vf, o1, 0, 0, 0);
                }
            }
        }
        if (more) {
            const int nb = cur ^ 1;
            *(LAS u32x4*)(lds + L_K + nb * KSLOT + pdst) = kr;
            if (k2w) *(LAS u32x4*)(lds + L_K + nb * KSLOT + 8192 + pdst) = k2r;
            *(LAS u32x4*)(lds + L_V + nb * VSLOT + pdst) = vr;
        }
        __syncthreads();
    }
    l_run += shfl_xor_l(l_run, 32, lane);
    if (hi == 0) wsf[32 + r32] = l_run;
    asm volatile("" ::: "memory");
    float rli[16];
#pragma unroll
    for (int g4 = 0; g4 < 4; ++g4) {
        const f32x4 lv = *(const LAS f32x4*)(wsf + 32 + 8 * g4 + 4 * hi);
#pragma unroll
        for (int i = 0; i < 4; ++i) rli[4 * g4 + i] = 1.0f / lv[i];
    }
    LAS bf16_t* stg = (LAS bf16_t*)(lds + L_OST) + wid * 2048;
#pragma unroll
    for (int r = 0; r < 16; ++r) {
        const int orow = (r & 3) + 8 * (r >> 2) + 4 * hi;
        stg[orow * 64 + r32] = (bf16_t)(cvtpk(o0[r] * rli[r], 0.f) & 0xffffu);
        stg[orow * 64 + 32 + r32] = (bf16_t)(cvtpk(o1[r] * rli[r], 0.f) & 0xffffu);
    }
    asm volatile("" ::: "memory");
#pragma unroll
    for (int i = 0; i < 4; ++i) {
        const int row = i * 8 + (lane >> 3), ch = lane & 7;
        const u32x4 v = *(const LAS u32x4*)(stg + row * 64 + ch * 8);
        const size_t grow = (size_t)(q0 + wid * 32 + row);
        const u32x4 gt = *(const u32x4*)(P.gate + grow * NZ + ch * 8);
        u32x4 w;
        w.x = cvtpk(bf_lo(v.x) * bf_lo(gt.x), bf_hi(v.x) * bf_hi(gt.x));
        w.y = cvtpk(bf_lo(v.y) * bf_lo(gt.y), bf_hi(v.y) * bf_hi(gt.y));
        w.z = cvtpk(bf_lo(v.z) * bf_lo(gt.z), bf_hi(v.z) * bf_hi(gt.z));
        w.w = cvtpk(bf_lo(v.w) * bf_lo(gt.w), bf_hi(v.w) * bf_hi(gt.w));
        *(u32x4*)(P.out + grow * DM + ch * 8) = w;
    }
    __syncthreads();
}
}

struct Args {
    const float* x; const float* c; const int* pos; const float* w_ada; const float* b_ada; const float* norm_g; const float* w_in;
    const float* qng; const float* w_uq; const float* kvng; const float* w_ukv; const float* relb; const float* fgb; const float* w_out; const float* final_g;
    float* out; unsigned char* ws; int ph_lo, ph_hi;
};

__device__ __forceinline__ int src_col(int kind, int n, float& sc) {
    sc = 1.f;
    if (kind == 0) {
        if (n < ZC_KPE) return n;
        if (n < ZC_GATE) { const int i = (n - ZC_KPE) >> 1, odd = (n - ZC_KPE) & 1; return 640 + i + 16 * odd; }
        if (n < 1056) return n;
        if (n < 1376) return 2016 + (n - 1056);
        if (n < ZC_BQ) return 3301 + (n - 1376);
        if (n < ZC_BK) { sc = 0.125f * LOG2E; return 1056 + (n - ZC_BQ); }
        if (n < ZC_BV) return 1376 + (n - ZC_BK);
        if (n < ZC_CQ2) return 1696 + (n - ZC_BV);
        if (n < ZC_CK) { sc = 0.125f * LOG2E; return 2336 + (n - ZC_CQ2); }
        if (n < ZC_CV) return 2656 + (n - ZC_CK);
        if (n < ZC_CF) return 2976 + (n - ZC_CV);
        if (n < ZC_CF + 5) return 3296 + (n - ZC_CF);
        return -1;
    } else if (kind == 1) {
        if (n >= 576) return -1;
        sc = 0.10206207261596577f * LOG2E;
        const int h = n / 96, d = n % 96;
        if (d < 64) return n;
        const int i = (d - 64) >> 1, odd = (d - 64) & 1; return h * 96 + 64 + i + 16 * odd;
    } else if (kind == 2) {
        if (n < 384) { const int h = n >> 6, d = n & 63; return h * 128 + d; }
        const int m = n - 384, h = m >> 6, d = m & 63; return h * 128 + 64 + d;
    }
    return n;
}
__device__ __forceinline__ void transpose_item(const float* W, int N, int K, bf16_t* WT, LAS float* scr, int kind, const float* rowscale, int item, int nblk, int lane) {
    const int kb = item / nblk, nb = item % nblk, k0 = 64 * kb, n0 = 32 * nb;
    float csc; const int sc = src_col(kind, n0 + (lane & 31), csc);
#pragma unroll 8
    for (int i = 0; i < 32; ++i) {
        const int kk = 2 * i + (lane >> 5);
        float v = 0.f;
        if (sc >= 0) { v = W[(size_t)(k0 + kk) * N + sc] * csc; if (rowscale) v *= rowscale[k0 + kk]; }
        scr[kk * 33 + (lane & 31)] = v;
    }
    __builtin_amdgcn_s_waitcnt(0xc07f);
    asm volatile("" ::: "memory");
    const int c = lane & 7;
#pragma unroll
    for (int j = 0; j < 4; ++j) {
        const int n = (lane >> 3) + 8 * j; const LAS float* s = scr + (8 * c) * 33 + n;
        u32x4 o; o.x = cvtpk(s[0 * 33], s[1 * 33]); o.y = cvtpk(s[2 * 33], s[3 * 33]); o.z = cvtpk(s[4 * 33], s[5 * 33]); o.w = cvtpk(s[6 * 33], s[7 * 33]);
        *(u32x4*)(WT + (size_t)(n0 + n) * K + k0 + 8 * c) = o;
    }
    __builtin_amdgcn_s_waitcnt(0xc07f);
    asm volatile("" ::: "memory");
}

__device__ __forceinline__ void phase0(const Args& a, LAS unsigned char* lds, const int wv, const int bid) {
    const int lane = lane_now(), wave = wv, tid = wv * 64 + lane;
    float* mod = (float*)(a.ws + WS_MOD);
    if (bid < 96) {
        LAS float* cact = (LAS float*)lds;
        for (int i = tid; i < 16 * 1024; i += 512) { const int b = i >> 10, k = i & 1023; const float v = a.c[i]; cact[k * 16 + b] = v / (1.f + __expf(-v)); }
        __syncthreads();
        const int q = bid, l = q / 48, j0 = (q % 48) * 64, ks = wave;
        float acc[16];
#pragma unroll
        for (int b = 0; b < 16; ++b) acc[b] = 0.f;
        const float* w = a.w_ada + (size_t)l * 1024 * 3072 + (size_t)(ks * 128) * 3072 + j0 + lane;
#pragma unroll 8
        for (int kk = 0; kk < 128; ++kk) {
            const float wv = w[(size_t)kk * 3072];
            const LAS f32x4* cp = (const LAS f32x4*)(cact + (ks * 128 + kk) * 16);
            const f32x4 c0 = cp[0], c1 = cp[1], c2 = cp[2], c3 = cp[3];
#pragma unroll
            for (int i = 0; i < 4; ++i) { acc[i] += wv * c0[i]; acc[4 + i] += wv * c1[i]; acc[8 + i] += wv * c2[i]; acc[12 + i] += wv * c3[i]; }
        }
        LAS float* part = (LAS float*)(lds + 65536);
#pragma unroll
        for (int b = 0; b < 16; ++b) part[(ks * 16 + b) * 64 + lane] = acc[b];
        __syncthreads();
        for (int o = tid; o < 1024; o += 512) {
            const int b = o >> 6, jj = o & 63; float s = a.b_ada[l * 3072 + j0 + jj];
#pragma unroll
            for (int k2 = 0; k2 < 8; ++k2) s += part[(k2 * 16 + b) * 64 + jj];
            mod[((size_t)l * 16 + b) * 3072 + j0 + jj] = s;
        }
        __syncthreads();
    }
    {
        LAS float* scr = (LAS float*)(lds + wave * 8448);
        const int gw = bid * 8 + wave, NGW = gridDim.x * 8;
        constexpr int I_IN = 16 * 120, I_UQ = 6 * 24, I_UKV = 4 * 24, I_OUT = 16 * 32, I_L = I_IN + I_UQ + I_UKV + I_OUT;
        for (int it = gw; it < 2 * I_L; it += NGW) {
            const int l = it / I_L; int r = it % I_L;
            if (r < I_IN) { transpose_item(a.w_in + (size_t)l * 1024 * NIN, NIN, 1024, (bf16_t*)(a.ws + WS_WIN) + (size_t)l * NZ * 1024, scr, 0, nullptr, r, 120, lane); continue; } r -= I_IN;
            if (r < I_UQ) { transpose_item(a.w_uq + (size_t)l * 384 * 576, 576, 384, (bf16_t*)(a.ws + WS_WUQ) + (size_t)l * 768 * 384, scr, 1, a.qng + l * 384, r, 24, lane); continue; } r -= I_UQ;
            if (r < I_UKV) { transpose_item(a.w_ukv + (size_t)l * 256 * 768, 768, 256, (bf16_t*)(a.ws + WS_WUKV) + (size_t)l * 768 * 256, scr, 2, a.kvng + l * 256, r, 24, lane); continue; } r -= I_UKV;
            transpose_item(a.w_out + (size_t)l * 1024 * 1024, 1024, 1024, (bf16_t*)(a.ws + WS_WOUT) + (size_t)l * 1024 * 1024, scr, 3, nullptr, r, 32, lane);
        }
    }
    {
        float* cs = (float*)(a.ws + WS_CS);
        const int gt = bid * 512 + tid, NGT = gridDim.x * 512;
        for (int i = gt; i < NTOK * 16; i += NGT) {
            const int tok = i >> 4, j = i & 15;
            const float inv = exp2f(-(float)j * (13.287712379549449f / 16.f));
            const float ang = (float)a.pos[tok] * inv;
            double r = (double)ang; r -= 6.283185307179586 * rint(r * 0.15915494309189535);
            cs[(size_t)tok * 32 + j] = cosf((float)r); cs[(size_t)tok * 32 + 16 + j] = sinf((float)r);
        }
    }
}

__device__ __forceinline__ void phase_norm(const Args& a, int l, const float* xin, const int wv, const int bid) {
    const int lane = lane_now(), wave = wv;
    const int gw = bid * 8 + wave, NGW = gridDim.x * 8, wpb = NGW / NB;
    const int b = gw / wpb, wi = gw % wpb;
    if (b >= NB) return;
    const float* mod = (const float*)(a.ws + WS_MOD) + ((size_t)l * 16 + b) * 3072;
    bf16_t* H = (bf16_t*)(a.ws + WS_H);
    f32x4 G[4], SH[4];
#pragma unroll
    for (int j = 0; j < 4; ++j) {
        const int col = 4 * lane + 256 * j;
        const f32x4 g = *(const f32x4*)(a.norm_g + l * 1024 + col), sc = *(const f32x4*)(mod + 1024 + col);
        G[j] = g * (sc + 1.0f); SH[j] = *(const f32x4*)(mod + col);
    }
    for (int row = wi; row < SEQ; row += wpb) {
        const size_t tok = (size_t)b * SEQ + row;
        const f32x4* xr = (const f32x4*)(xin + tok * DM) + lane;
        f32x4 v[4]; float s = 0.f;
#pragma unroll
        for (int j = 0; j < 4; ++j) { v[j] = xr[64 * j]; s += (v[j].x * v[j].x + v[j].y * v[j].y) + (v[j].z * v[j].z + v[j].w * v[j].w); }
        const float rstd = 1.0f / sqrtf(wave_sum(s, lane) * (1.f / DM) + EPS);
        u32x2* o8 = (u32x2*)(H + tok * DM) + lane;
#pragma unroll
        for (int j = 0; j < 4; ++j) { const f32x4 h = v[j] * rstd * G[j] + SH[j]; u32x2 w; w.x = cvtpk(h.x, h.y); w.y = cvtpk(h.z, h.w); o8[64 * j] = w; }
    }
}

__device__ __forceinline__ void phase_stats(const Args& a, const int wv, const int bid) {
    const int lane = lane_now(), wave = wv;
    const int gw = bid * 8 + wave, NGW = gridDim.x * 8;
    const bf16_t* Z = (const bf16_t*)(a.ws + WS_Z);
    float* RQ = (float*)(a.ws + WS_RQ); float* RKV = (float*)(a.ws + WS_RKV);
    for (int row = gw; row < NTOK; row += NGW) {
        const bf16_t* zr = Z + (size_t)row * NZ;
        const u32x4 v1 = *(const u32x4*)(zr + lane * 8);
        u32x4 v2 = {0u, 0u, 0u, 0u};
        if (lane < 16) v2 = *(const u32x4*)(zr + 512 + lane * 8);
        float s1 = 0.f, s2 = 0.f;
        { float t;
          t = bf_lo(v1.x); s1 += t * t; t = bf_hi(v1.x); s1 += t * t; t = bf_lo(v1.y); s1 += t * t; t = bf_hi(v1.y); s1 += t * t;
          t = bf_lo(v1.z); s1 += t * t; t = bf_hi(v1.z); s1 += t * t; t = bf_lo(v1.w); s1 += t * t; t = bf_hi(v1.w); s1 += t * t;
          t = bf_lo(v2.x); s2 += t * t; t = bf_hi(v2.x); s2 += t * t; t = bf_lo(v2.y); s2 += t * t; t = bf_hi(v2.y); s2 += t * t;
          t = bf_lo(v2.z); s2 += t * t; t = bf_hi(v2.z); s2 += t * t; t = bf_lo(v2.w); s2 += t * t; t = bf_hi(v2.w); s2 += t * t; }
        const float sq = wave_sum(lane < 48 ? s1 : 0.f, lane);
        const float skv = wave_sum((lane >= 48 ? s1 : 0.f) + s2, lane);
        if (lane == 0) { RQ[row] = 1.0f / sqrtf(sq * (1.f / 384.f) + EPS); RKV[row] = 1.0f / sqrtf(skv * (1.f / 256.f) + EPS); }
    }
    if (gw < 80) {
        const int b = gw / 5, h = gw % 5;
        const float* LF = (const float*)(a.ws + WS_LF) + ((size_t)b * SEQ + lane * 32) * 8 + h;
        float* Gp = (float*)(a.ws + WS_G) + (size_t)gw * SEQ + lane * 32;
        float v[32]; float run = 0.f;
#pragma unroll
        for (int i = 0; i < 32; ++i) { run += LF[i * 8]; v[i] = run; }
        float incl = run;
#pragma unroll
        for (int o = 1; o < 64; o <<= 1) { const float t = shfl_up_l(incl, o, lane); if (lane >= o) incl += t; }
        const float excl = incl - run;
#pragma unroll
        for (int i = 0; i < 32; ++i) Gp[i] = -(excl + v[i]) * LOG2E;
    }
}

__device__ __forceinline__ void phase_attn(const Args& a, int l, LAS unsigned char* lds, const int wv, const int bid) {
    const bf16_t* Z = (const bf16_t*)(a.ws + WS_Z);
    const bf16_t* QA = (const bf16_t*)(a.ws + WS_QA);
    const bf16_t* KVA = (const bf16_t*)(a.ws + WS_KVA);
    bf16_t* MIX = (bf16_t*)(a.ws + WS_H);
    const float* Gt = (const float*)(a.ws + WS_G);
    const int G = gridDim.x;
    for (int rnd = 0; ; ++rnd) {
        const int idx = rnd * G + ((rnd & 1) ? (G - 1 - bid) : bid);
        if (idx >= 2048) break;
        int mode, qb, bh; int r = idx;
        if (r < 5 * 176) { const int g = r / 176, w = r % 176; qb = 7 - g; if (w < 96) { mode = 0; bh = w; } else { mode = 2; bh = w - 96; } }
        else { r -= 5 * 176;
            if (r < 480) { mode = 1; qb = 2 + r / 80; bh = r % 80; }
            else { r -= 480;
                if (r < 96) { mode = 0; qb = 2; bh = r; } else if (r < 176) { mode = 2; qb = 2; bh = r - 96; }
                else if (r < 272) { mode = 0; qb = 1; bh = r - 176; } else if (r < 352) { mode = 1; qb = 1; bh = r - 272; }
                else if (r < 432) { mode = 2; qb = 1; bh = r - 352; } else if (r < 528) { mode = 0; qb = 0; bh = r - 432; }
                else if (r < 608) { mode = 2; qb = 0; bh = r - 528; } else { mode = 1; qb = 0; bh = r - 608; }
            }
        }
        att::AP P;
        if (mode == 0) {
            const int b = bh / 6, h = bh % 6; const size_t rb = (size_t)b * SEQ;
            P.Q = QA + rb * QAP + h * 96; P.qp = QAP;
            P.K = KVA + rb * QAP + h * 64; P.kp = QAP;
            P.K2 = Z + rb * NZ + ZC_KPE; P.k2p = NZ;
            P.V = KVA + rb * QAP + 384 + h * 64; P.vp = QAP;
            P.gate = Z + rb * NZ + ZC_GATE + h * 64; P.out = MIX + rb * DM + h * 64; P.kb = nullptr;
            att::attn_unit<0>(P, qb, lds, wv);
        } else if (mode == 1) {
            const int b = bh / 5, h = bh % 5; const size_t rb = (size_t)b * SEQ;
            P.Q = Z + rb * NZ + ZC_BQ + h * 64; P.qp = NZ;
            P.K = Z + rb * NZ + ZC_BK + h * 64; P.kp = NZ; P.K2 = nullptr; P.k2p = 0;
            P.V = Z + rb * NZ + ZC_BV + h * 64; P.vp = NZ;
            P.gate = Z + rb * NZ + ZC_GATE + 384 + h * 64; P.out = MIX + rb * DM + 384 + h * 64; P.kb = a.relb + ((size_t)l * 5 + h) * 257;
            att::attn_unit<1>(P, qb, lds, wv);
        } else {
            const int b = bh / 5, h = bh % 5; const size_t rb = (size_t)b * SEQ;
            P.Q = Z + rb * NZ + ZC_CQ2 + h * 64; P.qp = NZ;
            P.K = Z + rb * NZ + ZC_CK + h * 64; P.kp = NZ; P.K2 = nullptr; P.k2p = 0;
            P.V = Z + rb * NZ + ZC_CV + h * 64; P.vp = NZ;
            P.gate = Z + rb * NZ + ZC_GATE + 704 + h * 64; P.out = MIX + rb * DM + 704 + h * 64; P.kb = Gt + (size_t)bh * SEQ;
            att::attn_unit<2>(P, qb, lds, wv);
        }
    }
}

__device__ __forceinline__ void phase_final(const Args& a, const int wv, const int bid) {
    const int lane = lane_now(), wave = wv;
    const int gw = bid * 8 + wave, NGW = gridDim.x * 8;
    f32x4 G[4];
#pragma unroll
    for (int j = 0; j < 4; ++j) G[j] = *(const f32x4*)(a.final_g + 4 * lane + 256 * j);
    for (int row = gw; row < NTOK; row += NGW) {
        f32x4* xr = (f32x4*)(a.out + (size_t)row * DM) + lane;
        f32x4 v[4]; float s = 0.f;
#pragma unroll
        for (int j = 0; j < 4; ++j) { v[j] = xr[64 * j]; s += (v[j].x * v[j].x + v[j].y * v[j].y) + (v[j].z * v[j].z + v[j].w * v[j].w); }
        const float rstd = 1.0f / sqrtf(wave_sum(s, lane) * (1.f / DM) + EPS);
#pragma unroll
        for (int j = 0; j < 4; ++j) xr[64 * j] = v[j] * rstd * G[j];
    }
}

template <bool COOP>
__global__ void __launch_bounds__(512, 2) fwd(Args a0) {
    extern __shared__ __attribute__((aligned(16))) unsigned char lds_raw[];
    LAS unsigned char* lds = (LAS unsigned char*)lds_raw;
    const int wv = __builtin_amdgcn_readfirstlane(threadIdx.x >> 6);
    for (int ph = a0.ph_lo; ph < a0.ph_hi; ++ph) {
        if (ph > a0.ph_lo) { if constexpr (COOP) { cg::this_grid().sync(); } }
        int bid = blockIdx.x; asm volatile("" : "+s"(bid));
        Args a = a0; { unsigned char* w = a0.ws; asm volatile("" : "+s"(w)); a.ws = w; }
#ifndef ONLY
#define ONLY -1
#endif
#define EN(n) (ONLY < 0 || ONLY == (n))
        if (ph == 0) { if (EN(0)) phase0(a, lds, wv, bid); continue; }
        if (ph == NPHASE - 1) { if (EN(7)) phase_final(a, wv, bid); continue; }
        const int l = (ph - 1) / 6, sub = (ph - 1) % 6;
        const float* mod = (const float*)(a.ws + WS_MOD);
        if (sub == 0 && EN(1)) {
            phase_norm(a, l, l == 0 ? a.x : a.out, wv, bid);
        } else if (sub == 1 && EN(2)) {
            pg8::Gemm g{(const bf16_t*)(a.ws + WS_H), (const bf16_t*)(a.ws + WS_WIN) + (size_t)l * NZ * 1024, NTOK, NZ, 1024, 1024, 1024};
            pg8::StaticOrder S; S.init(NTOK, NZ, gridDim.x, bid);
            pg8::EpiZ E{(bf16_t*)(a.ws + WS_Z), (const float*)(a.ws + WS_CS), (float*)(a.ws + WS_LF), a.fgb + l * 5};
            pg8::gemm_phase<pg8::EpiZ>(lds, g, S, E, wv);
        } else if (sub == 2 && EN(3)) {
            phase_stats(a, wv, bid);
        } else if (sub == 3 && EN(4)) {
            {
                pg8::Gemm g{(const bf16_t*)(a.ws + WS_Z) + ZC_CQ, (const bf16_t*)(a.ws + WS_WUQ) + (size_t)l * 768 * 384, NTOK, 768, 384, NZ, 384};
                pg8::StaticOrder S; S.init(NTOK, 768, gridDim.x, bid);
                pg8::EpiQ E{(bf16_t*)(a.ws + WS_QA), (const float*)(a.ws + WS_CS), (const float*)(a.ws + WS_RQ)};
                pg8::gemm_phase<pg8::EpiQ>(lds, g, S, E, wv);
            }
            {
                pg8::Gemm g{(const bf16_t*)(a.ws + WS_Z) + ZC_CKV, (const bf16_t*)(a.ws + WS_WUKV) + (size_t)l * 768 * 256, NTOK, 768, 256, NZ, 256};
                pg8::StaticOrder S; S.init(NTOK, 768, gridDim.x, bid);
                pg8::EpiKV E{(bf16_t*)(a.ws + WS_KVA), (const float*)(a.ws + WS_RKV)};
                pg8::gemm_phase<pg8::EpiKV>(lds, g, S, E, wv);
            }
        } else if (sub == 4 && EN(5)) {
            phase_attn(a, l, lds, wv, bid);
        } else if (sub == 5 && EN(6)) {
            pg8::Gemm g{(const bf16_t*)(a.ws + WS_H), (const bf16_t*)(a.ws + WS_WOUT) + (size_t)l * 1024 * 1024, NTOK, 1024, 1024, 1024, 1024};
            pg8::StaticOrder S; S.init(NTOK, 1024, gridDim.x, bid);
            pg8::EpiOut E{l == 0 ? a.x : a.out, a.out, mod + (size_t)l * 16 * 3072 + 2048};
            pg8::gemm_phase<pg8::EpiOut>(lds, g, S, E, wv);
        }
    }
}

extern "C" void kernel_launch(void* const* d_in, const int* in_sizes, int n_in, void* d_out, int out_size, void* d_ws, size_t ws_size, hipStream_t stream) {
    static int grid = 0;
    if (grid == 0) {
        if (n_in != 15 || in_sizes[0] != NTOK * DM || out_size != NTOK * DM || ws_size < WS_END) { fprintf(stderr, "kernel_launch: unexpected shapes (n_in %d, ws %zu)\n", n_in, ws_size); grid = -1; return; }
        int dev = 0, cus = 0, per_cu = 0;
        hipGetDevice(&dev); hipDeviceGetAttribute(&cus, hipDeviceAttributeMultiprocessorCount, dev);
        hipFuncSetAttribute((const void*)fwd<true>, hipFuncAttributeMaxDynamicSharedMemorySize, LDS_BYTES);
        hipFuncSetAttribute((const void*)fwd<false>, hipFuncAttributeMaxDynamicSharedMemorySize, LDS_BYTES);
        hipOccupancyMaxActiveBlocksPerMultiprocessor(&per_cu, (const void*)fwd<true>, 512, LDS_BYTES);
        (void)hipGetLastError();
        if (per_cu < 1) fprintf(stderr, "kernel_launch: occupancy query reports %d blocks per CU\n", per_cu);
        grid = cus > 256 ? 256 : cus;
        if (grid != 256) fprintf(stderr, "kernel_launch: %d CUs; this kernel is laid out for 256\n", cus);
    }
    if (grid < 0) return;
    Args a{};
    a.x = (const float*)d_in[0]; a.c = (const float*)d_in[1]; a.pos = (const int*)d_in[2]; a.w_ada = (const float*)d_in[3]; a.b_ada = (const float*)d_in[4];
    a.norm_g = (const float*)d_in[5]; a.w_in = (const float*)d_in[6]; a.qng = (const float*)d_in[7]; a.w_uq = (const float*)d_in[8]; a.kvng = (const float*)d_in[9];
    a.w_ukv = (const float*)d_in[10]; a.relb = (const float*)d_in[11]; a.fgb = (const float*)d_in[12]; a.w_out = (const float*)d_in[13]; a.final_g = (const float*)d_in[14];
    a.out = (float*)d_out; a.ws = (unsigned char*)d_ws;
#if ONE_LAUNCH
    a.ph_lo = 0; a.ph_hi = NPHASE;
    void* args[] = {&a};
    hipError_t e = hipLaunchCooperativeKernel((const void*)fwd<true>, dim3(grid), dim3(512), args, LDS_BYTES, stream);
    if (e != hipSuccess) fprintf(stderr, "cooperative launch failed: %s\n", hipGetErrorString(e));
#else
    for (int ph = 0; ph < NPHASE; ++ph) {
        a.ph_lo = ph; a.ph_hi = ph + 1;
        hipLaunchKernelGGL(fwd<false>, dim3(grid), dim3(512), LDS_BYTES, stream, a);
    }
#endif
}
```

```cpp
#include <hip/hip_runtime.h>
#include <hip/hip_cooperative_groups.h>
#include <cstdio>
#include <cstdint>
namespace cg = cooperative_groups;

#ifndef ONE_LAUNCH
#define ONE_LAUNCH 1
#endif

#define LAS __attribute__((address_space(3)))
typedef unsigned short bf16_t;
typedef short bf16x8 __attribute__((ext_vector_type(8)));
typedef short s16x4 __attribute__((ext_vector_type(4)));
typedef float f32x2 __attribute__((ext_vector_type(2)));
typedef float f32x4 __attribute__((ext_vector_type(4)));
typedef float f32x16 __attribute__((ext_vector_type(16)));
typedef unsigned u32x2 __attribute__((ext_vector_type(2)));
typedef unsigned u32x4 __attribute__((ext_vector_type(4)));
typedef __bf16 bf16x2_t __attribute__((ext_vector_type(2)));

constexpr int DM = 1024, NB = 16, SEQ = 2048, NTOK = NB * SEQ;
constexpr int NIN = 3621, NZ = 3840, NZG = 3584;
constexpr int ZC_CQ = 0, ZC_CKV = 384, ZC_KPE = 640, ZC_GATE = 672, ZC_BQ = 1696, ZC_BK = 2016, ZC_BV = 2336, ZC_CQ2 = 2656, ZC_CK = 2976, ZC_CV = 3296, ZC_CF = 3616;
constexpr int QAP = 768;
constexpr float LOG2E = 1.4426950408889634f;
constexpr float EPS = 1e-6f;

constexpr size_t MiB = 1u << 20;
constexpr size_t WS_CTL = 0;
constexpr size_t WS_MOD = 1 * MiB;
constexpr size_t WS_CS = 2 * MiB;
constexpr size_t WS_RQ = 6 * MiB;
constexpr size_t WS_RKV = 6 * MiB + 256 * 1024;
constexpr size_t WS_LF = 7 * MiB;
constexpr size_t WS_G = 8 * MiB;
constexpr size_t WS_WIN = 10 * MiB;
constexpr size_t WS_WUQ = 25 * MiB;
constexpr size_t WS_WUKV = 26 * MiB + 512 * 1024;
constexpr size_t WS_W37 = 26 * MiB + 256 * 1024;
constexpr size_t WS_WOUT = 28 * MiB;
constexpr size_t WS_H = 32 * MiB;
constexpr size_t WS_QA = 96 * MiB;
constexpr size_t WS_KVA = 144 * MiB;
constexpr size_t WS_Z = 192 * MiB;
constexpr size_t WS_HN = 432 * MiB;
constexpr size_t WS_X = 9 * MiB;
constexpr size_t WS_END = 496 * MiB;

constexpr int LDS_BYTES = 147456;
constexpr int NPHASE = 10;

__device__ __forceinline__ unsigned cvtpk(float lo, float hi) { f32x2 v = {lo, hi}; bf16x2_t b = __builtin_convertvector(v, bf16x2_t); return __builtin_bit_cast(unsigned, b); }
__device__ __forceinline__ float bf_lo(unsigned u) { return __builtin_bit_cast(float, u << 16); }
__device__ __forceinline__ float bf_hi(unsigned u) { return __builtin_bit_cast(float, u & 0xffff0000u); }
__device__ __forceinline__ float shfl_xor_l(float v, int o, int lane) { return __builtin_bit_cast(float, __builtin_amdgcn_ds_bpermute((lane ^ o) << 2, __builtin_bit_cast(int, v))); }
__device__ __forceinline__ float shfl_up_l(float v, int o, int lane) { const int src = lane >= o ? lane - o : lane; return __builtin_bit_cast(float, __builtin_amdgcn_ds_bpermute(src << 2, __builtin_bit_cast(int, v))); }
__device__ __forceinline__ int lane_now() { int l; asm volatile("v_mbcnt_lo_u32_b32 %0, -1, 0\n\tv_mbcnt_hi_u32_b32 %0, -1, %0" : "=v"(l)); return l; }
__device__ __forceinline__ float wave_sum(float v, int lane) {
#pragma unroll
    for (int o = 1; o < 64; o <<= 1) v += shfl_xor_l(v, o, lane);
    return v;
}

namespace pg8 {
constexpr int BM = 256, BK = 64, HALF = 128, HTB = HALF * BK * 2, STAGE_BYTES = 8 * HTB, NXCD = 8, WGM = 8;
__device__ __forceinline__ int lds_byte(int r, int c) { return (r >> 3) * 1024 + (r & 7) * 128 + ((((c >> 3) ^ (r >> 1)) & 7) << 4) + (c & 7) * 2; }
__device__ __forceinline__ void stage_rc(int b, int& R, int& C) { const int st = b / 1024, sb = b % 1024; R = st * 8 + sb / 128; const int slot = (sb % 128) / 16; C = ((slot ^ (R >> 1)) & 7) * 8 + (sb % 16) / 2; }
__device__ __forceinline__ int perm32(int rho) { const int n = rho >> 4, i = rho & 15; return 8 * (i >> 2) + 4 * n + (i & 3); }

struct Unit { int pm, pn, kind; };
struct Gemm { const bf16_t* A; const bf16_t* Bt; int M, N, K, lda, ldb; };

struct StaticOrder {
    int nM, nN, nwg, G, c;
    __device__ void init(int M, int N, int G_, int c_) { nM = M / BM; nN = N / BM; nwg = nM * nN; G = G_; c = c_; }
    __device__ bool next(int i, Unit& u) const { const long L = (long)i * G + c; if (L >= nwg) return false; u.kind = 0; map((int)L, u); return true; }
    __device__ void map(int L, Unit& u) const {
        int wgid = L; { const int q = nwg / NXCD, r = nwg % NXCD, xcd = wgid % NXCD, off = wgid / NXCD; wgid = (xcd < r ? xcd * (q + 1) : r * (q + 1) + (xcd - r) * q) + off; }
        const int nig = WGM * nN, gid = wgid / nig, fm = gid * WGM, gsz = (nM - fm) < WGM ? (nM - fm) : WGM;
        u.pm = fm + ((wgid % nig) % gsz); u.pn = (wgid % nig) / gsz;
    }
};
struct Prob1 {
    Gemm g; StaticOrder S;
    __device__ bool next(int i, Unit& u) const { return S.next(i, u); }
    __device__ const char* a_tile(const Unit& u) const { return (const char*)g.A + (size_t)u.pm * BM * g.lda * 2; }
    __device__ const char* b_tile(const Unit& u) const { return (const char*)g.Bt + (size_t)u.pn * BM * g.ldb * 2; }
    __device__ int nt(const Unit&) const { return g.K / BK; }
    __device__ int lda() const { return g.lda; }
    __device__ int ldb() const { return g.ldb; }
};
struct Prob2 {
    Gemm g0, g1; StaticOrder S;
    __device__ bool next(int i, Unit& u) const { const long L = (long)i * S.G + S.c; if (L >= 2 * S.nwg) return false; u.kind = L >= S.nwg ? 1 : 0; S.map((int)(L - u.kind * S.nwg), u); return true; }
    __device__ const char* a_tile(const Unit& u) const { return (const char*)(u.kind ? g1.A : g0.A) + (size_t)u.pm * BM * g0.lda * 2; }
    __device__ const char* b_tile(const Unit& u) const { return (const char*)(u.kind ? g1.Bt : g0.Bt) + (size_t)u.pn * BM * g0.ldb * 2; }
    __device__ int nt(const Unit& u) const { return (u.kind ? g1.K : g0.K) / BK; }
    __device__ int lda() const { return g0.lda; }
    __device__ int ldb() const { return g0.ldb; }
};

template <class Epi, class Prob>
__device__ __forceinline__ void gemm_phase(LAS unsigned char* lds, const Prob& S, const Epi& E, const int wv) {
    const int lane = lane_now(), wid = wv, tid = wv * 64 + lane, wr = wid >> 2, wc = wid & 3, fr = lane & 15, fq = lane >> 4;
    unsigned voffA[2], voffB[2];
#pragma unroll
    for (int i = 0; i < 2; ++i) { int R, C; stage_rc(tid * 16 + i * 8192, R, C); const int Rb = Epi::PERM ? ((R & ~31) + perm32(R & 31)) : R;
        voffA[i] = (unsigned)(R * S.lda() + C) * 2u; voffB[i] = (unsigned)(Rb * S.ldb() + C) * 2u; }
    const size_t kstep = (size_t)(BK * 2);
    const size_t hstepA = (size_t)HALF * S.lda() * 2, hstepB = (size_t)HALF * S.ldb() * 2;
    const unsigned ldsw = (unsigned)wid * 1024u;
    const int aoff = lds_byte(wr * 64 + fr, fq * 8), boff = lds_byte(wc * 32 + fr, fq * 8);
#define PG8_SA(b, h) (((b) * 2 + (h)) * HTB)
#define PG8_SB(b, h) ((4 + (b) * 2 + (h)) * HTB)
#define PG8_STAGE(bufoff, gbase, voff) do { const char* _g = (const char*)(gbase); asm volatile("" : "+s"(_g)); _Pragma("unroll") for (int _i = 0; _i < 2; ++_i) \
        __builtin_amdgcn_global_load_lds((const unsigned*)(_g + (voff)[_i]), (LAS unsigned*)(lds + (bufoff) + ldsw + _i * 8192), 16, 0, 0); } while (0)
#define PG8_LDA(dst, b, h) do { _Pragma("unroll") for (int m = 0; m < 4; ++m) _Pragma("unroll") for (int k = 0; k < 2; ++k) dst[m][k] = *(const LAS bf16x8*)(lds + PG8_SA(b, h) + (k ? (aoff ^ 64) : aoff) + m * 2048); } while (0)
#define PG8_LDB(dst, b, h) do { _Pragma("unroll") for (int n = 0; n < 2; ++n) _Pragma("unroll") for (int k = 0; k < 2; ++k) dst[n][k] = *(const LAS bf16x8*)(lds + PG8_SB(b, h) + (k ? (boff ^ 64) : boff) + n * 2048); } while (0)
#define PG8_MMA(ai, bj, At, Bt) do { __builtin_amdgcn_s_setprio(1); _Pragma("unroll") for (int m = 0; m < 4; ++m) _Pragma("unroll") for (int n = 0; n < 2; ++n) _Pragma("unroll") for (int k = 0; k < 2; ++k) \
        acc[ai][bj][m][n] = __builtin_amdgcn_mfma_f32_16x16x32_bf16(Bt[n][k], At[m][k], acc[ai][bj][m][n], 0, 0, 0); __builtin_amdgcn_s_setprio(0); } while (0)
#define PG8_WAIT_V(n) asm volatile("s_waitcnt vmcnt(" #n ")" ::: "memory")
#define PG8_WAIT_L(n) asm volatile("s_waitcnt lgkmcnt(" #n ")" ::: "memory")
#define PG8_BAR __builtin_amdgcn_s_barrier()
#define PG8_SCHED __builtin_amdgcn_sched_barrier(0)
    Unit cur, nxt; int ui = 0;
    if (!S.next(0, cur)) return;
    f32x4 acc[2][2][4][2];
#pragma unroll
    for (int a = 0; a < 2; ++a)
#pragma unroll
        for (int b = 0; b < 2; ++b)
#pragma unroll
            for (int m = 0; m < 4; ++m)
#pragma unroll
                for (int n = 0; n < 2; ++n) acc[a][b][m][n] = (f32x4){0.f, 0.f, 0.f, 0.f};
    bf16x8 At[4][2], B0[2][2], B1[2][2];
    const char* cA = S.a_tile(cur); const char* cB = S.b_tile(cur);
    int nt = S.nt(cur);
    PG8_STAGE(PG8_SB(0, 0), cB, voffB); PG8_STAGE(PG8_SB(0, 1), cB + hstepB, voffB); PG8_STAGE(PG8_SA(0, 0), cA, voffA); PG8_STAGE(PG8_SA(0, 1), cA + hstepA, voffA);
    if (wr == 1) PG8_BAR;
    PG8_WAIT_V(2); PG8_BAR;
    PG8_STAGE(PG8_SB(1, 0), cB + kstep, voffB); PG8_STAGE(PG8_SA(1, 0), cA + kstep, voffA); PG8_STAGE(PG8_SB(1, 1), cB + hstepB + kstep, voffB);
    PG8_WAIT_V(6); PG8_BAR;
    for (;;) {
        const bool has_next = S.next(ui + 1, nxt);
        const char* nA = has_next ? S.a_tile(nxt) : cA; const char* nB = has_next ? S.b_tile(nxt) : cB;
        for (int t = 0; t < nt; t += 2) {
            const bool last = (t == nt - 2);
            const char* a1 = cA + (size_t)(t + 1) * kstep;
            const char* a2 = last ? nA : cA + (size_t)(t + 2) * kstep; const char* b2 = last ? nB : cB + (size_t)(t + 2) * kstep;
            const char* a3 = a2 + kstep; const char* b3 = b2 + kstep;
            PG8_LDB(B0, 0, 0); PG8_LDB(B1, 0, 1); PG8_SCHED; PG8_LDA(At, 0, 0); PG8_STAGE(PG8_SA(1, 1), a1 + hstepA, voffA);
            PG8_WAIT_V(8); PG8_WAIT_L(0); PG8_BAR; PG8_MMA(0, 0, At, B0); PG8_MMA(0, 1, At, B1); PG8_BAR; PG8_SCHED;
            PG8_LDA(At, 0, 1); PG8_STAGE(PG8_SB(0, 0), b2, voffB); PG8_STAGE(PG8_SB(0, 1), b2 + hstepB, voffB); PG8_STAGE(PG8_SA(0, 0), a2, voffA);
            PG8_WAIT_V(8); PG8_WAIT_L(0); PG8_BAR; PG8_MMA(1, 0, At, B0); PG8_MMA(1, 1, At, B1); PG8_BAR; PG8_SCHED;
            PG8_LDB(B0, 1, 0); PG8_LDB(B1, 1, 1); PG8_SCHED; PG8_LDA(At, 1, 0); PG8_STAGE(PG8_SA(0, 1), a2 + hstepA, voffA);
            PG8_WAIT_V(8); PG8_WAIT_L(0); PG8_BAR; PG8_MMA(0, 0, At, B0); PG8_MMA(0, 1, At, B1); PG8_BAR; PG8_SCHED;
            PG8_LDA(At, 1, 1); PG8_STAGE(PG8_SB(1, 0), b3, voffB); PG8_STAGE(PG8_SB(1, 1), b3 + hstepB, voffB); PG8_STAGE(PG8_SA(1, 0), a3, voffA);
            PG8_WAIT_V(8); PG8_WAIT_L(0); PG8_BAR; PG8_MMA(1, 0, At, B0); PG8_MMA(1, 1, At, B1); PG8_BAR; PG8_SCHED;
        }
        if (wr == 0) PG8_BAR;
        { const int le = lane_now();
          E(acc, cur, wid >> 2, wid & 3, le & 15, le >> 4); }
        if (!has_next) break;
#pragma unroll
        for (int a = 0; a < 2; ++a)
#pragma unroll
            for (int b = 0; b < 2; ++b)
#pragma unroll
                for (int m = 0; m < 4; ++m)
#pragma unroll
                    for (int n = 0; n < 2; ++n) acc[a][b][m][n] = (f32x4){0.f, 0.f, 0.f, 0.f};
        cur = nxt; cA = nA; cB = nB; ++ui; nt = S.nt(cur);
        if (wr == 1) PG8_BAR;
    }
    PG8_WAIT_V(0);
    PG8_BAR;
#undef PG8_SA
#undef PG8_SB
#undef PG8_STAGE
#undef PG8_LDA
#undef PG8_LDB
#undef PG8_MMA
#undef PG8_WAIT_V
#undef PG8_WAIT_L
#undef PG8_BAR
#undef PG8_SCHED
}

struct EpiZ {
    static constexpr bool PERM = true;
    bf16_t* Z; const float* cs; float* LF; const float* fb; float* ssq; LAS unsigned char* xl;
    __device__ __forceinline__ void operator()(const f32x4 (&acc)[2][2][4][2], const Unit& u, int wr, int wc, int fr, int fq) const {
        const int row0 = u.pm * BM + wr * 64 + fr;
        if (u.pn <= 2) {
            const int lane = fr + 16 * fq;
            LAS f32x2* Pp = (LAS f32x2*)xl;
#pragma unroll
            for (int ai = 0; ai < 2; ++ai)
#pragma unroll
                for (int m = 0; m < 4; ++m) {
                    float sq = 0.f, sk = 0.f;
#pragma unroll
                    for (int bj = 0; bj < 2; ++bj) {
                        const int colg = u.pn * BM + bj * HALF + wc * 32 + 8 * fq;
                        const f32x4 a = acc[ai][bj][m][0], b = acc[ai][bj][m][1];
                        const float t = (a[0] * a[0] + a[1] * a[1]) + (a[2] * a[2] + a[3] * a[3]) + (b[0] * b[0] + b[1] * b[1]) + (b[2] * b[2] + b[3] * b[3]);
                        if (colg < ZC_CKV) sq += t; else if (colg < ZC_KPE) sk += t;
                    }
                    sq += shfl_xor_l(sq, 16, lane); sq += shfl_xor_l(sq, 32, lane);
                    sk += shfl_xor_l(sk, 16, lane); sk += shfl_xor_l(sk, 32, lane);
                    if (fq == 0) Pp[(ai * HALF + wr * 64 + m * 16 + fr) * 4 + wc] = (f32x2){sq, sk};
                }
            asm volatile("s_waitcnt lgkmcnt(0)" ::: "memory"); __builtin_amdgcn_s_barrier(); asm volatile("" ::: "memory");
            const int tid = (wr * 4 + wc) * 64 + lane;
            if (tid < 256) {
                const f32x2 a = Pp[tid * 4 + 0], b = Pp[tid * 4 + 1], c = Pp[tid * 4 + 2], d = Pp[tid * 4 + 3];
                float* dst = ssq + (size_t)(u.pm * BM + tid) * 2;
                if (u.pn <= 1) __hip_atomic_fetch_add(dst, (a[0] + b[0]) + (c[0] + d[0]), __ATOMIC_RELAXED, __HIP_MEMORY_SCOPE_AGENT);
                if (u.pn >= 1) __hip_atomic_fetch_add(dst + 1, (a[1] + b[1]) + (c[1] + d[1]), __ATOMIC_RELAXED, __HIP_MEMORY_SCOPE_AGENT);
            }
            asm volatile("" ::: "memory");
        }
#pragma unroll
        for (int bj = 0; bj < 2; ++bj) {
            const int colg = u.pn * BM + bj * HALF + wc * 32 + 8 * fq;
            const int zc = colg + (colg >= ZC_KPE ? 32 : 0);
            const bool gatecol = (zc >= ZC_GATE && zc < ZC_BQ);
            const bool kvcol = (zc >= ZC_BK && zc < ZC_CQ2) || (zc >= ZC_CK);
#pragma unroll
            for (int ai = 0; ai < 2; ++ai)
#pragma unroll
                for (int m = 0; m < 4; ++m) {
                    const int row = row0 + ai * HALF + m * 16;
                    f32x4 v0 = acc[ai][bj][m][0], v1 = acc[ai][bj][m][1];
                    if (gatecol) {
#pragma unroll
                        for (int i = 0; i < 4; ++i) { v0[i] = v0[i] * __builtin_amdgcn_rcpf(1.f + __builtin_amdgcn_exp2f(-LOG2E * v0[i])); v1[i] = v1[i] * __builtin_amdgcn_rcpf(1.f + __builtin_amdgcn_exp2f(-LOG2E * v1[i])); }
                    }
                    u32x4 w; w.x = cvtpk(v0[0], v0[1]); w.y = cvtpk(v0[2], v0[3]); w.z = cvtpk(v1[0], v1[1]); w.w = cvtpk(v1[2], v1[3]);
                    if (kvcol) *(u32x4*)(Z + (size_t)row * NZ + zc) = w; else __builtin_nontemporal_store(w, (u32x4*)(Z + (size_t)row * NZ + zc));
                    if (m == 3) asm volatile("" ::: "memory");
                }
        }
    }
};
struct EpiQ {
    static constexpr bool PERM = true;
    bf16_t* O; const float* cs; const float* rs;
    __device__ __forceinline__ void operator()(const f32x4 (&acc)[2][2][4][2], const Unit& u, int wr, int wc, int fr, int fq) const {
        const int row0 = u.pm * BM + wr * 64 + fr;
        float rr[8];
#pragma unroll
        for (int j = 0; j < 8; ++j) rr[j] = rs[(size_t)(row0 + (j >> 2) * HALF + (j & 3) * 16) * 2];
#pragma unroll
        for (int j = 0; j < 8; ++j) rr[j] = __builtin_amdgcn_rsqf(rr[j] * (1.f / 384.f) + EPS);
#pragma unroll
        for (int bj = 0; bj < 2; ++bj) {
            const int colg = u.pn * BM + bj * HALF + wc * 32 + 8 * fq;
            if (colg >= 576) continue;
            const int hd = colg % 96;
            const bool rope = hd >= 64;
            const int i0 = rope ? ((hd - 64) >> 1) : 0;
#pragma unroll
            for (int ai = 0; ai < 2; ++ai) {
                f32x4 co[4], si[4];
                if (rope) {
#pragma unroll
                    for (int m = 0; m < 4; ++m) { const size_t row = (size_t)(row0 + ai * HALF + m * 16); co[m] = *(const f32x4*)(cs + row * 32 + i0); si[m] = *(const f32x4*)(cs + row * 32 + 16 + i0); }
                }
#pragma unroll
                for (int m = 0; m < 4; ++m) {
                    const int row = row0 + ai * HALF + m * 16;
                    const float r = rr[ai * 4 + m];
                    f32x4 v0 = acc[ai][bj][m][0] * r, v1 = acc[ai][bj][m][1] * r;
                    if (rope) {
                        f32x4 a, b;
                        a[0] = v0[0] * co[m][0] - v0[1] * si[m][0]; a[1] = v0[0] * si[m][0] + v0[1] * co[m][0];
                        a[2] = v0[2] * co[m][1] - v0[3] * si[m][1]; a[3] = v0[2] * si[m][1] + v0[3] * co[m][1];
                        b[0] = v1[0] * co[m][2] - v1[1] * si[m][2]; b[1] = v1[0] * si[m][2] + v1[1] * co[m][2];
                        b[2] = v1[2] * co[m][3] - v1[3] * si[m][3]; b[3] = v1[2] * si[m][3] + v1[3] * co[m][3];
                        v0 = a; v1 = b;
                    }
                    u32x4 w; w.x = cvtpk(v0[0], v0[1]); w.y = cvtpk(v0[2], v0[3]); w.z = cvtpk(v1[0], v1[1]); w.w = cvtpk(v1[2], v1[3]);
                    *(u32x4*)(O + (size_t)row * QAP + colg) = w;
                }
                asm volatile("" ::: "memory");
            }
        }
    }
};
struct EpiKV {
    static constexpr bool PERM = true;
    bf16_t* O; const float* rs;
    __device__ __forceinline__ void operator()(const f32x4 (&acc)[2][2][4][2], const Unit& u, int wr, int wc, int fr, int fq) const {
        const int row0 = u.pm * BM + wr * 64 + fr;
        float rr[8];
#pragma unroll
        for (int j = 0; j < 8; ++j) rr[j] = rs[(size_t)(row0 + (j >> 2) * HALF + (j & 3) * 16) * 2 + 1];
#pragma unroll
        for (int j = 0; j < 8; ++j) rr[j] = __builtin_amdgcn_rsqf(rr[j] * (1.f / 256.f) + EPS);
#pragma unroll
        for (int bj = 0; bj < 2; ++bj) {
            const int colg = u.pn * BM + bj * HALF + wc * 32 + 8 * fq;
#pragma unroll
            for (int ai = 0; ai < 2; ++ai)
#pragma unroll
                for (int m = 0; m < 4; ++m) {
                    const int row = row0 + ai * HALF + m * 16;
                    const float r = rr[ai * 4 + m];
                    const f32x4 v0 = acc[ai][bj][m][0] * r, v1 = acc[ai][bj][m][1] * r;
                    u32x4 w; w.x = cvtpk(v0[0], v0[1]); w.y = cvtpk(v0[2], v0[3]); w.z = cvtpk(v1[0], v1[1]); w.w = cvtpk(v1[2], v1[3]);
                    *(u32x4*)(O + (size_t)row * QAP + colg) = w;
                    asm volatile("" ::: "memory");
                }
        }
    }
};
struct EpiUp {
    static constexpr bool PERM = true;
    EpiQ q; EpiKV kv;
    __device__ __forceinline__ void operator()(const f32x4 (&acc)[2][2][4][2], const Unit& u, int wr, int wc, int fr, int fq) const { if (u.kind == 0) q(acc, u, wr, wc, fr, fq); else kv(acc, u, wr, wc, fr, fq); }
};
struct EpiOut {
    static constexpr bool PERM = true;
    const float* xold; float* xnew; const float* gate;
    __device__ __forceinline__ void operator()(const f32x4 (&acc)[2][2][4][2], const Unit& u, int wr, int wc, int fr, int fq) const {
        const int row0 = u.pm * BM + wr * 64 + fr;
        const int b = (u.pm * BM) / SEQ;
#pragma unroll
        for (int bj = 0; bj < 2; ++bj) {
            const int colg = u.pn * BM + bj * HALF + wc * 32 + 8 * fq;
            const f32x4 g0 = *(const f32x4*)(gate + (size_t)b * 3072 + colg), g1 = *(const f32x4*)(gate + (size_t)b * 3072 + colg + 4);
#pragma unroll
            for (int ai = 0; ai < 2; ++ai)
#pragma unroll
                for (int m = 0; m < 4; ++m) {
                    const int row = row0 + ai * HALF + m * 16;
                    const size_t off = (size_t)row * DM + colg;
                    const f32x4 x0 = *(const f32x4*)(xold + off), x1 = *(const f32x4*)(xold + off + 4);
                    *(f32x4*)(xnew + off) = x0 + g0 * acc[ai][bj][m][0];
                    *(f32x4*)(xnew + off + 4) = x1 + g1 * acc[ai][bj][m][1];
                    if (m & 1) asm volatile("" ::: "memory");
                }
        }
    }
};

template <bool LAST>
struct EpiOutN {
    static constexpr bool PERM = true;
    const float* xold; float* xnew; const float* gate; const float* ng; const float* modn; bf16_t* H; float* ssq;
    float* xbuf; unsigned* cnt; LAS unsigned char* xl;
    __device__ __forceinline__ void operator()(f32x4 (&acc)[2][2][4][2], const Unit& u, int wr, int wc, int fr, int fq) const {
        const int lane = fr + 16 * fq, wid = wr * 4 + wc;
        const int row0 = u.pm * BM + wr * 64 + fr;
        const int b = (u.pm * BM) / SEQ;
        LAS float* Pp = (LAS float*)xl;
        LAS float* Sp = (LAS float*)(xl + 4096);
        volatile LAS unsigned* flag = (volatile LAS unsigned*)(xl + 5120);
#pragma unroll
        for (int bj = 0; bj < 2; ++bj) {
            const int colg = u.pn * BM + bj * HALF + wc * 32 + 8 * fq;
            const f32x4 g0 = *(const f32x4*)(gate + (size_t)b * 3072 + colg), g1 = *(const f32x4*)(gate + (size_t)b * 3072 + colg + 4);
#pragma unroll
            for (int ai = 0; ai < 2; ++ai) {
                f32x4 x0[4], x1[4];
#pragma unroll
                for (int m = 0; m < 4; ++m) {
                    const size_t r = (size_t)(row0 + ai * HALF + m * 16);
                    if (LAST) {
                        const u32x4 xb = __builtin_nontemporal_load((const u32x4*)((const bf16_t*)xold + r * (2 * DM) + colg));
                        x0[m] = (f32x4){bf_lo(xb.x), bf_hi(xb.x), bf_lo(xb.y), bf_hi(xb.y)}; x1[m] = (f32x4){bf_lo(xb.z), bf_hi(xb.z), bf_lo(xb.w), bf_hi(xb.w)};
                    } else { x0[m] = __builtin_nontemporal_load((const f32x4*)(xold + r * DM + colg)); x1[m] = __builtin_nontemporal_load((const f32x4*)(xold + r * DM + colg + 4)); }
                }
#pragma unroll
                for (int m = 0; m < 4; ++m) {
                    acc[ai][bj][m][0] = x0[m] + g0 * acc[ai][bj][m][0];
                    acc[ai][bj][m][1] = x1[m] + g1 * acc[ai][bj][m][1];
                    asm volatile("" : "+v"(acc[ai][bj][m][0]), "+v"(acc[ai][bj][m][1]));
                }
                asm volatile("" ::: "memory");
            }
        }
#pragma unroll
        for (int ai = 0; ai < 2; ++ai)
#pragma unroll
            for (int m = 0; m < 4; ++m) {
                float t = 0.f;
#pragma unroll
                for (int bj = 0; bj < 2; ++bj) { const f32x4 p = acc[ai][bj][m][0], q = acc[ai][bj][m][1];
                    t += (p[0] * p[0] + p[1] * p[1]) + (p[2] * p[2] + p[3] * p[3]) + (q[0] * q[0] + q[1] * q[1]) + (q[2] * q[2] + q[3] * q[3]); }
                t += shfl_xor_l(t, 16, lane); t += shfl_xor_l(t, 32, lane);
                if (fq == 0) Pp[(ai * HALF + wr * 64 + m * 16 + fr) * 4 + wc] = t;
            }
        asm volatile("s_waitcnt lgkmcnt(0)" ::: "memory"); __builtin_amdgcn_s_barrier(); asm volatile("" ::: "memory");
        const int row = wid * 32 + (lane & 31);
        if (lane < 32) {
            const f32x4 p = *(const LAS f32x4*)(Pp + row * 4);
            __hip_atomic_store(xbuf + (size_t)(u.pm * BM + row) * 4 + u.pn, (p[0] + p[1]) + (p[2] + p[3]), __ATOMIC_RELAXED, __HIP_MEMORY_SCOPE_AGENT);
        }
        asm volatile("s_waitcnt vmcnt(0)" ::: "memory");
        if (lane == 0) __hip_atomic_fetch_add(cnt + 64 * u.pm, 1u, __ATOMIC_RELAXED, __HIP_MEMORY_SCOPE_AGENT);
        if (!LAST) {
#pragma unroll
            for (int bj = 0; bj < 2; ++bj) {
                const int colg = u.pn * BM + bj * HALF + wc * 32 + 8 * fq;
#pragma unroll
                for (int ai = 0; ai < 2; ++ai)
#pragma unroll
                    for (int m = 0; m < 4; ++m) {
                        const int rt = ai * HALF + wr * 64 + m * 16 + fr;
                        const f32x4 v0 = acc[ai][bj][m][0], v1 = acc[ai][bj][m][1];
                        u32x4 xw; xw.x = cvtpk(v0[0], v0[1]); xw.y = cvtpk(v0[2], v0[3]); xw.z = cvtpk(v1[0], v1[1]); xw.w = cvtpk(v1[2], v1[3]);
                        *(u32x4*)((bf16_t*)xnew + (size_t)(u.pm * BM + rt) * (2 * DM) + colg) = xw;
                        if (m & 1) asm volatile("" ::: "memory");
                    }
            }
        }
        if (wid == 0) {
            bool dead = false; unsigned spins = 0u;
            for (;;) {
                if ((unsigned)__builtin_amdgcn_readfirstlane(__hip_atomic_load(cnt + 64 * u.pm, __ATOMIC_RELAXED, __HIP_MEMORY_SCOPE_AGENT)) >= 32u) break;
                if (++spins > (1u << 22)) { dead = true; break; }
                __builtin_amdgcn_s_sleep(2);
            }
            __builtin_amdgcn_fence(__ATOMIC_ACQUIRE, "agent");
            if (lane == 0) flag[0] = dead ? 1u : 0u;
        }
        asm volatile("s_waitcnt vmcnt(0) lgkmcnt(0)" ::: "memory"); __builtin_amdgcn_s_barrier(); asm volatile("" ::: "memory");
        const bool bad = flag[0] != 0u;
        if (lane < 32) {
            const float* slot = xbuf + (size_t)(u.pm * BM + row) * 4;
            float t = 0.f;
#pragma unroll
            for (int k = 0; k < 4; ++k) t += __hip_atomic_load(slot + k, __ATOMIC_RELAXED, __HIP_MEMORY_SCOPE_AGENT);
            Sp[row] = 1.0f / sqrtf(t * (1.f / DM) + EPS);
            if (!LAST && u.pn == 0) *(f32x2*)(ssq + (size_t)(u.pm * BM + row) * 2) = (f32x2){0.f, 0.f};
        }
        asm volatile("s_waitcnt vmcnt(0) lgkmcnt(0)" ::: "memory"); __builtin_amdgcn_s_barrier(); asm volatile("" ::: "memory");
        const float qnan = __builtin_nanf("");
#pragma unroll
        for (int bj = 0; bj < 2; ++bj) {
            const int colg = u.pn * BM + bj * HALF + wc * 32 + 8 * fq;
            f32x4 G0, G1, S0, S1;
            if (LAST) { G0 = *(const f32x4*)(ng + colg); G1 = *(const f32x4*)(ng + colg + 4); S0 = (f32x4){0.f, 0.f, 0.f, 0.f}; S1 = S0; }
            else {
                const float* mb = modn + (size_t)b * 3072;
                G0 = *(const f32x4*)(ng + colg) * (*(const f32x4*)(mb + 1024 + colg) + 1.0f); G1 = *(const f32x4*)(ng + colg + 4) * (*(const f32x4*)(mb + 1024 + colg + 4) + 1.0f);
                S0 = *(const f32x4*)(mb + colg); S1 = *(const f32x4*)(mb + colg + 4);
            }
#pragma unroll
            for (int ai = 0; ai < 2; ++ai)
#pragma unroll
                for (int m = 0; m < 4; ++m) {
                    const int rt = ai * HALF + wr * 64 + m * 16 + fr;
                    const float rs = Sp[rt];
                    const size_t off = (size_t)(u.pm * BM + rt) * DM + colg;
                    f32x4 v0 = acc[ai][bj][m][0], v1 = acc[ai][bj][m][1];
                    if (bad) { v0 = (f32x4){qnan, qnan, qnan, qnan}; v1 = v0; }
                    if (LAST) {
                        *(f32x4*)(xnew + off) = v0 * rs * G0; *(f32x4*)(xnew + off + 4) = v1 * rs * G1;
                    } else {
                        const f32x4 h0 = v0 * rs * G0 + S0, h1 = v1 * rs * G1 + S1;
                        u32x4 w; w.x = cvtpk(h0[0], h0[1]); w.y = cvtpk(h0[2], h0[3]); w.z = cvtpk(h1[0], h1[1]); w.w = cvtpk(h1[2], h1[3]);
                        *(u32x4*)(H + off) = w;
                    }
                    if (m & 1) asm volatile("" ::: "memory");
                }
        }
    }
};
}

namespace att {
constexpr int KSLOT = 12288, VSLOT = 8192, NSLOT = 4;
constexpr int L_K = 0, L_V = NSLOT * KSLOT, L_WS = L_V + NSLOT * VSLOT, L_OST = L_WS + 2048, L_TB = L_OST + 8 * 4096, L_GB = L_TB + 2048, L_END = L_GB + NSLOT * 8 * 256;
static_assert(L_END <= 131072, "attention LDS map");
constexpr float NEG = -1e30f;
constexpr float THR = 8.0f;

struct AP { const bf16_t* Q; int qp; const bf16_t* K; int kp; const bf16_t* K2; int k2p; const bf16_t* V; int vp; const bf16_t* gate; bf16_t* out; const float* kb; unsigned* ctr; };
constexpr int L_NEXT = 131072 + 128;

#define ATT_WAIT_V(n) asm volatile("s_waitcnt vmcnt(" #n ")" ::: "memory")

template <int MODE>
__device__ __forceinline__ void attn_unit(const AP P, const int qb, LAS unsigned char* lds, const int wv) {
    constexpr int DQK = (MODE == 0) ? 96 : 64, NQ = DQK / 16;
    constexpr int PG = (MODE == 1) ? 2 : 3;
    const int lane = lane_now(), r32 = lane & 31, hi = lane >> 5;
    const int wid = wv, tid = wv * 64 + lane;
    const int q0 = qb * 256;
    const int cw = 4 * qb + (wid >> 1);
    int t0 = 0; const int t1 = 4 * qb + 4;
    if (MODE == 1) t0 = (4 * qb - 8) > 0 ? (4 * qb - 8) : 0;
    const int qrel = 32 * (wid & 1) + r32;
    const bf16_t* ksrc = P.K + (size_t)lane * P.kp + wid * 8;
    const bf16_t* k2src = (MODE == 0) ? (P.K2 + (size_t)lane * P.k2p + (wid & 3) * 8) : nullptr;
    const bf16_t* vsrc = P.V + (size_t)(16 * (wid & 3) + (lane >> 2)) * P.vp + (wid >> 2) * 32 + (lane & 3) * 8;
    const float* gsrc = (MODE == 2) ? (P.kb + lane) : nullptr;
#define ATT_DMA_K(t) do { const int sl_ = ((t) - t0) & (NSLOT - 1); \
        __builtin_amdgcn_global_load_lds((const unsigned*)(ksrc + (size_t)(t) * 64 * P.kp), (LAS unsigned*)(lds + L_K + sl_ * KSLOT + wid * 1024), 16, 0, 0); \
        if (MODE == 0) __builtin_amdgcn_global_load_lds((const unsigned*)(k2src + (size_t)(t) * 64 * P.k2p), (LAS unsigned*)(lds + L_K + sl_ * KSLOT + 8192 + (wid & 3) * 1024), 16, 0, 0); } while (0)
#define ATT_DMA_V(t) do { const int sl_ = ((t) - t0) & (NSLOT - 1); \
        __builtin_amdgcn_global_load_lds((const unsigned*)(vsrc + (size_t)(t) * 64 * P.vp), (LAS unsigned*)(lds + L_V + sl_ * VSLOT + wid * 1024), 16, 0, 0); \
        if (MODE == 2) __builtin_amdgcn_global_load_lds((const unsigned*)(gsrc + (t) * 64), (LAS unsigned*)(lds + L_GB + (sl_ * 8 + wid) * 256), 4, 0, 0); } while (0)
#define ATT_VALID(t) (((t) <= cw) && (MODE != 1 || (t) >= cw - 8))
    ATT_DMA_K(t0); ATT_DMA_K(t0 + 1); ATT_DMA_K(t0 + 2); ATT_DMA_K(t0 + 3); ATT_DMA_V(t0); ATT_DMA_V(t0 + 1);
    bf16x8 qr[NQ];
    {
        const bf16_t* Qw = P.Q + (size_t)(q0 + wid * 32 + r32) * P.qp + hi * 8;
#pragma unroll
        for (int d0 = 0; d0 < NQ; ++d0) qr[d0] = *(const bf16x8*)(Qw + d0 * 16);
    }
    if (MODE == 1) { LAS float* tb = (LAS float*)(lds + L_TB); for (int i = tid; i < 257; i += 512) tb[i] = P.kb[i] * LOG2E; }
    float m_run = NEG, l_run = 0.f;
    f32x16 o0, o1;
#pragma unroll
    for (int r = 0; r < 16; ++r) { o0[r] = 0.f; o1[r] = 0.f; }
    LAS float* wsf = (LAS float*)(lds + L_WS) + wid * 64;
    const int vboff = ((lane >> 4) & 1) * 32 + (lane & 3) * 8 + (4 * hi + ((lane & 15) >> 2)) * 64;
    const LAS unsigned char* kbase = lds + L_K + hi * 1024 + r32 * 16;
    bf16x8 kf[2 * NQ];
    f32x16 sc0, sc1;
#define ATT_KLOAD(t) do { const LAS unsigned char* kp_ = kbase + (((t) - t0) & (NSLOT - 1)) * KSLOT; \
        _Pragma("unroll") for (int d0 = 0; d0 < NQ; ++d0) { kf[2 * d0] = *(const LAS bf16x8*)(kp_ + d0 * 2048); kf[2 * d0 + 1] = *(const LAS bf16x8*)(kp_ + d0 * 2048 + 512); } } while (0)
#define ATT_QK(d0_, d1_) do { _Pragma("unroll") for (int r = 0; r < 16; ++r) { d0_[r] = 0.f; d1_[r] = 0.f; } \
        _Pragma("unroll") for (int d0 = 0; d0 < NQ; ++d0) { d0_ = __builtin_amdgcn_mfma_f32_32x32x16_bf16(kf[2 * d0], qr[d0], d0_, 0, 0, 0); d1_ = __builtin_amdgcn_mfma_f32_32x32x16_bf16(kf[2 * d0 + 1], qr[d0], d1_, 0, 0, 0); } } while (0)
    ATT_WAIT_V(0);
    asm volatile("s_waitcnt lgkmcnt(0)" ::: "memory");
    __builtin_amdgcn_s_barrier();
    asm volatile("" ::: "memory");
    ATT_KLOAD(t0);
    ATT_QK(sc0, sc1);
    ATT_KLOAD(t0 + 1);
    for (int t = t0; t < t1; ++t) {
        const int cur = (t - t0) & (NSLOT - 1);
        {
            if (t + 3 < t1) { if (PG == 2) ATT_WAIT_V(2); else ATT_WAIT_V(3); } else ATT_WAIT_V(0);
            asm volatile("s_waitcnt lgkmcnt(0)" ::: "memory");
            __builtin_amdgcn_s_barrier();
            asm volatile("" ::: "memory");
        }
        if (t + 4 < t1) ATT_DMA_K(t + 4);
        if (t + 2 < t1) ATT_DMA_V(t + 2);
        const bool vcur = ATT_VALID(t), vnext = (t + 1 < t1) && ATT_VALID(t + 1);
        f32x16 sn0, sn1;
        if (vnext) ATT_QK(sn0, sn1);
        if (t + 2 < t1) ATT_KLOAD(t + 2);
        if (vcur) {
            f32x16 p0 = sc0, p1 = sc1;
            if (MODE == 2) {
                const LAS float* gp = (const LAS float*)(lds + L_GB + (cur * 8 + wid) * 256) + 4 * hi;
#pragma unroll
                for (int g4 = 0; g4 < 4; ++g4) {
                    const f32x4 a = *(const LAS f32x4*)(gp + 8 * g4), b = *(const LAS f32x4*)(gp + 32 + 8 * g4);
#pragma unroll
                    for (int i = 0; i < 4; ++i) { p0[4 * g4 + i] += a[i]; p1[4 * g4 + i] += b[i]; }
                }
                if (t == cw) {
#pragma unroll
                    for (int r = 0; r < 16; ++r) { const int kj = (r & 3) + 8 * (r >> 2) + 4 * hi; if (kj > qrel) p0[r] = NEG; if (kj + 32 > qrel) p1[r] = NEG; }
                }
            }
            if (MODE == 1) {
                const LAS float* tb = (const LAS float*)(lds + L_TB);
                const int mm = cw - t;
                if (mm >= 3) {
                    const float c = tb[256];
#pragma unroll
                    for (int r = 0; r < 16; ++r) { p0[r] += c; p1[r] += c; }
                } else {
                    const int base = 64 * mm + qrel - 4 * hi;
#pragma unroll
                    for (int r = 0; r < 16; ++r) {
                        const int c0 = (r & 3) + 8 * (r >> 2);
                        int i0 = base - c0; i0 = (i0 > 128 ? 128 : i0) + 128;
                        int i1 = base - c0 - 32; i1 = (i1 > 128 ? 128 : i1) + 128;
                        p0[r] += tb[i0]; p1[r] += tb[i1];
                    }
                }
            }
            float rm = fmaxf(p0[0], p1[0]);
#pragma unroll
            for (int r = 1; r < 16; ++r) rm = fmaxf(rm, fmaxf(p0[r], p1[r]));
            rm = fmaxf(rm, shfl_xor_l(rm, 32, lane));
            if (__any(rm > m_run + THR)) {
                const float mn = fmaxf(m_run, rm);
                const float f = __builtin_amdgcn_exp2f(m_run - mn);
                m_run = mn; l_run *= f;
                if (hi == 0) wsf[r32] = f;
                asm volatile("" ::: "memory");
#pragma unroll
                for (int g4 = 0; g4 < 4; ++g4) {
                    const f32x4 fv = *(const LAS f32x4*)(wsf + 8 * g4 + 4 * hi);
#pragma unroll
                    for (int i = 0; i < 4; ++i) { o0[4 * g4 + i] *= fv[i]; o1[4 * g4 + i] *= fv[i]; }
                }
            }
            float s = 0.f;
#pragma unroll
            for (int r = 0; r < 16; ++r) { p0[r] = __builtin_amdgcn_exp2f(p0[r] - m_run); p1[r] = __builtin_amdgcn_exp2f(p1[r] - m_run); s += p0[r] + p1[r]; }
            l_run += s;
            u32x4 pw[4];
            pw[0] = (u32x4){cvtpk(p0[0], p0[1]), cvtpk(p0[2], p0[3]), cvtpk(p0[4], p0[5]), cvtpk(p0[6], p0[7])};
            pw[1] = (u32x4){cvtpk(p0[8], p0[9]), cvtpk(p0[10], p0[11]), cvtpk(p0[12], p0[13]), cvtpk(p0[14], p0[15])};
            pw[2] = (u32x4){cvtpk(p1[0], p1[1]), cvtpk(p1[2], p1[3]), cvtpk(p1[4], p1[5]), cvtpk(p1[6], p1[7])};
            pw[3] = (u32x4){cvtpk(p1[8], p1[9]), cvtpk(p1[10], p1[11]), cvtpk(p1[12], p1[13]), cvtpk(p1[14], p1[15])};
            const unsigned vb = (unsigned)(uintptr_t)(lds + L_V + cur * VSLOT + vboff);
#pragma unroll
            for (int d0 = 0; d0 < 2; ++d0) {
                s16x4 lo[4], hh[4];
#pragma unroll
                for (int ks = 0; ks < 4; ++ks) {
                    asm volatile("ds_read_b64_tr_b16 %0, %1 offset:%c2" : "=&v"(lo[ks]) : "v"(vb), "i"(d0 * 4096 + ks * 1024) : "memory");
                    asm volatile("ds_read_b64_tr_b16 %0, %1 offset:%c2" : "=&v"(hh[ks]) : "v"(vb), "i"(d0 * 4096 + ks * 1024 + 512) : "memory");
                }
                asm volatile("s_waitcnt lgkmcnt(0)" ::: "memory"); __builtin_amdgcn_sched_barrier(0);
#pragma unroll
                for (int ks = 0; ks < 4; ++ks) {
                    const bf16x8 pa = __builtin_bit_cast(bf16x8, pw[ks]);
                    const bf16x8 vf = {lo[ks][0], lo[ks][1], lo[ks][2], lo[ks][3], hh[ks][0], hh[ks][1], hh[ks][2], hh[ks][3]};
                    if (d0 == 0) o0 = __builtin_amdgcn_mfma_f32_32x32x16_bf16(pa, vf, o0, 0, 0, 0);
                    else o1 = __builtin_amdgcn_mfma_f32_32x32x16_bf16(pa, vf, o1, 0, 0, 0);
                }
            }
        }
        if (vnext) { sc0 = sn0; sc1 = sn1; }
    }
    unsigned nxt_unit = 0u;
    if (tid == 0) nxt_unit = __hip_atomic_fetch_add(P.ctr, 1u, __ATOMIC_RELAXED, __HIP_MEMORY_SCOPE_AGENT);
    l_run += shfl_xor_l(l_run, 32, lane);
    if (hi == 0) wsf[32 + r32] = l_run;
    asm volatile("" ::: "memory");
    float rli[16];
#pragma unroll
    for (int g4 = 0; g4 < 4; ++g4) {
        const f32x4 lv = *(const LAS f32x4*)(wsf + 32 + 8 * g4 + 4 * hi);
#pragma unroll
        for (int i = 0; i < 4; ++i) rli[4 * g4 + i] = 1.0f / lv[i];
    }
    LAS bf16_t* stg = (LAS bf16_t*)(lds + L_OST) + wid * 2048;
#pragma unroll
    for (int r = 0; r < 16; ++r) {
        const int orow = (r & 3) + 8 * (r >> 2) + 4 * hi;
        stg[orow * 64 + r32] = (bf16_t)(cvtpk(o0[r] * rli[r], 0.f) & 0xffffu);
        stg[orow * 64 + 32 + r32] = (bf16_t)(cvtpk(o1[r] * rli[r], 0.f) & 0xffffu);
    }
    asm volatile("" ::: "memory");
#pragma unroll
    for (int i = 0; i < 4; ++i) {
        const int row = i * 8 + (lane >> 3), ch = lane & 7;
        const u32x4 v = *(const LAS u32x4*)(stg + row * 64 + ch * 8);
        const size_t grow = (size_t)(q0 + wid * 32 + row);
        const u32x4 gt = *(const u32x4*)(P.gate + grow * NZ + ch * 8);
        u32x4 w;
        w.x = cvtpk(bf_lo(v.x) * bf_lo(gt.x), bf_hi(v.x) * bf_hi(gt.x));
        w.y = cvtpk(bf_lo(v.y) * bf_lo(gt.y), bf_hi(v.y) * bf_hi(gt.y));
        w.z = cvtpk(bf_lo(v.z) * bf_lo(gt.z), bf_hi(v.z) * bf_hi(gt.z));
        w.w = cvtpk(bf_lo(v.w) * bf_lo(gt.w), bf_hi(v.w) * bf_hi(gt.w));
        *(u32x4*)(P.out + grow * DM + ch * 8) = w;
    }
    if (tid == 0) *(volatile LAS unsigned*)(lds + L_NEXT) = nxt_unit;
    __syncthreads();
#undef ATT_DMA_K
#undef ATT_DMA_V
#undef ATT_VALID
#undef ATT_KLOAD
#undef ATT_QK
}
}


namespace fa {
constexpr int NW = 8, QBLK = 32, KVBLK = 64;
constexpr int NSLOT = 3, SLOTB = 8192;
template <int MODE> struct Map {
    static constexpr int KSLOT = (MODE == 0) ? 12288 : 8192;
    static constexpr int LDS_K = 0, LDS_V = NSLOT * KSLOT, LDS_WS = LDS_V + NSLOT * SLOTB, LDS_OST = LDS_WS + NW * 64 * 4, LDS_TB = LDS_OST + NW * 4096, LDS_G = LDS_TB + 2048, LDS_END = LDS_G + 8192;
    static_assert(LDS_END <= 131072, "fast attention LDS map");
};
typedef LAS const unsigned char* lds_cptr;
#define SBAR() __builtin_amdgcn_sched_barrier(0)
__device__ __forceinline__ int crow(int r, int hi) { return (r & 3) + 8 * (r >> 2) + 4 * hi; }
__device__ __forceinline__ void glds16(const void* gsrc, unsigned lds_dst) { unsigned keep;
    asm volatile("s_mov_b32 %0, m0\n\ts_mov_b32 m0, %2\n\ts_nop 0\n\tglobal_load_lds_dwordx4 %1, off\n\ts_mov_b32 m0, %0" : "=&s"(keep) : "v"(gsrc), "s"(lds_dst) : "memory"); }
__device__ __forceinline__ void glds16s(const void* sbase, unsigned voff, unsigned lds_dst) { unsigned keep;
    asm volatile("s_mov_b32 %0, m0\n\ts_mov_b32 m0, %3\n\ts_nop 0\n\tglobal_load_lds_dwordx4 %1, %2\n\ts_mov_b32 m0, %0" : "=&s"(keep) : "v"(voff), "s"(sbase), "s"(lds_dst) : "memory"); }
__device__ __forceinline__ float max3f(float a, float b, float c) { float r; asm("v_max3_f32 %0, %1, %2, %3" : "=v"(r) : "v"(a), "v"(b), "v"(c)); return r; }
__device__ __forceinline__ float max2f(float a, float b) { float r; asm("v_max_f32_e32 %0, %1, %2" : "=v"(r) : "v"(a), "v"(b)); return r; }
__device__ __forceinline__ float fadd_s(float a, float b) { float r; asm("v_add_f32_e32 %0, %1, %2" : "=v"(r) : "v"(a), "v"(b)); return r; }
__device__ __forceinline__ float fsub_s(float a, float b) { float r; asm("v_sub_f32_e32 %0, %1, %2" : "=v"(r) : "v"(a), "v"(b)); return r; }
#define WAIT_BAR(N) asm volatile("s_waitcnt vmcnt(" #N ") lgkmcnt(0)\n\ts_barrier" ::: "memory")
__device__ __forceinline__ void kx_init(int* kx, int r32, int hi) {
    const int a0 = (r32 >> 3) * 1024 + (r32 & 7) * 128, sw = (r32 >> 1) & 7;
#pragma unroll
    for (int d0 = 0; d0 < 4; ++d0) kx[d0] = a0 + (((2 * d0 + hi) ^ sw) << 4);
}
template <int NQ>
__device__ __forceinline__ void qkt(f32x16& p0, f32x16& p1, lds_cptr Kslot, const bf16x8* qr, const f32x16& negm, int r32, int hi, const int* kx) {
    lds_cptr kb = Kslot + hi * 1024 + r32 * 16;
#pragma unroll
    for (int d0 = 0; d0 < NQ; ++d0) {
        const bf16x8 b0 = (d0 < 4) ? *(const LAS bf16x8*)(Kslot + kx[d0 & 3]) : *(const LAS bf16x8*)(kb + d0 * 2048);
        const bf16x8 b1 = (d0 < 4) ? *(const LAS bf16x8*)(Kslot + kx[d0 & 3] + 4096) : *(const LAS bf16x8*)(kb + d0 * 2048 + 512);
        if (d0 == 0) { p0 = __builtin_amdgcn_mfma_f32_32x32x16_bf16(b0, qr[0], negm, 0, 0, 0); p1 = __builtin_amdgcn_mfma_f32_32x32x16_bf16(b1, qr[0], negm, 0, 0, 0); }
        else { p0 = __builtin_amdgcn_mfma_f32_32x32x16_bf16(b0, qr[d0], p0, 0, 0, 0); p1 = __builtin_amdgcn_mfma_f32_32x32x16_bf16(b1, qr[d0], p1, 0, 0, 0); } }
}
__device__ __forceinline__ void kload2(bf16x8* kf, lds_cptr kslot, int j, const int* kx) { kf[2 * j] = *(const LAS bf16x8*)(kslot + kx[j]); kf[2 * j + 1] = *(const LAS bf16x8*)(kslot + kx[j] + 4096); }
__device__ __forceinline__ void kload8(bf16x8* kf, lds_cptr kslot, const int* kx) {
#pragma unroll
    for (int j = 0; j < 4; ++j) kload2(kf, kslot, j, kx);
}
__device__ __forceinline__ s16x4 vtr(lds_cptr p) { return __builtin_bit_cast(s16x4, __builtin_amdgcn_ds_read_tr16_b64_v4i16((LAS s16x4*)p)); }
__device__ __forceinline__ float rowmax(const f32x16& p0, const f32x16& p1) {
    float a = max3f(p0[0], p0[1], p1[0]), b = max3f(p0[2], p0[3], p1[1]); a = max3f(a, p1[2], p1[3]);
#pragma unroll
    for (int r = 4; r < 16; r += 4) { a = max3f(a, p0[r], p0[r + 1]); b = max3f(b, p0[r + 2], p0[r + 3]); a = max3f(a, p1[r], p1[r + 1]); b = max3f(b, p1[r + 2], p1[r + 3]); }
    const float m = max2f(a, b);
    auto rr = __builtin_amdgcn_permlane32_swap(__float_as_uint(m), __float_as_uint(m), false, false);
    return max2f(__uint_as_float(rr[0]), __uint_as_float(rr[1]));
}
__device__ __forceinline__ void pv(f32x16* o, int vb, bf16x8 pa0, bf16x8 pa1, bf16x8 pa2, bf16x8 pa3) {
#pragma unroll
    for (int d0 = 0; d0 < 2; ++d0) { s16x4 lo[4], hi[4];
#pragma unroll
        for (int ks = 0; ks < 4; ++ks) {
            asm volatile("ds_read_b64_tr_b16 %0,%1 offset:%c2" : "=&v"(lo[ks]) : "v"(vb), "i"(d0 * 4096 + ks * 1024) : "memory");
            asm volatile("ds_read_b64_tr_b16 %0,%1 offset:%c2" : "=&v"(hi[ks]) : "v"(vb), "i"(d0 * 4096 + ks * 1024 + 512) : "memory"); }
        asm volatile("s_waitcnt lgkmcnt(0)" ::: "memory"); SBAR();
#define PK(k) (bf16x8){lo[k][0], lo[k][1], lo[k][2], lo[k][3], hi[k][0], hi[k][1], hi[k][2], hi[k][3]}
        o[d0] = __builtin_amdgcn_mfma_f32_32x32x16_bf16(pa0, PK(0), o[d0], 0, 0, 0);
        o[d0] = __builtin_amdgcn_mfma_f32_32x32x16_bf16(pa1, PK(1), o[d0], 0, 0, 0);
        o[d0] = __builtin_amdgcn_mfma_f32_32x32x16_bf16(pa2, PK(2), o[d0], 0, 0, 0);
        o[d0] = __builtin_amdgcn_mfma_f32_32x32x16_bf16(pa3, PK(3), o[d0], 0, 0, 0);
#undef PK
    }
}
template <int MODE>
__device__ __forceinline__ void bias_mask(f32x16& p0, f32x16& p1, int ta, int qb, int cw, int qrelu, int qrel64, int hi, const LAS float* tab) {
    if (MODE == 0) {
        if (ta > cw) {
            asm volatile("" ::: "memory");
            const float NEGI = -INFINITY;
#pragma unroll
            for (int r = 0; r < 16; ++r) { p0[r] = NEGI; p1[r] = NEGI; }
        }
    } else if (MODE == 2) {
        const LAS float* gp = tab + 64 * ta + 4 * hi;
#pragma unroll
        for (int g4 = 0; g4 < 4; ++g4) {
            const f32x4 a = *(const LAS f32x4*)(gp + 8 * g4), b = *(const LAS f32x4*)(gp + 32 + 8 * g4);
#pragma unroll
            for (int i = 0; i < 4; ++i) { p0[4 * g4 + i] += a[i]; p1[4 * g4 + i] += b[i]; }
            if (g4 == 1) { asm volatile("" : "+v"(p0), "+v"(p1) :: "memory"); }
        }
        const int jb = ta - 4 * qb;
        if (jb >= 0) {
            const float NEGI = -INFINITY; const int kb = 64 * jb + 4 * hi;
#pragma unroll
            for (int r = 0; r < 16; ++r) { const int kv = kb + (r & 3) + 8 * (r >> 2); if (kv > qrelu) p0[r] = NEGI; if (kv + 32 > qrelu) p1[r] = NEGI; }
        }
    } else {
        const int mm = cw - ta;
        if (mm < 0 || mm > 8) {
            const float NEGI = -INFINITY;
#pragma unroll
            for (int r = 0; r < 16; ++r) { p0[r] = NEGI; p1[r] = NEGI; }
        } else if (mm >= 3) {
            const float c = tab[256];
#pragma unroll
            for (int r = 0; r < 16; ++r) { p0[r] += c; p1[r] += c; }
        } else {
            const int base = 64 * mm + qrel64 - 4 * hi;
            const LAS float* tp = tab + (base + 128 - 59);
#pragma unroll
            for (int r = 0; r < 16; ++r) {
                const int c0 = (r & 3) + 8 * (r >> 2);
                p0[r] += tp[59 - c0]; p1[r] += tp[27 - c0];
            }
        }
    }
}

template <int MODE, int THRL>
__device__ __forceinline__ void attn_unit(const att::AP P, const int qb, LAS unsigned char* lds, const int wv) {
    constexpr int NQ = (MODE == 0) ? 6 : 4;
    constexpr int LDS_K = Map<MODE>::LDS_K, LDS_V = Map<MODE>::LDS_V, LDS_WS = Map<MODE>::LDS_WS, LDS_OST = Map<MODE>::LDS_OST, LDS_TB = Map<MODE>::LDS_TB, LDS_G = Map<MODE>::LDS_G;
    const int lane = lane_now(), r32 = lane & 31, hi = lane >> 5;
    const int wid = wv, tid = wv * 64 + lane;
    const int q0 = qb * 256;
    const int cw = 4 * qb + (wid >> 1);
    int t0 = 0; const int t1 = 4 * qb + 4;
    if (MODE == 1) t0 = (4 * qb - 8) > 0 ? (4 * qb - 8) : 0;
    const int NT = t1 - t0;
#define KOFF(sl) ((MODE == 0) ? ((sl) + ((sl) >> 1)) : (sl))
    const int qrelu = wid * QBLK + r32;
    const int qrel64 = 32 * (wid & 1) + r32;
    LAS float* tab = (LAS float*)(lds + (MODE == 2 ? LDS_G : LDS_TB));
    const bf16_t* Qw = P.Q + (size_t)(q0 + wid * QBLK) * P.qp;
    const bf16_t* Kh = P.K + (size_t)(t1 - 1) * KVBLK * P.kp; const bf16_t* Vh = P.V + (size_t)(t1 - 1) * KVBLK * P.vp;
    const unsigned lds0 = (unsigned)(uintptr_t)lds;
    LAS float* wsf = (LAS float*)(lds + LDS_WS) + wid * 64;
    const unsigned kvo = (unsigned)((8 * wid + (lane >> 3)) * P.kp + (((lane & 7) ^ (((wid & 1) << 2) | (lane >> 4))) * 8)) * 2u, vvo = (unsigned)((16 * (wid & 3) + (lane >> 2)) * P.vp + (wid >> 2) * 32 + (lane & 3) * 8) * 2u;
    const unsigned kdst = lds0 + LDS_K + wid * 1024, vdst = lds0 + LDS_V + wid * 1024;
    const bf16_t* K2h = (MODE == 0) ? (P.K2 + (size_t)(t1 - 1) * KVBLK * P.k2p) : nullptr; const unsigned k2vo = (MODE == 0) ? (unsigned)(lane * P.k2p + (wid & 3) * 8) * 2u : 0u;
    const unsigned k2dst = lds0 + LDS_K + 8192 + (wid & 3) * 1024;
#define DMA_K(t, slot) glds16s(Kh - (size_t)(t) * KVBLK * P.kp, kvo, (unsigned)__builtin_amdgcn_readfirstlane(kdst + KOFF(slot)))
#define DMA_K2(t, slot) glds16s(K2h - (size_t)(t) * KVBLK * P.k2p, k2vo, (unsigned)__builtin_amdgcn_readfirstlane(k2dst + KOFF(slot)))
#define DMA_V(t, slot) glds16s(Vh - (size_t)(t) * KVBLK * P.vp, vvo, (unsigned)__builtin_amdgcn_readfirstlane(vdst + (slot)))
    const int vb0 = (int)(lds0 + LDS_V) + ((lane >> 4) & 1) * 32 + (lane & 3) * 8 + (4 * hi + ((lane & 15) >> 2)) * 64;
    lds_cptr Kbase = lds + LDS_K; bf16x8 kf[8];
    int kx[4]; kx_init(kx, r32, hi);
    lds_cptr kp0 = lds + LDS_K + hi * 1024 + r32 * 16; lds_cptr vp0 = lds + LDS_V + ((lane >> 4) & 1) * 32 + (lane & 3) * 8 + (4 * hi + ((lane & 15) >> 2)) * 64;
    DMA_K(0, 0); if (MODE == 0) DMA_K2(0, 0); DMA_V(0, 0); DMA_K(1, SLOTB); if (MODE == 0) DMA_K2(1, SLOTB);
    bf16x8 qr[NQ];
#pragma unroll
    for (int d0 = 0; d0 < NQ; ++d0) qr[d0] = *(const bf16x8*)(Qw + (size_t)r32 * P.qp + d0 * 16 + hi * 8);
    if (MODE == 2) { if (4 * tid < t1 * 64) { const f32x4 g = *(const f32x4*)(P.kb + 4 * tid); *(LAS f32x4*)(tab + 4 * tid) = g; } }
    else if (MODE == 1) { if (tid < 320) tab[tid] = P.kb[tid < 256 ? tid : 256] * LOG2E; }
    float mhat = 0.f, l_reg = 0.f; f32x16 o[2];
#pragma unroll
    for (int r = 0; r < 16; ++r) { o[0][r] = 0.f; o[1][r] = 0.f; }
    f32x16 negm;
#pragma unroll
    for (int r = 0; r < 16; ++r) negm[r] = 0.f;
    asm volatile("" : "+v"(negm));
#define BMASK(P0, P1, t, BAND) bias_mask<MODE>(P0, P1, t1 - 1 - (t), qb, cw, qrelu, qrel64, hi, tab)
    bool resc = false;
#define START(P0, P1) do { const float rm = rowmax(P0, P1); resc = false; \
    { const float dl = __builtin_fmaxf(rm, -1.0e4f); mhat = fadd_s(mhat, dl); \
      _Pragma("unroll") for (int r = 0; r < 16; ++r) { P0[r] = fsub_s(P0[r], dl); P1[r] = fsub_s(P1[r], dl); } \
      _Pragma("unroll") for (int r = 0; r < 16; ++r) negm[r] = -mhat; asm volatile("" : "+v"(negm)); } \
    _Pragma("unroll") for (int r = 0; r < 16; ++r) P0[r] = __builtin_amdgcn_exp2f(P0[r]); } while (0)
#define RESC() do { if (resc) { asm volatile("s_waitcnt lgkmcnt(0)" ::: "memory"); \
      _Pragma("unroll") for (int d_ = 0; d_ < 2; ++d_) _Pragma("unroll") for (int r = 0; r < 16; ++r) o[d_][r] *= wsf[crow(r, hi)]; } } while (0)
    f32x16 pA0, pA1, pB0, pB1;
    int sl_prev = 0, sl_cur = 0, sl_next = SLOTB;
#define ROT() do { sl_prev = sl_cur; sl_cur = sl_next; sl_next = (sl_next == (NSLOT - 1) * SLOTB) ? 0 : sl_next + SLOTB; } while (0)
    DMA_K(2, 2 * SLOTB);
    if (MODE == 0) WAIT_BAR(4); else WAIT_BAR(3);
    qkt<NQ>(pA0, pA1, Kbase, qr, negm, r32, hi, kx); asm volatile("s_nop 15\n\ts_nop 7" : "+v"(pA0), "+v"(pA1)); BMASK(pA0, pA1, 0, true);
    START(pA0, pA1);
#pragma unroll
    for (int r = 0; r < 16; ++r) pA1[r] = __builtin_amdgcn_exp2f(pA1[r]);
    WAIT_BAR(0);
    DMA_K(3, 0); if (MODE == 0) DMA_K2(2, 2 * SLOTB); DMA_V(1, SLOTB);
    ROT();
    kload8(kf, Kbase + KOFF(sl_cur), kx);
    if (MODE == 0) WAIT_BAR(3); else WAIT_BAR(2);
    s16x4 vlo[8], vhi[8]; u32x4 pw0, pw1, pw2, pw3;
#define PKW(P, B) cvtpk(P[B], P[B + 1])
#define PAF(k) __builtin_bit_cast(bf16x8, pw##k)
#define VFR(i) (bf16x8){vlo[i][0], vlo[i][1], vlo[i][2], vlo[i][3], vhi[i][0], vhi[i][1], vhi[i][2], vhi[i][3]}
#define PIN(x) asm volatile("" : "+v"(x))
#define MX3(a, b, c) __builtin_fmaxf(__builtin_fmaxf((a), (b)), (c))
#define GAPA(MF, A0, A1, A2, A3, W0, W1, PW) do { MF; sacc += A0; sacc += A1; sacc += A2; sacc += A3; PIN(sacc); W0; W1; PIN(PW); SBAR(); } while (0)
#define EX(v) __builtin_amdgcn_exp2f(v)
#define GAPB(MF, X, B) do { MF; X[B] = EX(X[B]); X[B + 1] = EX(X[B + 1]); X[B + 2] = EX(X[B + 2]); X[B + 3] = EX(X[B + 3]); PIN(X); SBAR(); } while (0)
#define VRD(i) do { vlo[i] = vtr(vp_ + (((i) >> 2) * 4096 + ((i) & 3) * 1024)); vhi[i] = vtr(vp_ + (((i) >> 2) * 4096 + ((i) & 3) * 1024 + 512)); } while (0)
#define KRD(G, j) do { if (G) { kload2(kf, Kbase + KOFF(sl_next), j, kx); SBAR(); } } while (0)
#define STEP(C0, C1, P0, P1, t, GK, GK2, GV, GL, BAND) do { SBAR(); \
    lds_cptr vp_ = vp0 + sl_prev; \
    bf16x8 kr0, kr1, kr2, kr3; \
    if (MODE == 0) { lds_cptr kq_ = kp0 + KOFF(sl_cur) + 8192; kr0 = *(const LAS bf16x8*)(kq_); kr1 = *(const LAS bf16x8*)(kq_ + 512); kr2 = *(const LAS bf16x8*)(kq_ + 2048); kr3 = *(const LAS bf16x8*)(kq_ + 2560); SBAR(); } \
    VRD(0); SBAR(); float sacc = (P0[0] + P0[1]); \
    GAPA(C0 = __builtin_amdgcn_mfma_f32_32x32x16_bf16(kf[0], qr[0], negm, 0, 0, 0), P0[2], P0[3], P0[4], P0[5],     pw0[0] = PKW(P0, 0), pw0[1] = PKW(P0, 2), pw0); \
    VRD(4); SBAR(); GAPA(C1 = __builtin_amdgcn_mfma_f32_32x32x16_bf16(kf[1], qr[0], negm, 0, 0, 0), P0[6], P0[7], P0[8], P0[9],     pw0[2] = PKW(P0, 4), pw0[3] = PKW(P0, 6), pw0); \
    VRD(1); SBAR(); GAPA(C0 = __builtin_amdgcn_mfma_f32_32x32x16_bf16(kf[2], qr[1], C0, 0, 0, 0),   P0[10], P0[11], P0[12], P0[13], pw1[0] = PKW(P0, 8), pw1[1] = PKW(P0, 10), pw1); \
    VRD(5); SBAR(); GAPA(C1 = __builtin_amdgcn_mfma_f32_32x32x16_bf16(kf[3], qr[1], C1, 0, 0, 0),   P0[14], P0[15], P1[0], P1[1],   pw1[2] = PKW(P0, 12), pw1[3] = PKW(P0, 14), pw1); \
    VRD(2); SBAR(); GAPA(C0 = __builtin_amdgcn_mfma_f32_32x32x16_bf16(kf[4], qr[2], C0, 0, 0, 0),   P1[2], P1[3], P1[4], P1[5],     pw2[0] = PKW(P1, 0), pw2[1] = PKW(P1, 2), pw2); \
    VRD(6); SBAR(); GAPA(C1 = __builtin_amdgcn_mfma_f32_32x32x16_bf16(kf[5], qr[2], C1, 0, 0, 0),   P1[6], P1[7], P1[8], P1[9],     pw2[2] = PKW(P1, 4), pw2[3] = PKW(P1, 6), pw2); \
    VRD(3); SBAR(); GAPA(C0 = __builtin_amdgcn_mfma_f32_32x32x16_bf16(kf[6], qr[3], C0, 0, 0, 0),   P1[10], P1[11], P1[12], P1[13], pw3[0] = PKW(P1, 8), pw3[1] = PKW(P1, 10), pw3); \
    VRD(7); SBAR(); GAPA(C1 = __builtin_amdgcn_mfma_f32_32x32x16_bf16(kf[7], qr[3], C1, 0, 0, 0),   P1[14], P1[15], 0.f, 0.f,       pw3[2] = PKW(P1, 12), pw3[3] = PKW(P1, 14), pw3); \
    if (MODE == 0) { \
        C0 = __builtin_amdgcn_mfma_f32_32x32x16_bf16(kr0, qr[NQ - 2], C0, 0, 0, 0); C1 = __builtin_amdgcn_mfma_f32_32x32x16_bf16(kr1, qr[NQ - 2], C1, 0, 0, 0); \
        C0 = __builtin_amdgcn_mfma_f32_32x32x16_bf16(kr2, qr[NQ - 1], C0, 0, 0, 0); C1 = __builtin_amdgcn_mfma_f32_32x32x16_bf16(kr3, qr[NQ - 1], C1, 0, 0, 0); SBAR(); } \
    l_reg += sacc; \
    if (GK) { DMA_K((t) + 3, sl_cur); } if (MODE == 0 && (GK2)) { DMA_K2((t) + 2, sl_prev); } if (GV) { DMA_V((t) + 1, sl_next); } \
    BMASK(C0, C1, t, BAND); \
    { float a = MX3(C0[0], C0[1], C1[0]), b = MX3(C0[2], C0[3], C1[1]); a = MX3(a, C1[2], C1[3]); \
      _Pragma("unroll") for (int r = 4; r < 16; r += 4) { a = MX3(a, C0[r], C0[r + 1]); b = MX3(b, C0[r + 2], C0[r + 3]); a = MX3(a, C1[r], C1[r + 1]); b = MX3(b, C1[r + 2], C1[r + 3]); } \
      float rm = __builtin_fmaxf(a, b); { auto rr = __builtin_amdgcn_permlane32_swap(__float_as_uint(rm), __float_as_uint(rm), false, false); rm = __builtin_fmaxf(__uint_as_float(rr[0]), __uint_as_float(rr[1])); } \
      resc = false; \
      if (__builtin_expect(__any(rm > (float)THRL), 0)) { const float dl = __builtin_fmaxf(rm, 0.f); mhat += dl; \
        _Pragma("unroll") for (int r = 0; r < 16; ++r) { C0[r] -= dl; C1[r] -= dl; } \
        _Pragma("unroll") for (int r = 0; r < 16; ++r) negm[r] = -mhat; asm volatile("" : "+v"(negm)); \
        const float f = __builtin_amdgcn_exp2f(-dl); l_reg *= f; if (hi == 0) wsf[r32] = f; resc = true; } } \
    SBAR(); \
    GAPB(o[0] = __builtin_amdgcn_mfma_f32_32x32x16_bf16(PAF(0), VFR(0), o[0], 0, 0, 0), C0, 0); \
    GAPB(o[1] = __builtin_amdgcn_mfma_f32_32x32x16_bf16(PAF(0), VFR(4), o[1], 0, 0, 0), C0, 4); \
    KRD(GL, 0); GAPB(o[0] = __builtin_amdgcn_mfma_f32_32x32x16_bf16(PAF(1), VFR(1), o[0], 0, 0, 0), C0, 8); \
    KRD(GL, 1); GAPB(o[1] = __builtin_amdgcn_mfma_f32_32x32x16_bf16(PAF(1), VFR(5), o[1], 0, 0, 0), C0, 12); \
    KRD(GL, 2); GAPB(o[0] = __builtin_amdgcn_mfma_f32_32x32x16_bf16(PAF(2), VFR(2), o[0], 0, 0, 0), C1, 0); \
    KRD(GL, 3); GAPB(o[1] = __builtin_amdgcn_mfma_f32_32x32x16_bf16(PAF(2), VFR(6), o[1], 0, 0, 0), C1, 4); \
    GAPB(o[0] = __builtin_amdgcn_mfma_f32_32x32x16_bf16(PAF(3), VFR(3), o[0], 0, 0, 0), C1, 8); \
    GAPB(o[1] = __builtin_amdgcn_mfma_f32_32x32x16_bf16(PAF(3), VFR(7), o[1], 0, 0, 0), C1, 12); \
    } while (0)
    int t = 1;
#define ENDW(tt) do { if ((tt) + 3 < NT) { if (MODE == 0) WAIT_BAR(3); else WAIT_BAR(2); } else if ((tt) + 2 < NT) { if (MODE == 0) WAIT_BAR(2); else WAIT_BAR(1); } else { WAIT_BAR(0); } } while (0)
    for (; t + 1 < NT; t += 2) {
        STEP(pB0, pB1, pA0, pA1, t, (t + 3 < NT), (t + 2 < NT), (t + 1 < NT), (t + 1 < NT), true);         ENDW(t);     RESC(); ROT();
        STEP(pA0, pA1, pB0, pB1, t + 1, (t + 4 < NT), (t + 3 < NT), (t + 2 < NT), (t + 2 < NT), true);     ENDW(t + 1); RESC(); ROT();
    }
    STEP(pB0, pB1, pA0, pA1, NT - 1, false, false, false, false, true); RESC();
    u32x4 gtv[4];
#pragma unroll
    for (int i = 0; i < 4; ++i) gtv[i] = __builtin_nontemporal_load((const u32x4*)(P.gate + (size_t)(q0 + wid * QBLK + i * 8 + (lane >> 3)) * NZ + (lane & 7) * 8));
    { float sacc = pB0[0] + pB0[1];
#pragma unroll
      for (int r = 2; r < 16; ++r) sacc += pB0[r];
#pragma unroll
      for (int r = 0; r < 16; ++r) sacc += pB1[r];
      l_reg += sacc;
      pw0 = (u32x4){PKW(pB0, 0), PKW(pB0, 2), PKW(pB0, 4), PKW(pB0, 6)}; pw1 = (u32x4){PKW(pB0, 8), PKW(pB0, 10), PKW(pB0, 12), PKW(pB0, 14)};
      pw2 = (u32x4){PKW(pB1, 0), PKW(pB1, 2), PKW(pB1, 4), PKW(pB1, 6)}; pw3 = (u32x4){PKW(pB1, 8), PKW(pB1, 10), PKW(pB1, 12), PKW(pB1, 14)};
      SBAR(); pv(o, vb0 + sl_cur, PAF(0), PAF(1), PAF(2), PAF(3)); }
#undef PKW
#undef PAF
#undef VFR
#undef PIN
#undef MX3
#undef GAPA
#undef GAPB
#undef EX
#undef VRD
#undef KRD
#undef STEP
#undef ENDW
    unsigned nxt_unit = 0u;
    if (tid == 0) nxt_unit = __hip_atomic_fetch_add(P.ctr, 1u, __ATOMIC_RELAXED, __HIP_MEMORY_SCOPE_AGENT);
    { auto rr = __builtin_amdgcn_permlane32_swap(__float_as_uint(l_reg), __float_as_uint(l_reg), false, false); l_reg = __uint_as_float(rr[0]) + __uint_as_float(rr[1]); }
    if (hi == 0) wsf[32 + r32] = l_reg; asm volatile("s_waitcnt lgkmcnt(0)" ::: "memory");
    float rli[16];
#pragma unroll
    for (int r = 0; r < 16; ++r) rli[r] = __builtin_amdgcn_rcpf(wsf[32 + crow(r, hi)]);
    {
        LAS bf16_t* stg = (LAS bf16_t*)(lds + LDS_OST) + wid * 2048;
#pragma unroll
        for (int r = 0; r < 16; ++r) { const int orow = crow(r, hi);
#pragma unroll
            for (int d0 = 0; d0 < 2; ++d0) stg[orow * 64 + d0 * 32 + r32] = (bf16_t)(cvtpk(o[d0][r] * rli[r], 0.f) & 0xffffu); }
        asm volatile("s_waitcnt lgkmcnt(0)" ::: "memory");
#pragma unroll
        for (int i = 0; i < 4; ++i) { const int row = i * 8 + (lane >> 3), ch = lane & 7; const u32x4 v = *(const LAS u32x4*)(stg + row * 64 + ch * 8);
            const size_t grow = (size_t)(q0 + wid * QBLK + row);
            const u32x4 gt = gtv[i];
            u32x4 w;
            w.x = cvtpk(bf_lo(v.x) * bf_lo(gt.x), bf_hi(v.x) * bf_hi(gt.x));
            w.y = cvtpk(bf_lo(v.y) * bf_lo(gt.y), bf_hi(v.y) * bf_hi(gt.y));
            w.z = cvtpk(bf_lo(v.z) * bf_lo(gt.z), bf_hi(v.z) * bf_hi(gt.z));
            w.w = cvtpk(bf_lo(v.w) * bf_lo(gt.w), bf_hi(v.w) * bf_hi(gt.w));
            *(u32x4*)(P.out + grow * DM + ch * 8) = w; }
    }
    if (tid == 0) *(volatile LAS unsigned*)(lds + att::L_NEXT) = nxt_unit;
    asm volatile("s_waitcnt lgkmcnt(0)\n\ts_barrier" ::: "memory");
#undef DMA_K
#undef DMA_K2
#undef DMA_V
#undef BMASK
#undef START
#undef RESC
#undef ROT
#undef KOFF
}
#undef SBAR
#undef WAIT_BAR
}

struct Args {
    const float* x; const float* c; const int* pos; const float* w_ada; const float* b_ada; const float* norm_g; const float* w_in;
    const float* qng; const float* w_uq; const float* kvng; const float* w_ukv; const float* relb; const float* fgb; const float* w_out; const float* final_g;
    float* out; unsigned char* ws; int ph_lo, ph_hi;
};

__device__ __forceinline__ int src_col(int kind, int n, float& sc) {
    sc = 1.f;
    if (kind == 4) { if (n < 32) { kind = 0; n = ZC_KPE + n; } else if (n < 37) { kind = 0; n = ZC_CF + (n - 32); } else return -1; }
    else if (kind == 0) { n = n + (n >= ZC_KPE ? 32 : 0); }
    if (kind == 0) {
        if (n < ZC_KPE) return n;
        if (n < ZC_GATE) { const int i = (n - ZC_KPE) >> 1, odd = (n - ZC_KPE) & 1; return 640 + i + 16 * odd; }
        if (n < 1056) return n;
        if (n < 1376) return 2016 + (n - 1056);
        if (n < ZC_BQ) return 3301 + (n - 1376);
        if (n < ZC_BK) { sc = 0.125f * LOG2E; return 1056 + (n - ZC_BQ); }
        if (n < ZC_BV) return 1376 + (n - ZC_BK);
        if (n < ZC_CQ2) return 1696 + (n - ZC_BV);
        if (n < ZC_CK) { sc = 0.125f * LOG2E; return 2336 + (n - ZC_CQ2); }
        if (n < ZC_CV) return 2656 + (n - ZC_CK);
        if (n < ZC_CF) return 2976 + (n - ZC_CV);
        if (n < ZC_CF + 5) return 3296 + (n - ZC_CF);
        return -1;
    } else if (kind == 1) {
        if (n >= 576) return -1;
        sc = 0.10206207261596577f * LOG2E;
        const int h = n / 96, d = n % 96;
        if (d < 64) return n;
        const int i = (d - 64) >> 1, odd = (d - 64) & 1; return h * 96 + 64 + i + 16 * odd;
    } else if (kind == 2) {
        if (n < 384) { const int h = n >> 6, d = n & 63; return h * 128 + d; }
        const int m = n - 384, h = m >> 6, d = m & 63; return h * 128 + 64 + d;
    }
    return n;
}
__device__ __forceinline__ void transpose_item(const float* W, int N, int K, bf16_t* WT, LAS float* scr, int kind, const float* rowscale, int item, int nblk, int lane, int pitch = 0) {
    if (pitch == 0) pitch = K;
    const int kb = item / nblk, nb = item % nblk, k0 = 64 * kb, n0 = 32 * nb;
    float csc; const int sc = src_col(kind, n0 + (lane & 31), csc);
    float v[32], rsc[32];
    const float* wp = W + (size_t)(k0 + (lane >> 5)) * N + (sc >= 0 ? sc : 0);
#pragma unroll
    for (int i = 0; i < 32; ++i) v[i] = __builtin_nontemporal_load(wp + (size_t)(2 * i) * N);
    if (rowscale) {
#pragma unroll
        for (int i = 0; i < 32; ++i) rsc[i] = rowscale[k0 + 2 * i + (lane >> 5)];
    } else {
#pragma unroll
        for (int i = 0; i < 32; ++i) rsc[i] = 1.f;
    }
    if (sc < 0) csc = 0.f;
#pragma unroll
    for (int i = 0; i < 32; ++i) scr[(2 * i + (lane >> 5)) * 33 + (lane & 31)] = v[i] * csc * rsc[i];
    __builtin_amdgcn_s_waitcnt(0xc07f);
    asm volatile("" ::: "memory");
    const int c = lane & 7;
#pragma unroll
    for (int j = 0; j < 4; ++j) {
        const int n = (lane >> 3) + 8 * j; const LAS float* s = scr + (8 * c) * 33 + n;
        u32x4 o; o.x = cvtpk(s[0 * 33], s[1 * 33]); o.y = cvtpk(s[2 * 33], s[3 * 33]); o.z = cvtpk(s[4 * 33], s[5 * 33]); o.w = cvtpk(s[6 * 33], s[7 * 33]);
        *(u32x4*)(WT + (size_t)(n0 + n) * pitch + k0 + 8 * c) = o;
    }
    __builtin_amdgcn_s_waitcnt(0xc07f);
    asm volatile("" ::: "memory");
}

__device__ __forceinline__ void phase0(const Args& a, LAS unsigned char* lds, const int wv, const int bid) {
    const int lane = lane_now(), wave = wv, tid = wv * 64 + lane;
    float* mod = (float*)(a.ws + WS_MOD);
    if (bid < 192) {
        LAS float* cact = (LAS float*)lds;
        for (int i = tid; i < 16 * 1024; i += 512) { const int b = i >> 10, k = i & 1023; const float v = a.c[i]; cact[k * 16 + b] = v / (1.f + __expf(-v)); }
        __syncthreads();
        const int q = bid, l = q / 96, j0 = (q % 96) * 32, ks = wave * 2 + (lane >> 5), jc = lane & 31;
        float acc[16];
#pragma unroll
        for (int b = 0; b < 16; ++b) acc[b] = 0.f;
        const float* w = a.w_ada + (size_t)l * 1024 * 3072 + (size_t)(ks * 64) * 3072 + j0 + jc;
#pragma unroll 8
        for (int kk = 0; kk < 64; ++kk) {
            const float wv = __builtin_nontemporal_load(w + (size_t)kk * 3072);
            const LAS f32x4* cp = (const LAS f32x4*)(cact + (ks * 64 + kk) * 16);
            const f32x4 c0 = cp[0], c1 = cp[1], c2 = cp[2], c3 = cp[3];
#pragma unroll
            for (int i = 0; i < 4; ++i) { acc[i] += wv * c0[i]; acc[4 + i] += wv * c1[i]; acc[8 + i] += wv * c2[i]; acc[12 + i] += wv * c3[i]; }
        }
        LAS float* part = (LAS float*)(lds + 65536);
#pragma unroll
        for (int b = 0; b < 16; ++b) part[(ks * 16 + b) * 32 + jc] = acc[b];
        __syncthreads();
        {
            const int b = tid >> 5, jj = tid & 31; float sacc = a.b_ada[l * 3072 + j0 + jj];
#pragma unroll
            for (int k2 = 0; k2 < 16; ++k2) sacc += part[(k2 * 16 + b) * 32 + jj];
            mod[((size_t)l * 16 + b) * 3072 + j0 + jj] = sacc;
        }
        __syncthreads();
    }
    {
        LAS float* scr = (LAS float*)(lds + wave * 8448);
        const int gw = bid * 8 + wave, NGW = gridDim.x * 8;
        constexpr int I_IN = 16 * 112, I_37 = 16 * 2, I_UQ = 6 * 24, I_UKV = 4 * 24, I_OUT = 16 * 32, I_L = I_IN + I_37 + I_UQ + I_UKV + I_OUT;
        for (int it = gw; it < 2 * I_L; it += NGW) {
            const int l = it / I_L; int r = it % I_L;
            if (r < I_IN) { transpose_item(a.w_in + (size_t)l * 1024 * NIN, NIN, 1024, (bf16_t*)(a.ws + WS_WIN) + (size_t)l * NZG * 1024, scr, 0, nullptr, r, 112, lane); continue; } r -= I_IN;
            if (r < I_37) { transpose_item(a.w_in + (size_t)l * 1024 * NIN, NIN, 1024, (bf16_t*)(a.ws + WS_W37) + (size_t)l * 64 * 1024, scr, 4, nullptr, r, 2, lane); continue; } r -= I_37;
            if (r < I_UQ) { transpose_item(a.w_uq + (size_t)l * 384 * 576, 576, 384, (bf16_t*)(a.ws + WS_WUQ) + (size_t)l * 768 * 384, scr, 1, a.qng + l * 384, r, 24, lane); continue; } r -= I_UQ;
            if (r < I_UKV) { transpose_item(a.w_ukv + (size_t)l * 256 * 768, 768, 256, (bf16_t*)(a.ws + WS_WUKV) + (size_t)l * 768 * 384, scr, 2, a.kvng + l * 256, r, 24, lane, 384); continue; } r -= I_UKV;
            transpose_item(a.w_out + (size_t)l * 1024 * 1024, 1024, 1024, (bf16_t*)(a.ws + WS_WOUT) + (size_t)l * 1024 * 1024, scr, 3, nullptr, r, 32, lane);
        }
    }
    {
        float* cs = (float*)(a.ws + WS_CS);
        const int gt = bid * 512 + tid, NGT = gridDim.x * 512;
        for (int i = gt; i < NTOK * 16; i += NGT) {
            const int tok = i >> 4, j = i & 15;
            const float inv = exp2f(-(float)j * (13.287712379549449f / 16.f));
            const float ang = (float)a.pos[tok] * inv;
            double r = (double)ang; r -= 6.283185307179586 * rint(r * 0.15915494309189535);
            cs[(size_t)tok * 32 + j] = cosf((float)r); cs[(size_t)tok * 32 + 16 + j] = sinf((float)r);
        }
    }
}


__device__ __forceinline__ void side37(const Args& a, const int L, const bf16_t* H, LAS unsigned char* lds, const int wv, const int bid) {
    const int lane = lane_now(), lr = lane & 15, fq = lane >> 4, tid = wv * 64 + lane;
    const int row = bid * 128 + wv * 16 + lr;
    const bf16_t* hp = H + (size_t)row * 1024 + 8 * fq;
    bf16x8 hf[32];
#pragma unroll
    for (int k = 0; k < 32; ++k) hf[k] = *(const bf16x8*)(hp + 32 * k);
    {
        const bf16_t* wsrc = (const bf16_t*)(a.ws + WS_W37) + (size_t)L * 64 * 1024;
#pragma unroll
        for (int j = 0; j < 12; ++j) { const int i = tid + 512 * j, r = i >> 7, ch = i & 127;
            const u32x4 v = *(const u32x4*)(wsrc + (size_t)r * 1024 + ch * 8); *(LAS u32x4*)(lds + r * 2064 + ch * 16) = v; }
    }
    __syncthreads();
    f32x4 acc0 = {0.f, 0.f, 0.f, 0.f}, acc1 = acc0, acc2 = acc0;
    const LAS unsigned char* wl = lds + lr * 2064 + fq * 16;
#pragma unroll
    for (int k = 0; k < 32; ++k) {
        const bf16x8 w0 = *(const LAS bf16x8*)(wl + k * 64), w1 = *(const LAS bf16x8*)(wl + 16 * 2064 + k * 64), w2 = *(const LAS bf16x8*)(wl + 32 * 2064 + k * 64);
        acc0 = __builtin_amdgcn_mfma_f32_16x16x32_bf16(w0, hf[k], acc0, 0, 0, 0);
        acc1 = __builtin_amdgcn_mfma_f32_16x16x32_bf16(w1, hf[k], acc1, 0, 0, 0);
        acc2 = __builtin_amdgcn_mfma_f32_16x16x32_bf16(w2, hf[k], acc2, 0, 0, 0);
    }
    __syncthreads();
    bf16_t* Z = (bf16_t*)(a.ws + WS_Z);
    const float* cs = (const float*)(a.ws + WS_CS) + (size_t)row * 32;
#pragma unroll
    for (int n = 0; n < 2; ++n) {
        const f32x4 v = n == 0 ? acc0 : acc1;
        const int i0 = 8 * n + 2 * fq;
        const f32x2 co = *(const f32x2*)(cs + i0), si = *(const f32x2*)(cs + 16 + i0);
        u32x2 w;
        w.x = cvtpk(v[0] * co[0] - v[1] * si[0], v[0] * si[0] + v[1] * co[0]);
        w.y = cvtpk(v[2] * co[1] - v[3] * si[1], v[2] * si[1] + v[3] * co[1]);
        *(u32x2*)(Z + (size_t)row * NZ + ZC_KPE + 16 * n + 4 * fq) = w;
    }
    if (fq < 2) {
        float* LF = (float*)(a.ws + WS_LF) + (size_t)row * 8;
        const float* fb = a.fgb + L * 5;
        const int nh = fq == 0 ? 4 : 1;
#pragma unroll
        for (int i = 0; i < 4; ++i) if (i < nh) { const float t = acc2[i] + fb[4 * fq + i]; LF[4 * fq + i] = fminf(t, 0.f) - log1pf(__expf(-fabsf(t))); }
    }
}

__device__ __forceinline__ void phase_norm(const Args& a, int l, const float* xin, const int wv, const int bid) {
    const int lane = lane_now(), wave = wv;
    const int gw = bid * 8 + wave, NGW = gridDim.x * 8, wpb = NGW / NB;
    const int b = gw / wpb, wi = gw % wpb;
    if (b >= NB) return;
    const float* mod = (const float*)(a.ws + WS_MOD) + ((size_t)l * 16 + b) * 3072;
    bf16_t* H = (bf16_t*)(a.ws + WS_H);
    f32x4 G[4], SH[4];
#pragma unroll
    for (int j = 0; j < 4; ++j) {
        const int col = 4 * lane + 256 * j;
        const f32x4 g = *(const f32x4*)(a.norm_g + l * 1024 + col), sc = *(const f32x4*)(mod + 1024 + col);
        G[j] = g * (sc + 1.0f); SH[j] = *(const f32x4*)(mod + col);
    }
    for (int row = wi; row < SEQ; row += wpb) {
        const size_t tok = (size_t)b * SEQ + row;
        const f32x4* xr = (const f32x4*)(xin + tok * DM) + lane;
        f32x4 v[4]; float s = 0.f;
#pragma unroll
        for (int j = 0; j < 4; ++j) { v[j] = __builtin_nontemporal_load(xr + 64 * j); s += (v[j].x * v[j].x + v[j].y * v[j].y) + (v[j].z * v[j].z + v[j].w * v[j].w); }
        const float rstd = 1.0f / sqrtf(wave_sum(s, lane) * (1.f / DM) + EPS);
        if (lane == 0) *(f32x2*)((float*)(a.ws + WS_RQ) + tok * 2) = (f32x2){0.f, 0.f};
        u32x2* o8 = (u32x2*)(H + tok * DM) + lane;
#pragma unroll
        for (int j = 0; j < 4; ++j) { const f32x4 h = v[j] * rstd * G[j] + SH[j]; u32x2 w; w.x = cvtpk(h.x, h.y); w.y = cvtpk(h.z, h.w); o8[64 * j] = w; }
    }
}

__device__ __forceinline__ void phase_stats(const Args& a, const int wv, const int bid) {
    const int lane = lane_now(), wave = wv;
    const int gw = bid * 8 + wave;
    if (gw < 80) {
        const int b = gw / 5, h = gw % 5;
        const float* LF = (const float*)(a.ws + WS_LF) + ((size_t)b * SEQ + lane * 32) * 8 + h;
        float* Gp = (float*)(a.ws + WS_G) + (size_t)gw * SEQ + lane * 32;
        float v[32]; float run = 0.f;
#pragma unroll
        for (int i = 0; i < 32; ++i) { run += LF[i * 8]; v[i] = run; }
        float incl = run;
#pragma unroll
        for (int o = 1; o < 64; o <<= 1) { const float t = shfl_up_l(incl, o, lane); if (lane >= o) incl += t; }
        const float excl = incl - run;
#pragma unroll
        for (int i = 0; i < 32; ++i) Gp[i] = -(excl + v[i]) * LOG2E;
    }
}

__device__ __forceinline__ void phase_attn(const Args& a, int l, LAS unsigned char* lds, const int wv, const int bid, const int crep) {
    const bf16_t* Z = (const bf16_t*)(a.ws + WS_Z);
    const bf16_t* QA = (const bf16_t*)(a.ws + WS_QA);
    const bf16_t* KVA = (const bf16_t*)(a.ws + WS_KVA);
    bf16_t* MIX = (bf16_t*)(a.ws + WS_H);
    const float* Gt = (const float*)(a.ws + WS_G);
    unsigned* ctr0 = (unsigned*)(a.ws + WS_CTL) + 8192 + 64 * (l * 8) + 1024 * crep;
    const int myx = (int)((unsigned)__builtin_amdgcn_s_getreg((3 << 11) | 20) & 7u);
    volatile LAS unsigned* nxt = (volatile LAS unsigned*)(lds + att::L_NEXT);
    int curx = myx;
    if (wv == 0 && lane_now() == 0) *nxt = __hip_atomic_fetch_add(ctr0 + 64 * curx, 1u, __ATOMIC_RELAXED, __HIP_MEMORY_SCOPE_AGENT);
    __syncthreads();
    for (;;) {
        const int u = __builtin_amdgcn_readfirstlane((int)*nxt);
        if (u >= 256) {
            __syncthreads();
            if (wv == 0 && lane_now() == 0) {
                unsigned c[8];
#pragma unroll
                for (int j = 0; j < 8; ++j) c[j] = __hip_atomic_load(ctr0 + 64 * j, __ATOMIC_RELAXED, __HIP_MEMORY_SCOPE_AGENT);
                int pick = -1;
#pragma unroll
                for (int k = 7; k >= 1; --k) { const int x = (curx + k) & 7; unsigned cx = 0u;
#pragma unroll
                    for (int j = 0; j < 8; ++j) cx = (j == x) ? c[j] : cx;
                    if (cx < 256u) pick = x; }
                nxt[1] = (unsigned)pick;
                nxt[0] = pick >= 0 ? __hip_atomic_fetch_add(ctr0 + 64 * pick, 1u, __ATOMIC_RELAXED, __HIP_MEMORY_SCOPE_AGENT) : 0u;
            }
            __syncthreads();
            const int pk = __builtin_amdgcn_readfirstlane((int)nxt[1]);
            if (pk < 0) break;
            curx = pk;
            continue;
        }
        unsigned* ctr = ctr0 + 64 * curx;
        int mode, qb, bh;
        { const int g = u >> 5, w = u & 31, hh = 4 * g + (w & 3); qb = 7 - (w >> 2);
          if (hh < 12) { mode = 0; bh = curx * 12 + hh; } else if (hh < 22) { mode = 2; bh = curx * 10 + (hh - 12); } else { mode = 1; bh = curx * 10 + (hh - 22); } }
        att::AP P;
        if (mode == 0) {
            const int b = bh / 6, h = bh % 6; const size_t rb = (size_t)b * SEQ;
            P.Q = QA + rb * QAP + h * 96; P.qp = QAP;
            P.K = KVA + rb * QAP + h * 64; P.kp = QAP;
            P.K2 = Z + rb * NZ + ZC_KPE; P.k2p = NZ;
            P.V = KVA + rb * QAP + 384 + h * 64; P.vp = QAP;
            P.gate = Z + rb * NZ + ZC_GATE + h * 64; P.out = MIX + rb * DM + h * 64; P.kb = nullptr; P.ctr = ctr;
            fa::attn_unit<0, 8>(P, qb, lds, wv);
        } else if (mode == 1) {
            const int b = bh / 5, h = bh % 5; const size_t rb = (size_t)b * SEQ;
            P.Q = Z + rb * NZ + ZC_BQ + h * 64; P.qp = NZ;
            P.K = Z + rb * NZ + ZC_BK + h * 64; P.kp = NZ; P.K2 = nullptr; P.k2p = 0;
            P.V = Z + rb * NZ + ZC_BV + h * 64; P.vp = NZ;
            P.gate = Z + rb * NZ + ZC_GATE + 384 + h * 64; P.out = MIX + rb * DM + 384 + h * 64; P.kb = a.relb + ((size_t)l * 5 + h) * 257; P.ctr = ctr;
            fa::attn_unit<1, 8>(P, qb, lds, wv);
        } else {
            const int b = bh / 5, h = bh % 5; const size_t rb = (size_t)b * SEQ;
            P.Q = Z + rb * NZ + ZC_CQ2 + h * 64; P.qp = NZ;
            P.K = Z + rb * NZ + ZC_CK + h * 64; P.kp = NZ; P.K2 = nullptr; P.k2p = 0;
            P.V = Z + rb * NZ + ZC_CV + h * 64; P.vp = NZ;
            P.gate = Z + rb * NZ + ZC_GATE + 704 + h * 64; P.out = MIX + rb * DM + 704 + h * 64; P.kb = Gt + (size_t)bh * SEQ; P.ctr = ctr;
            fa::attn_unit<2, 8>(P, qb, lds, wv);
        }
    }
    __syncthreads();
}

__device__ __forceinline__ void phase_final(const Args& a, const int wv, const int bid) {
    const int lane = lane_now(), wave = wv;
    const int gw = bid * 8 + wave, NGW = gridDim.x * 8;
    f32x4 G[4];
#pragma unroll
    for (int j = 0; j < 4; ++j) G[j] = *(const f32x4*)(a.final_g + 4 * lane + 256 * j);
    for (int row = gw; row < NTOK; row += NGW) {
        f32x4* xr = (f32x4*)(a.out + (size_t)row * DM) + lane;
        f32x4 v[4]; float s = 0.f;
#pragma unroll
        for (int j = 0; j < 4; ++j) { v[j] = xr[64 * j]; s += (v[j].x * v[j].x + v[j].y * v[j].y) + (v[j].z * v[j].z + v[j].w * v[j].w); }
        const float rstd = 1.0f / sqrtf(wave_sum(s, lane) * (1.f / DM) + EPS);
#pragma unroll
        for (int j = 0; j < 4; ++j) xr[64 * j] = v[j] * rstd * G[j];
    }
}


#define XB_TMO      128
#define XB_XCNT(j)  (256  + 64 * (j))
#define XB_XSUB(j)  (1280 + 64 * (j))
#define XB_XGEN(j)  (2304 + 64 * (j))
#define XB_TOP      3328
#define XB_TOPGEN   3392
#define XCD_BAR_WORDS 3456
#define XB_SPIN_CAP (1u << 18)
__device__ __forceinline__ unsigned xb_ld(unsigned* p)              { return __hip_atomic_load(p, __ATOMIC_RELAXED, __HIP_MEMORY_SCOPE_AGENT); }
__device__ __forceinline__ unsigned xb_add(unsigned* p, unsigned v) { return __hip_atomic_fetch_add(p, v, __ATOMIC_RELAXED, __HIP_MEMORY_SCOPE_AGENT); }
__device__ __forceinline__ unsigned xb_xcc_id() { return (unsigned)__builtin_amdgcn_s_getreg((3 << 11) | 20) & 0xFu; }
#define XB_SPIN(cond, bar) do { unsigned _sp = 0; while (cond) { __builtin_amdgcn_s_sleep(4); \
    if ((++_sp & 255u) == 0u) { if (xb_ld(&(bar)[XB_TMO])) break; if (_sp > XB_SPIN_CAP) { atomicAdd(&(bar)[XB_TMO], 1u); break; } } } } while (0)
struct XcdBarrier { unsigned* bar; unsigned x; volatile LAS unsigned* st; };
__device__ __forceinline__ void xcd_barrier_complete(unsigned* bar, unsigned x, unsigned& nloc, unsigned& nx) {
    const unsigned G = gridDim.x * gridDim.y * gridDim.z;
    unsigned sum, cnt, mine, sp = 0u;
    for (;;) {
        sum = 0u; cnt = 0u; mine = 0u;
#pragma unroll
        for (unsigned j = 0; j < 16; ++j) { const unsigned c = xb_ld(&bar[XB_XCNT(j)]); sum += c; cnt += (c > 0u) ? 1u : 0u; mine = (j == x) ? c : mine; }
        if (sum == G) break;
        __builtin_amdgcn_s_sleep(1);
        if ((++sp & 255u) == 0u) { if (xb_ld(&bar[XB_TMO])) break; if (sp > XB_SPIN_CAP) { atomicAdd(&bar[XB_TMO], 1u); break; } }
    }
    nloc = mine > 0u ? mine : 1u; nx = cnt > 0u ? cnt : 1u;
}
__device__ __forceinline__ void xcd_barrier(const XcdBarrier& b, const bool first) {
    asm volatile("s_waitcnt vmcnt(0)" ::: "memory");
    __syncthreads();
    if (first) {
        unsigned* bar = b.bar;
        __builtin_amdgcn_s_waitcnt(0);
        unsigned nloc = b.st[0], nx = b.st[1];
        if (nloc == 0u) { xcd_barrier_complete(bar, b.x, nloc, nx); b.st[0] = nloc; b.st[1] = nx; }
        const unsigned old = xb_add(&bar[XB_XSUB(b.x)], 1u);
        const unsigned gen = old / nloc;
        if (old + 1u == (gen + 1u) * nloc) {
            __builtin_amdgcn_fence(__ATOMIC_RELEASE, "agent");
            asm volatile("s_waitcnt vmcnt(0)" ::: "memory");
            const unsigned og = xb_add(&bar[XB_TOP], 1u);
            const unsigned tg = og / nx;
            if (og + 1u == (tg + 1u) * nx) xb_add(&bar[XB_TOPGEN], 1u);
            else XB_SPIN(xb_ld(&bar[XB_TOPGEN]) == tg, bar);
            __builtin_amdgcn_fence(__ATOMIC_ACQUIRE, "agent");
            xb_add(&bar[XB_XGEN(b.x)], 1u);
            asm volatile("s_waitcnt vmcnt(0)" ::: "memory");
        } else {
            XB_SPIN(xb_ld(&bar[XB_XGEN(b.x)]) == gen, bar);
            __builtin_amdgcn_fence(__ATOMIC_ACQUIRE, "agent");
            asm volatile("s_waitcnt vmcnt(0)" ::: "memory");
        }
    }
    __syncthreads();
}

#ifndef ONLY
#define ONLY -1
#endif
#define EN(n) (ONLY < 0 || ONLY == (n))
#ifndef DBLMASK
#define DBLMASK 0
#endif
#define PH_IN(k) (lo <= (k) && (k) < hi)
#define SEAM(k) do { if constexpr (COOP) { if (lo <= (k) && (k) + 1 < hi) xcd_barrier(xb, wv == 0 && lane_now() == 0); } } while (0)
#define BAR() do { if constexpr (COOP) xcd_barrier(xb, wv == 0 && lane_now() == 0); } while (0)

template <bool COOP, int L>
__device__ __forceinline__ void layer_phases(const Args& a, LAS unsigned char* lds, const int wv, const int bid, const int lo, const int hi, const XcdBarrier& xb) {
    constexpr int P = (L == 0) ? 2 : 6;
    const float* mod = (const float*)(a.ws + WS_MOD);
    if (L == 0) { if (PH_IN(1) && EN(1)) phase_norm(a, 0, a.x, wv, bid); SEAM(1); }
    if (PH_IN(P + 0) && EN(2)) {
        const bool side_first = ((bid >> 3) & 1) == 0;
        if (side_first) side37(a, L, (const bf16_t*)(a.ws + (L == 0 ? WS_H : WS_HN)), lds, wv, bid);
        pg8::Gemm g{(const bf16_t*)(a.ws + (L == 0 ? WS_H : WS_HN)), (const bf16_t*)(a.ws + WS_WIN) + (size_t)L * NZG * 1024, NTOK, NZG, 1024, 1024, 1024};
        pg8::StaticOrder S; S.init(NTOK, NZG, gridDim.x, bid);
        pg8::EpiZ E{(bf16_t*)(a.ws + WS_Z), (const float*)(a.ws + WS_CS), (float*)(a.ws + WS_LF), a.fgb + L * 5, (float*)(a.ws + WS_RQ), lds + 131072 + 1024};
        pg8::gemm_phase<pg8::EpiZ>(lds, pg8::Prob1{g, S}, E, wv);
        if (!side_first) side37(a, L, (const bf16_t*)(a.ws + (L == 0 ? WS_H : WS_HN)), lds, wv, bid);
    }
    SEAM(P + 0);
    if (PH_IN(P + 1) && EN(4)) {
        phase_stats(a, wv, bid);
        {
            pg8::Gemm g0{(const bf16_t*)(a.ws + WS_Z) + ZC_CQ, (const bf16_t*)(a.ws + WS_WUQ) + (size_t)L * 768 * 384, NTOK, 768, 384, NZ, 384};
            pg8::Gemm g1{(const bf16_t*)(a.ws + WS_Z) + ZC_CKV, (const bf16_t*)(a.ws + WS_WUKV) + (size_t)L * 768 * 384, NTOK, 768, 256, NZ, 384};
            pg8::StaticOrder S; S.init(NTOK, 768, gridDim.x, bid);
            pg8::EpiUp E{pg8::EpiQ{(bf16_t*)(a.ws + WS_QA), (const float*)(a.ws + WS_CS), (const float*)(a.ws + WS_RQ)}, pg8::EpiKV{(bf16_t*)(a.ws + WS_KVA), (const float*)(a.ws + WS_RQ)}};
            pg8::gemm_phase<pg8::EpiUp>(lds, pg8::Prob2{g0, g1, S}, E, wv);
        }
    }
    SEAM(P + 1);
    if (PH_IN(P + 2) && EN(5)) phase_attn(a, L, lds, wv, bid, 0);
#ifdef ATT2
    if (PH_IN(P + 2) && EN(5)) phase_attn(a, L, lds, wv, bid, 1);
#endif
    SEAM(P + 2);
    if (PH_IN(P + 3) && EN(6)) {
        pg8::Gemm g{(const bf16_t*)(a.ws + WS_H), (const bf16_t*)(a.ws + WS_WOUT) + (size_t)L * 1024 * 1024, NTOK, 1024, 1024, 1024, 1024};
        pg8::StaticOrder S; S.init(NTOK, 1024, gridDim.x, bid);
        unsigned* cnt = (unsigned*)(a.ws + WS_CTL) + 16384 + L * 8192;
        float* xbuf = (float*)(a.ws + WS_X) + (size_t)L * NTOK * 4;
        if (L == 0) {
            pg8::EpiOutN<false> E{a.x, a.out, mod + 2048, a.norm_g + 1024, mod + (size_t)16 * 3072, (bf16_t*)(a.ws + WS_HN), (float*)(a.ws + WS_RQ), xbuf, cnt, lds + 131072 + 1024};
            pg8::gemm_phase<pg8::EpiOutN<false>>(lds, pg8::Prob1{g, S}, E, wv);
        } else {
            pg8::EpiOutN<true> E{a.out, a.out, mod + (size_t)16 * 3072 + 2048, a.final_g, nullptr, nullptr, nullptr, xbuf, cnt, lds + 131072 + 1024};
            pg8::gemm_phase<pg8::EpiOutN<true>>(lds, pg8::Prob1{g, S}, E, wv);
        }
    }
    if (L == 0) SEAM(P + 3);
}

template <bool COOP>
__global__ void __launch_bounds__(512, 2) fwd(Args a) {
    extern __shared__ __attribute__((aligned(16))) unsigned char lds_raw[];
    LAS unsigned char* lds = (LAS unsigned char*)lds_raw;
    const int wv = __builtin_amdgcn_readfirstlane(threadIdx.x >> 6);
    const int bid = blockIdx.x, lo = a.ph_lo, hi = a.ph_hi;
    XcdBarrier xb; xb.bar = (unsigned*)(a.ws + WS_CTL) + 1024; xb.x = xb_xcc_id(); xb.st = (volatile LAS unsigned*)(lds + 131072 + 64);
    if constexpr (COOP) {
        if (threadIdx.x == 0) { xb.st[0] = 0u; xb.st[1] = 0u; (void)xb_add(&xb.bar[XB_XCNT(xb.x)], 1u); }
        __syncthreads();
    }
    if (PH_IN(0) && EN(0)) phase0(a, lds, wv, bid);
    SEAM(0);
    layer_phases<COOP, 0>(a, lds, wv, bid, lo, hi, xb);
    layer_phases<COOP, 1>(a, lds, wv, bid, lo, hi, xb);
}

extern "C" void kernel_launch(void* const* d_in, const int* in_sizes, int n_in, void* d_out, int out_size, void* d_ws, size_t ws_size, hipStream_t stream) {
    static int grid = 0;
    if (grid == 0) {
        if (n_in != 15 || in_sizes[0] != NTOK * DM || out_size != NTOK * DM || ws_size < WS_END) { fprintf(stderr, "kernel_launch: unexpected shapes (n_in %d, ws %zu)\n", n_in, ws_size); grid = -1; return; }
        int dev = 0, cus = 0, per_cu = 0;
        hipGetDevice(&dev); hipDeviceGetAttribute(&cus, hipDeviceAttributeMultiprocessorCount, dev);
        hipFuncSetAttribute((const void*)fwd<true>, hipFuncAttributeMaxDynamicSharedMemorySize, LDS_BYTES);
        hipFuncSetAttribute((const void*)fwd<false>, hipFuncAttributeMaxDynamicSharedMemorySize, LDS_BYTES);
        hipOccupancyMaxActiveBlocksPerMultiprocessor(&per_cu, (const void*)fwd<true>, 512, LDS_BYTES);
        (void)hipGetLastError();
        if (per_cu < 1) fprintf(stderr, "kernel_launch: occupancy query reports %d blocks per CU\n", per_cu);
        grid = cus > 256 ? 256 : cus;
        if (grid != 256) fprintf(stderr, "kernel_launch: %d CUs; this kernel is laid out for 256\n", cus);
    }
    if (grid < 0) return;
    Args a{};
    a.x = (const float*)d_in[0]; a.c = (const float*)d_in[1]; a.pos = (const int*)d_in[2]; a.w_ada = (const float*)d_in[3]; a.b_ada = (const float*)d_in[4];
    a.norm_g = (const float*)d_in[5]; a.w_in = (const float*)d_in[6]; a.qng = (const float*)d_in[7]; a.w_uq = (const float*)d_in[8]; a.kvng = (const float*)d_in[9];
    a.w_ukv = (const float*)d_in[10]; a.relb = (const float*)d_in[11]; a.fgb = (const float*)d_in[12]; a.w_out = (const float*)d_in[13]; a.final_g = (const float*)d_in[14];
    a.out = (float*)d_out; a.ws = (unsigned char*)d_ws;
    if (hipMemsetAsync((char*)d_ws + WS_CTL, 0, 196608, stream) != hipSuccess) { fprintf(stderr, "kernel_launch: memset failed\n"); return; }
#if ONE_LAUNCH
    a.ph_lo = 0; a.ph_hi = NPHASE;
    void* args[] = {&a};
    hipError_t e = hipLaunchCooperativeKernel((const void*)fwd<true>, dim3(grid), dim3(512), args, LDS_BYTES, stream);
    if (e != hipSuccess) fprintf(stderr, "cooperative launch failed: %s\n", hipGetErrorString(e));
#else
    for (int ph = 0; ph < NPHASE; ++ph) {
        a.ph_lo = ph; a.ph_hi = ph + 1;
        hipLaunchKernelGGL(fwd<false>, dim3(grid), dim3(512), LDS_BYTES, stream, a);
    }
#endif
}
```

```cpp
#include <hip/hip_runtime.h>
#include <hip/hip_cooperative_groups.h>
#include <cstdio>
#include <cstdint>
namespace cg = cooperative_groups;

#ifndef ONE_LAUNCH
#define ONE_LAUNCH 1
#endif

#define LAS __attribute__((address_space(3)))
typedef unsigned short bf16_t;
typedef short bf16x8 __attribute__((ext_vector_type(8)));
typedef short s16x4 __attribute__((ext_vector_type(4)));
typedef float f32x2 __attribute__((ext_vector_type(2)));
typedef float f32x4 __attribute__((ext_vector_type(4)));
typedef float f32x16 __attribute__((ext_vector_type(16)));
typedef unsigned u32x2 __attribute__((ext_vector_type(2)));
typedef unsigned u32x4 __attribute__((ext_vector_type(4)));
typedef __bf16 bf16x2_t __attribute__((ext_vector_type(2)));

constexpr int DM = 1024, NB = 16, SEQ = 2048, NTOK = NB * SEQ;
constexpr int NIN = 3621, NZ = 3840, NZG = 3584;
constexpr int ZPAD = 32;
constexpr int ZC_CQ = 0, ZC_CKV = 384, ZC_KPE = 640, ZC_GATE = 672 + ZPAD, ZC_BQ = 1696 + ZPAD, ZC_BK = 2016 + ZPAD, ZC_BV = 2336 + ZPAD, ZC_CQ2 = 2656 + ZPAD, ZC_CK = 2976 + ZPAD, ZC_CV = 3296 + ZPAD, ZC_CF = 3616 + ZPAD;
constexpr int QAP = 768;
constexpr float LOG2E = 1.4426950408889634f;
constexpr float EPS = 1e-6f;

constexpr size_t MiB = 1u << 20;
constexpr size_t WS_CTL = 0;
constexpr size_t WS_MOD = 1 * MiB;
constexpr size_t WS_CS = 2 * MiB;
constexpr size_t WS_RQ = 6 * MiB;
constexpr size_t WS_RKV = 6 * MiB + 256 * 1024;
constexpr size_t WS_LF = 7 * MiB;
constexpr size_t WS_G = 8 * MiB;
constexpr size_t WS_WIN = 10 * MiB;
constexpr size_t WS_WUQ = 25 * MiB;
constexpr size_t WS_WUKV = 26 * MiB + 512 * 1024;
constexpr size_t WS_W37 = 26 * MiB + 256 * 1024;
constexpr size_t WS_WOUT = 28 * MiB;
constexpr size_t WS_H = 32 * MiB;
constexpr size_t WS_QA = 96 * MiB;
constexpr size_t WS_KVA = 144 * MiB;
constexpr size_t WS_Z = 192 * MiB;
constexpr size_t WS_HN = 432 * MiB;
constexpr size_t WS_X = 9 * MiB;
constexpr size_t WS_END = 496 * MiB;

constexpr int LDS_BYTES = 147456;
constexpr int NPHASE = 10;

__device__ __forceinline__ unsigned cvtpk(float lo, float hi) { f32x2 v = {lo, hi}; bf16x2_t b = __builtin_convertvector(v, bf16x2_t); return __builtin_bit_cast(unsigned, b); }
__device__ __forceinline__ float bf_lo(unsigned u) { return __builtin_bit_cast(float, u << 16); }
__device__ __forceinline__ float bf_hi(unsigned u) { return __builtin_bit_cast(float, u & 0xffff0000u); }
__device__ __forceinline__ float shfl_xor_l(float v, int o, int lane) { return __builtin_bit_cast(float, __builtin_amdgcn_ds_bpermute((lane ^ o) << 2, __builtin_bit_cast(int, v))); }
__device__ __forceinline__ float shfl_up_l(float v, int o, int lane) { const int src = lane >= o ? lane - o : lane; return __builtin_bit_cast(float, __builtin_amdgcn_ds_bpermute(src << 2, __builtin_bit_cast(int, v))); }
__device__ __forceinline__ int lane_now() { int l; asm volatile("v_mbcnt_lo_u32_b32 %0, -1, 0\n\tv_mbcnt_hi_u32_b32 %0, -1, %0" : "=v"(l)); return l; }
__device__ __forceinline__ float wave_sum(float v, int lane) {
#pragma unroll
    for (int o = 1; o < 64; o <<= 1) v += shfl_xor_l(v, o, lane);
    return v;
}

namespace pg8 {
constexpr int BM = 256, BK = 64, HALF = 128, HTB = HALF * BK * 2, STAGE_BYTES = 8 * HTB, NXCD = 8, WGM = 8;
__device__ __forceinline__ int lds_byte(int r, int c) { const int st = (r >> 4) * 2 + (c >> 5), rr = r & 15, cc = c & 31, ob = rr * 64 + cc * 2; return st * 1024 + (ob ^ (((ob >> 9) & 1) << 5)); }
__device__ __forceinline__ void stage_rc(int b, int& R, int& C) { const int st = b / 1024, sb = b % 1024, swz = sb ^ (((sb >> 9) & 1) << 5); R = (st >> 1) * 16 + swz / 64; C = (st & 1) * 32 + (swz % 64) / 2; }
__device__ __forceinline__ int perm32(int rho) { const int n = rho >> 4, i = rho & 15; return 8 * (i >> 2) + 4 * n + (i & 3); }

struct Unit { int pm, pn, kind; };
struct Gemm { const bf16_t* A; const bf16_t* Bt; int M, N, K, lda, ldb; };

struct StaticOrder {
    int nM, nN, nwg, G, c;
    __device__ void init(int M, int N, int G_, int c_) { nM = M / BM; nN = N / BM; nwg = nM * nN; G = G_; c = c_; }
    __device__ bool next(int i, Unit& u) const { const long L = (long)i * G + c; if (L >= nwg) return false; u.kind = 0; map((int)L, u); return true; }
    __device__ void map(int L, Unit& u) const {
        int wgid = L; { const int q = nwg / NXCD, r = nwg % NXCD, xcd = wgid % NXCD, off = wgid / NXCD; wgid = (xcd < r ? xcd * (q + 1) : r * (q + 1) + (xcd - r) * q) + off; }
        const int nig = WGM * nN, gid = wgid / nig, fm = gid * WGM, gsz = (nM - fm) < WGM ? (nM - fm) : WGM;
        u.pm = fm + ((wgid % nig) % gsz); u.pn = (wgid % nig) / gsz;
    }
};
struct Prob1 {
    Gemm g; StaticOrder S;
    __device__ bool next(int i, Unit& u) const { return S.next(i, u); }
    __device__ const char* a_tile(const Unit& u) const { return (const char*)g.A + (size_t)u.pm * BM * g.lda * 2; }
    __device__ const char* b_tile(const Unit& u) const { return (const char*)g.Bt + (size_t)u.pn * BM * g.ldb * 2; }
    __device__ int nt(const Unit&) const { return g.K / BK; }
    __device__ int lda() const { return g.lda; }
    __device__ int ldb() const { return g.ldb; }
};
struct Prob2 {
    Gemm g0, g1; StaticOrder S;
    __device__ bool next(int i, Unit& u) const { const long L = (long)i * S.G + S.c; if (L >= 2 * S.nwg) return false; u.kind = L >= S.nwg ? 1 : 0; S.map((int)(L - u.kind * S.nwg), u); return true; }
    __device__ const char* a_tile(const Unit& u) const { return (const char*)(u.kind ? g1.A : g0.A) + (size_t)u.pm * BM * g0.lda * 2; }
    __device__ const char* b_tile(const Unit& u) const { return (const char*)(u.kind ? g1.Bt : g0.Bt) + (size_t)u.pn * BM * g0.ldb * 2; }
    __device__ int nt(const Unit& u) const { return (u.kind ? g1.K : g0.K) / BK; }
    __device__ int lda() const { return g0.lda; }
    __device__ int ldb() const { return g0.ldb; }
};

template <class Epi, class Prob>
__device__ __forceinline__ void gemm_phase(LAS unsigned char* lds, const Prob& S, const Epi& E, const int wv) {
    const int lane = lane_now(), wid = wv, tid = wv * 64 + lane, wr = wid >> 2, wc = wid & 3, fr = lane & 15, fq = lane >> 4;
    unsigned voffA[2], voffB[2];
#pragma unroll
    for (int i = 0; i < 2; ++i) { int R, C; stage_rc(tid * 16 + i * 8192, R, C); const int Rb = Epi::PERM ? ((R & ~31) + perm32(R & 31)) : R;
        voffA[i] = (unsigned)(R * S.lda() + C) * 2u; voffB[i] = (unsigned)(Rb * S.ldb() + C) * 2u; }
    const size_t kstep = (size_t)(BK * 2);
    const size_t hstepA = (size_t)HALF * S.lda() * 2, hstepB = (size_t)HALF * S.ldb() * 2;
    const unsigned ldsw = (unsigned)wid * 1024u;
    const int aoff = lds_byte(wr * 64 + fr, fq * 8), boff = lds_byte(wc * 32 + fr, fq * 8);
#define PG8_SA(b, h) (((b) * 2 + (h)) * HTB)
#define PG8_SB(b, h) ((4 + (b) * 2 + (h)) * HTB)
#define PG8_STAGE(bufoff, gbase, voff) do { const char* _g = (const char*)(gbase); asm volatile("" : "+s"(_g)); _Pragma("unroll") for (int _i = 0; _i < 2; ++_i) \
        __builtin_amdgcn_global_load_lds((const unsigned*)(_g + (voff)[_i]), (LAS unsigned*)(lds + (bufoff) + ldsw + _i * 8192), 16, 0, 0); } while (0)
#define PG8_LDA(dst, b, h) do { _Pragma("unroll") for (int m = 0; m < 4; ++m) _Pragma("unroll") for (int k = 0; k < 2; ++k) dst[m][k] = *(const LAS bf16x8*)(lds + PG8_SA(b, h) + aoff + m * 2048 + k * 1024); } while (0)
#define PG8_LDB(dst, b, h) do { _Pragma("unroll") for (int n = 0; n < 2; ++n) _Pragma("unroll") for (int k = 0; k < 2; ++k) dst[n][k] = *(const LAS bf16x8*)(lds + PG8_SB(b, h) + boff + n * 2048 + k * 1024); } while (0)
#define PG8_MMA(ai, bj, At, Bt) do { __builtin_amdgcn_s_setprio(1); _Pragma("unroll") for (int m = 0; m < 4; ++m) _Pragma("unroll") for (int n = 0; n < 2; ++n) _Pragma("unroll") for (int k = 0; k < 2; ++k) \
        acc[ai][bj][m][n] = __builtin_amdgcn_mfma_f32_16x16x32_bf16(Bt[n][k], At[m][k], acc[ai][bj][m][n], 0, 0, 0); __builtin_amdgcn_s_setprio(0); } while (0)
#define PG8_WAIT_V(n) asm volatile("s_waitcnt vmcnt(" #n ")" ::: "memory")
#define PG8_WAIT_L(n) asm volatile("s_waitcnt lgkmcnt(" #n ")" ::: "memory")
#define PG8_BAR __builtin_amdgcn_s_barrier()
#define PG8_SCHED __builtin_amdgcn_sched_barrier(0)
    Unit cur, nxt; int ui = 0;
    if (!S.next(0, cur)) return;
    f32x4 acc[2][2][4][2];
#pragma unroll
    for (int a = 0; a < 2; ++a)
#pragma unroll
        for (int b = 0; b < 2; ++b)
#pragma unroll
            for (int m = 0; m < 4; ++m)
#pragma unroll
                for (int n = 0; n < 2; ++n) acc[a][b][m][n] = (f32x4){0.f, 0.f, 0.f, 0.f};
    bf16x8 At[4][2], B0[2][2], B1[2][2];
    const char* cA = S.a_tile(cur); const char* cB = S.b_tile(cur);
    int nt = S.nt(cur);
    PG8_STAGE(PG8_SB(0, 0), cB, voffB); PG8_STAGE(PG8_SB(0, 1), cB + hstepB, voffB); PG8_STAGE(PG8_SA(0, 0), cA, voffA); PG8_STAGE(PG8_SA(0, 1), cA + hstepA, voffA);
    if (wr == 1) PG8_BAR;
    PG8_WAIT_V(2); PG8_BAR;
    PG8_STAGE(PG8_SB(1, 0), cB + kstep, voffB); PG8_STAGE(PG8_SA(1, 0), cA + kstep, voffA); PG8_STAGE(PG8_SB(1, 1), cB + hstepB + kstep, voffB);
    PG8_WAIT_V(6); PG8_BAR;
    for (;;) {
        const bool has_next = S.next(ui + 1, nxt);
        const char* nA = has_next ? S.a_tile(nxt) : cA; const char* nB = has_next ? S.b_tile(nxt) : cB;
        for (int t = 0; t < nt; t += 2) {
            const bool last = (t == nt - 2);
            const char* a1 = cA + (size_t)(t + 1) * kstep;
            const char* a2 = last ? nA : cA + (size_t)(t + 2) * kstep; const char* b2 = last ? nB : cB + (size_t)(t + 2) * kstep;
            const char* a3 = a2 + kstep; const char* b3 = b2 + kstep;
            PG8_LDB(B0, 0, 0); PG8_LDB(B1, 0, 1); PG8_SCHED; PG8_LDA(At, 0, 0); PG8_STAGE(PG8_SA(1, 1), a1 + hstepA, voffA);
            PG8_WAIT_V(8); PG8_WAIT_L(0); PG8_BAR; PG8_MMA(0, 0, At, B0); PG8_MMA(0, 1, At, B1); PG8_BAR; PG8_SCHED;
            PG8_LDA(At, 0, 1); PG8_STAGE(PG8_SB(0, 0), b2, voffB); PG8_STAGE(PG8_SB(0, 1), b2 + hstepB, voffB); PG8_STAGE(PG8_SA(0, 0), a2, voffA);
            PG8_WAIT_V(8); PG8_WAIT_L(0); PG8_BAR; PG8_MMA(1, 0, At, B0); PG8_MMA(1, 1, At, B1); PG8_BAR; PG8_SCHED;
            PG8_LDB(B0, 1, 0); PG8_LDB(B1, 1, 1); PG8_SCHED; PG8_LDA(At, 1, 0); PG8_STAGE(PG8_SA(0, 1), a2 + hstepA, voffA);
            PG8_WAIT_V(8); PG8_WAIT_L(0); PG8_BAR; PG8_MMA(0, 0, At, B0); PG8_MMA(0, 1, At, B1); PG8_BAR; PG8_SCHED;
            PG8_LDA(At, 1, 1); PG8_STAGE(PG8_SB(1, 0), b3, voffB); PG8_STAGE(PG8_SB(1, 1), b3 + hstepB, voffB); PG8_STAGE(PG8_SA(1, 0), a3, voffA);
            PG8_WAIT_V(8); PG8_WAIT_L(0); PG8_BAR; PG8_MMA(1, 0, At, B0); PG8_MMA(1, 1, At, B1); PG8_BAR; PG8_SCHED;
        }
        if (wr == 0) PG8_BAR;
        { const int le = lane_now();
          E(acc, cur, wid >> 2, wid & 3, le & 15, le >> 4); }
        if (!has_next) break;
#pragma unroll
        for (int a = 0; a < 2; ++a)
#pragma unroll
            for (int b = 0; b < 2; ++b)
#pragma unroll
                for (int m = 0; m < 4; ++m)
#pragma unroll
                    for (int n = 0; n < 2; ++n) acc[a][b][m][n] = (f32x4){0.f, 0.f, 0.f, 0.f};
        cur = nxt; cA = nA; cB = nB; ++ui; nt = S.nt(cur);
        if (wr == 1) PG8_BAR;
    }
    PG8_WAIT_V(0);
    PG8_BAR;
#undef PG8_SA
#undef PG8_SB
#undef PG8_STAGE
#undef PG8_LDA
#undef PG8_LDB
#undef PG8_MMA
#undef PG8_WAIT_V
#undef PG8_WAIT_L
#undef PG8_BAR
#undef PG8_SCHED
}

struct EpiZ {
    static constexpr bool PERM = true;
    bf16_t* Z; const float* cs; float* LF; const float* fb; float* ssq; LAS unsigned char* xl;
    __device__ __forceinline__ void operator()(const f32x4 (&acc)[2][2][4][2], const Unit& u, int wr, int wc, int fr, int fq) const {
        const int row0 = u.pm * BM + wr * 64 + fr;
        if (u.pn <= 2) {
            const int lane = fr + 16 * fq;
            LAS f32x2* Pp = (LAS f32x2*)xl;
#pragma unroll
            for (int ai = 0; ai < 2; ++ai)
#pragma unroll
                for (int m = 0; m < 4; ++m) {
                    float sq = 0.f, sk = 0.f;
#pragma unroll
                    for (int bj = 0; bj < 2; ++bj) {
                        const int colg = u.pn * BM + bj * HALF + wc * 32 + 8 * fq;
                        const f32x4 a = acc[ai][bj][m][0], b = acc[ai][bj][m][1];
                        const float t = (a[0] * a[0] + a[1] * a[1]) + (a[2] * a[2] + a[3] * a[3]) + (b[0] * b[0] + b[1] * b[1]) + (b[2] * b[2] + b[3] * b[3]);
                        if (colg < ZC_CKV) sq += t; else if (colg < ZC_KPE) sk += t;
                    }
                    sq += shfl_xor_l(sq, 16, lane); sq += shfl_xor_l(sq, 32, lane);
                    sk += shfl_xor_l(sk, 16, lane); sk += shfl_xor_l(sk, 32, lane);
                    if (fq == 0) Pp[(ai * HALF + wr * 64 + m * 16 + fr) * 4 + wc] = (f32x2){sq, sk};
                }
            asm volatile("s_waitcnt lgkmcnt(0)" ::: "memory"); __builtin_amdgcn_s_barrier(); asm volatile("" ::: "memory");
            const int tid = (wr * 4 + wc) * 64 + lane;
            if (tid < 256) {
                const f32x2 a = Pp[tid * 4 + 0], b = Pp[tid * 4 + 1], c = Pp[tid * 4 + 2], d = Pp[tid * 4 + 3];
                float* dst = ssq + (size_t)(u.pm * BM + tid) * 2;
                if (u.pn <= 1) __hip_atomic_fetch_add(dst, (a[0] + b[0]) + (c[0] + d[0]), __ATOMIC_RELAXED, __HIP_MEMORY_SCOPE_AGENT);
                if (u.pn >= 1) __hip_atomic_fetch_add(dst + 1, (a[1] + b[1]) + (c[1] + d[1]), __ATOMIC_RELAXED, __HIP_MEMORY_SCOPE_AGENT);
            }
            asm volatile("" ::: "memory");
        }
#pragma unroll
        for (int bj = 0; bj < 2; ++bj) {
            const int colg = u.pn * BM + bj * HALF + wc * 32 + 8 * fq;
            const int zc = colg + (colg >= ZC_KPE ? 32 + ZPAD : 0);
            const bool gatecol = (zc >= ZC_GATE && zc < ZC_BQ);
            const bool kvcol = (zc >= ZC_BK && zc < ZC_CQ2) || (zc >= ZC_CK);
#pragma unroll
            for (int ai = 0; ai < 2; ++ai)
#pragma unroll
                for (int m = 0; m < 4; ++m) {
                    const int row = row0 + ai * HALF + m * 16;
                    f32x4 v0 = acc[ai][bj][m][0], v1 = acc[ai][bj][m][1];
                    if (gatecol) {
#pragma unroll
                        for (int i = 0; i < 4; ++i) { v0[i] = v0[i] * __builtin_amdgcn_rcpf(1.f + __builtin_amdgcn_exp2f(-LOG2E * v0[i])); v1[i] = v1[i] * __builtin_amdgcn_rcpf(1.f + __builtin_amdgcn_exp2f(-LOG2E * v1[i])); }
                    }
                    u32x4 w; w.x = cvtpk(v0[0], v0[1]); w.y = cvtpk(v0[2], v0[3]); w.z = cvtpk(v1[0], v1[1]); w.w = cvtpk(v1[2], v1[3]);
                    if (kvcol) *(u32x4*)(Z + (size_t)row * NZ + zc) = w; else __builtin_nontemporal_store(w, (u32x4*)(Z + (size_t)row * NZ + zc));
                    if (m == 3) asm volatile("" ::: "memory");
                }
        }
    }
};
struct EpiQ {
    static constexpr bool PERM = true;
    bf16_t* O; const float* cs; const float* rs;
    __device__ __forceinline__ void operator()(const f32x4 (&acc)[2][2][4][2], const Unit& u, int wr, int wc, int fr, int fq) const {
        const int row0 = u.pm * BM + wr * 64 + fr;
        float rr[8];
#pragma unroll
        for (int j = 0; j < 8; ++j) rr[j] = rs[(size_t)(row0 + (j >> 2) * HALF + (j & 3) * 16) * 2];
#pragma unroll
        for (int j = 0; j < 8; ++j) rr[j] = __builtin_amdgcn_rsqf(rr[j] * (1.f / 384.f) + EPS);
#pragma unroll
        for (int bj = 0; bj < 2; ++bj) {
            const int colg = u.pn * BM + bj * HALF + wc * 32 + 8 * fq;
            if (colg >= 576) continue;
            const int hd = colg % 96;
            const bool rope = hd >= 64;
            const int i0 = rope ? ((hd - 64) >> 1) : 0;
#pragma unroll
            for (int ai = 0; ai < 2; ++ai) {
                f32x4 co[4], si[4];
                if (rope) {
#pragma unroll
                    for (int m = 0; m < 4; ++m) { const size_t row = (size_t)(row0 + ai * HALF + m * 16); co[m] = *(const f32x4*)(cs + row * 32 + i0); si[m] = *(const f32x4*)(cs + row * 32 + 16 + i0); }
                }
#pragma unroll
                for (int m = 0; m < 4; ++m) {
                    const int row = row0 + ai * HALF + m * 16;
                    const float r = rr[ai * 4 + m];
                    f32x4 v0 = acc[ai][bj][m][0] * r, v1 = acc[ai][bj][m][1] * r;
                    if (rope) {
                        f32x4 a, b;
                        a[0] = v0[0] * co[m][0] - v0[1] * si[m][0]; a[1] = v0[0] * si[m][0] + v0[1] * co[m][0];
                        a[2] = v0[2] * co[m][1] - v0[3] * si[m][1]; a[3] = v0[2] * si[m][1] + v0[3] * co[m][1];
                        b[0] = v1[0] * co[m][2] - v1[1] * si[m][2]; b[1] = v1[0] * si[m][2] + v1[1] * co[m][2];
                        b[2] = v1[2] * co[m][3] - v1[3] * si[m][3]; b[3] = v1[2] * si[m][3] + v1[3] * co[m][3];
                        v0 = a; v1 = b;
                    }
                    u32x4 w; w.x = cvtpk(v0[0], v0[1]); w.y = cvtpk(v0[2], v0[3]); w.z = cvtpk(v1[0], v1[1]); w.w = cvtpk(v1[2], v1[3]);
                    *(u32x4*)(O + (size_t)row * QAP + colg) = w;
                }
                asm volatile("" ::: "memory");
            }
        }
    }
};
struct EpiKV {
    static constexpr bool PERM = true;
    bf16_t* O; const float* rs;
    __device__ __forceinline__ void operator()(const f32x4 (&acc)[2][2][4][2], const Unit& u, int wr, int wc, int fr, int fq) const {
        const int row0 = u.pm * BM + wr * 64 + fr;
        float rr[8];
#pragma unroll
        for (int j = 0; j < 8; ++j) rr[j] = rs[(size_t)(row0 + (j >> 2) * HALF + (j & 3) * 16) * 2 + 1];
#pragma unroll
        for (int j = 0; j < 8; ++j) rr[j] = __builtin_amdgcn_rsqf(rr[j] * (1.f / 256.f) + EPS);
#pragma unroll
        for (int bj = 0; bj < 2; ++bj) {
            const int colg = u.pn * BM + bj * HALF + wc * 32 + 8 * fq;
#pragma unroll
            for (int ai = 0; ai < 2; ++ai)
#pragma unroll
                for (int m = 0; m < 4; ++m) {
                    const int row = row0 + ai * HALF + m * 16;
                    const float r = rr[ai * 4 + m];
                    const f32x4 v0 = acc[ai][bj][m][0] * r, v1 = acc[ai][bj][m][1] * r;
                    u32x4 w; w.x = cvtpk(v0[0], v0[1]); w.y = cvtpk(v0[2], v0[3]); w.z = cvtpk(v1[0], v1[1]); w.w = cvtpk(v1[2], v1[3]);
                    *(u32x4*)(O + (size_t)row * QAP + colg) = w;
                    asm volatile("" ::: "memory");
                }
        }
    }
};
struct EpiUp {
    static constexpr bool PERM = true;
    EpiQ q; EpiKV kv;
    __device__ __forceinline__ void operator()(const f32x4 (&acc)[2][2][4][2], const Unit& u, int wr, int wc, int fr, int fq) const { if (u.kind == 0) q(acc, u, wr, wc, fr, fq); else kv(acc, u, wr, wc, fr, fq); }
};
struct EpiOut {
    static constexpr bool PERM = true;
    const float* xold; float* xnew; const float* gate;
    __device__ __forceinline__ void operator()(const f32x4 (&acc)[2][2][4][2], const Unit& u, int wr, int wc, int fr, int fq) const {
        const int row0 = u.pm * BM + wr * 64 + fr;
        const int b = (u.pm * BM) / SEQ;
#pragma unroll
        for (int bj = 0; bj < 2; ++bj) {
            const int colg = u.pn * BM + bj * HALF + wc * 32 + 8 * fq;
            const f32x4 g0 = *(const f32x4*)(gate + (size_t)b * 3072 + colg), g1 = *(const f32x4*)(gate + (size_t)b * 3072 + colg + 4);
#pragma unroll
            for (int ai = 0; ai < 2; ++ai)
#pragma unroll
                for (int m = 0; m < 4; ++m) {
                    const int row = row0 + ai * HALF + m * 16;
                    const size_t off = (size_t)row * DM + colg;
                    const f32x4 x0 = *(const f32x4*)(xold + off), x1 = *(const f32x4*)(xold + off + 4);
                    *(f32x4*)(xnew + off) = x0 + g0 * acc[ai][bj][m][0];
                    *(f32x4*)(xnew + off + 4) = x1 + g1 * acc[ai][bj][m][1];
                    if (m & 1) asm volatile("" ::: "memory");
                }
        }
    }
};

template <bool LAST>
struct EpiOutN {
    static constexpr bool PERM = true;
    const float* xold; float* xnew; const float* gate; const float* ng; const float* modn; bf16_t* H; float* ssq;
    float* xbuf; unsigned* cnt; LAS unsigned char* xl;
    __device__ __forceinline__ void operator()(f32x4 (&acc)[2][2][4][2], const Unit& u, int wr, int wc, int fr, int fq) const {
        const int lane = fr + 16 * fq, wid = wr * 4 + wc;
        const int row0 = u.pm * BM + wr * 64 + fr;
        const int b = (u.pm * BM) / SEQ;
        LAS float* Pp = (LAS float*)xl;
        LAS float* Sp = (LAS float*)(xl + 4096);
        volatile LAS unsigned* flag = (volatile LAS unsigned*)(xl + 5120);
#pragma unroll
        for (int bj = 0; bj < 2; ++bj) {
            const int colg = u.pn * BM + bj * HALF + wc * 32 + 8 * fq;
            const f32x4 g0 = *(const f32x4*)(gate + (size_t)b * 3072 + colg), g1 = *(const f32x4*)(gate + (size_t)b * 3072 + colg + 4);
#pragma unroll
            for (int ai = 0; ai < 2; ++ai) {
                f32x4 x0[4], x1[4];
#pragma unroll
                for (int m = 0; m < 4; ++m) {
                    const size_t r = (size_t)(row0 + ai * HALF + m * 16);
                    if (LAST) {
                        const u32x4 xb = __builtin_nontemporal_load((const u32x4*)((const bf16_t*)xold + r * (2 * DM) + colg));
                        x0[m] = (f32x4){bf_lo(xb.x), bf_hi(xb.x), bf_lo(xb.y), bf_hi(xb.y)}; x1[m] = (f32x4){bf_lo(xb.z), bf_hi(xb.z), bf_lo(xb.w), bf_hi(xb.w)};
                    } else { x0[m] = __builtin_nontemporal_load((const f32x4*)(xold + r * DM + colg)); x1[m] = __builtin_nontemporal_load((const f32x4*)(xold + r * DM + colg + 4)); }
                }
#pragma unroll
                for (int m = 0; m < 4; ++m) {
                    acc[ai][bj][m][0] = x0[m] + g0 * acc[ai][bj][m][0];
                    acc[ai][bj][m][1] = x1[m] + g1 * acc[ai][bj][m][1];
                    asm volatile("" : "+v"(acc[ai][bj][m][0]), "+v"(acc[ai][bj][m][1]));
                }
                asm volatile("" ::: "memory");
            }
        }
#pragma unroll
        for (int ai = 0; ai < 2; ++ai)
#pragma unroll
            for (int m = 0; m < 4; ++m) {
                float t = 0.f;
#pragma unroll
                for (int bj = 0; bj < 2; ++bj) { const f32x4 p = acc[ai][bj][m][0], q = acc[ai][bj][m][1];
                    t += (p[0] * p[0] + p[1] * p[1]) + (p[2] * p[2] + p[3] * p[3]) + (q[0] * q[0] + q[1] * q[1]) + (q[2] * q[2] + q[3] * q[3]); }
                t += shfl_xor_l(t, 16, lane); t += shfl_xor_l(t, 32, lane);
                if (fq == 0) Pp[(ai * HALF + wr * 64 + m * 16 + fr) * 4 + wc] = t;
            }
        asm volatile("s_waitcnt lgkmcnt(0)" ::: "memory"); __builtin_amdgcn_s_barrier(); asm volatile("" ::: "memory");
        const int row = wid * 32 + (lane & 31);
        if (lane < 32) {
            const f32x4 p = *(const LAS f32x4*)(Pp + row * 4);
            __hip_atomic_store(xbuf + (size_t)(u.pm * BM + row) * 4 + u.pn, (p[0] + p[1]) + (p[2] + p[3]), __ATOMIC_RELAXED, __HIP_MEMORY_SCOPE_AGENT);
        }
        asm volatile("s_waitcnt vmcnt(0)" ::: "memory");
        if (lane == 0) __hip_atomic_fetch_add(cnt + 64 * u.pm, 1u, __ATOMIC_RELAXED, __HIP_MEMORY_SCOPE_AGENT);
        if (!LAST) {
#pragma unroll
            for (int bj = 0; bj < 2; ++bj) {
                const int colg = u.pn * BM + bj * HALF + wc * 32 + 8 * fq;
#pragma unroll
                for (int ai = 0; ai < 2; ++ai)
#pragma unroll
                    for (int m = 0; m < 4; ++m) {
                        const int rt = ai * HALF + wr * 64 + m * 16 + fr;
                        const f32x4 v0 = acc[ai][bj][m][0], v1 = acc[ai][bj][m][1];
                        u32x4 xw; xw.x = cvtpk(v0[0], v0[1]); xw.y = cvtpk(v0[2], v0[3]); xw.z = cvtpk(v1[0], v1[1]); xw.w = cvtpk(v1[2], v1[3]);
                        *(u32x4*)((bf16_t*)xnew + (size_t)(u.pm * BM + rt) * (2 * DM) + colg) = xw;
                        if (m & 1) asm volatile("" ::: "memory");
                    }
            }
        }
        if (wid == 0) {
            bool dead = false; unsigned spins = 0u;
            for (;;) {
                if ((unsigned)__builtin_amdgcn_readfirstlane(__hip_atomic_load(cnt + 64 * u.pm, __ATOMIC_RELAXED, __HIP_MEMORY_SCOPE_AGENT)) >= 32u) break;
                if (++spins > (1u << 22)) { dead = true; break; }
                __builtin_amdgcn_s_sleep(2);
            }
            __builtin_amdgcn_fence(__ATOMIC_ACQUIRE, "agent");
            if (lane == 0) flag[0] = dead ? 1u : 0u;
        }
        asm volatile("s_waitcnt vmcnt(0) lgkmcnt(0)" ::: "memory"); __builtin_amdgcn_s_barrier(); asm volatile("" ::: "memory");
        const bool bad = flag[0] != 0u;
        if (lane < 32) {
            const float* slot = xbuf + (size_t)(u.pm * BM + row) * 4;
            float t = 0.f;
#pragma unroll
            for (int k = 0; k < 4; ++k) t += __hip_atomic_load(slot + k, __ATOMIC_RELAXED, __HIP_MEMORY_SCOPE_AGENT);
            Sp[row] = 1.0f / sqrtf(t * (1.f / DM) + EPS);
            if (!LAST && u.pn == 0) *(f32x2*)(ssq + (size_t)(u.pm * BM + row) * 2) = (f32x2){0.f, 0.f};
        }
        asm volatile("s_waitcnt vmcnt(0) lgkmcnt(0)" ::: "memory"); __builtin_amdgcn_s_barrier(); asm volatile("" ::: "memory");
        const float qnan = __builtin_nanf("");
#pragma unroll
        for (int bj = 0; bj < 2; ++bj) {
            const int colg = u.pn * BM + bj * HALF + wc * 32 + 8 * fq;
            f32x4 G0, G1, S0, S1;
            if (LAST) { G0 = *(const f32x4*)(ng + colg); G1 = *(const f32x4*)(ng + colg + 4); S0 = (f32x4){0.f, 0.f, 0.f, 0.f}; S1 = S0; }
            else {
                const float* mb = modn + (size_t)b * 3072;
                G0 = *(const f32x4*)(ng + colg) * (*(const f32x4*)(mb + 1024 + colg) + 1.0f); G1 = *(const f32x4*)(ng + colg + 4) * (*(const f32x4*)(mb + 1024 + colg + 4) + 1.0f);
                S0 = *(const f32x4*)(mb + colg); S1 = *(const f32x4*)(mb + colg + 4);
            }
#pragma unroll
            for (int ai = 0; ai < 2; ++ai)
#pragma unroll
                for (int m = 0; m < 4; ++m) {
                    const int rt = ai * HALF + wr * 64 + m * 16 + fr;
                    const float rs = Sp[rt];
                    const size_t off = (size_t)(u.pm * BM + rt) * DM + colg;
                    f32x4 v0 = acc[ai][bj][m][0], v1 = acc[ai][bj][m][1];
                    if (bad) { v0 = (f32x4){qnan, qnan, qnan, qnan}; v1 = v0; }
                    if (LAST) {
                        *(f32x4*)(xnew + off) = v0 * rs * G0; *(f32x4*)(xnew + off + 4) = v1 * rs * G1;
                    } else {
                        const f32x4 h0 = v0 * rs * G0 + S0, h1 = v1 * rs * G1 + S1;
                        u32x4 w; w.x = cvtpk(h0[0], h0[1]); w.y = cvtpk(h0[2], h0[3]); w.z = cvtpk(h1[0], h1[1]); w.w = cvtpk(h1[2], h1[3]);
                        *(u32x4*)(H + off) = w;
                    }
                    if (m & 1) asm volatile("" ::: "memory");
                }
        }
    }
};
}

namespace att {
constexpr int KSLOT = 12288, VSLOT = 8192, NSLOT = 4;
constexpr int L_K = 0, L_V = NSLOT * KSLOT, L_WS = L_V + NSLOT * VSLOT, L_OST = L_WS + 2048, L_TB = L_OST + 8 * 4096, L_GB = L_TB + 2048, L_END = L_GB + NSLOT * 8 * 256;
static_assert(L_END <= 131072, "attention LDS map");
constexpr float NEG = -1e30f;
constexpr float THR = 8.0f;

struct AP { const bf16_t* Q; int qp; const bf16_t* K; int kp; const bf16_t* K2; int k2p; const bf16_t* V; int vp; const bf16_t* gate; bf16_t* out; const float* kb; unsigned* ctr; };
constexpr int L_NEXT = 131072 + 128;

#define ATT_WAIT_V(n) asm volatile("s_waitcnt vmcnt(" #n ")" ::: "memory")

template <int MODE>
__device__ __forceinline__ void attn_unit(const AP P, const int qb, LAS unsigned char* lds, const int wv) {
    constexpr int DQK = (MODE == 0) ? 96 : 64, NQ = DQK / 16;
    constexpr int PG = (MODE == 1) ? 2 : 3;
    const int lane = lane_now(), r32 = lane & 31, hi = lane >> 5;
    const int wid = wv, tid = wv * 64 + lane;
    const int q0 = qb * 256;
    const int cw = 4 * qb + (wid >> 1);
    int t0 = 0; const int t1 = 4 * qb + 4;
    if (MODE == 1) t0 = (4 * qb - 8) > 0 ? (4 * qb - 8) : 0;
    const int qrel = 32 * (wid & 1) + r32;
    const bf16_t* ksrc = P.K + (size_t)lane * P.kp + wid * 8;
    const bf16_t* k2src = (MODE == 0) ? (P.K2 + (size_t)lane * P.k2p + (wid & 3) * 8) : nullptr;
    const bf16_t* vsrc = P.V + (size_t)(16 * (wid & 3) + (lane >> 2)) * P.vp + (wid >> 2) * 32 + (lane & 3) * 8;
    const float* gsrc = (MODE == 2) ? (P.kb + lane) : nullptr;
#define ATT_DMA_K(t) do { const int sl_ = ((t) - t0) & (NSLOT - 1); \
        __builtin_amdgcn_global_load_lds((const unsigned*)(ksrc + (size_t)(t) * 64 * P.kp), (LAS unsigned*)(lds + L_K + sl_ * KSLOT + wid * 1024), 16, 0, 0); \
        if (MODE == 0) __builtin_amdgcn_global_load_lds((const unsigned*)(k2src + (size_t)(t) * 64 * P.k2p), (LAS unsigned*)(lds + L_K + sl_ * KSLOT + 8192 + (wid & 3) * 1024), 16, 0, 0); } while (0)
#define ATT_DMA_V(t) do { const int sl_ = ((t) - t0) & (NSLOT - 1); \
        __builtin_amdgcn_global_load_lds((const unsigned*)(vsrc + (size_t)(t) * 64 * P.vp), (LAS unsigned*)(lds + L_V + sl_ * VSLOT + wid * 1024), 16, 0, 0); \
        if (MODE == 2) __builtin_amdgcn_global_load_lds((const unsigned*)(gsrc + (t) * 64), (LAS unsigned*)(lds + L_GB + (sl_ * 8 + wid) * 256), 4, 0, 0); } while (0)
#define ATT_VALID(t) (((t) <= cw) && (MODE != 1 || (t) >= cw - 8))
    ATT_DMA_K(t0); ATT_DMA_K(t0 + 1); ATT_DMA_K(t0 + 2); ATT_DMA_K(t0 + 3); ATT_DMA_V(t0); ATT_DMA_V(t0 + 1);
    bf16x8 qr[NQ];
    {
        const bf16_t* Qw = P.Q + (size_t)(q0 + wid * 32 + r32) * P.qp + hi * 8;
#pragma unroll
        for (int d0 = 0; d0 < NQ; ++d0) qr[d0] = *(const bf16x8*)(Qw + d0 * 16);
    }
    if (MODE == 1) { LAS float* tb = (LAS float*)(lds + L_TB); for (int i = tid; i < 257; i += 512) tb[i] = P.kb[i] * LOG2E; }
    float m_run = NEG, l_run = 0.f;
    f32x16 o0, o1;
#pragma unroll
    for (int r = 0; r < 16; ++r) { o0[r] = 0.f; o1[r] = 0.f; }
    LAS float* wsf = (LAS float*)(lds + L_WS) + wid * 64;
    const int vboff = ((lane >> 4) & 1) * 32 + (lane & 3) * 8 + (4 * hi + ((lane & 15) >> 2)) * 64;
    const LAS unsigned char* kbase = lds + L_K + hi * 1024 + r32 * 16;
    bf16x8 kf[2 * NQ];
    f32x16 sc0, sc1;
#define ATT_KLOAD(t) do { const LAS unsigned char* kp_ = kbase + (((t) - t0) & (NSLOT - 1)) * KSLOT; \
        _Pragma("unroll") for (int d0 = 0; d0 < NQ; ++d0) { kf[2 * d0] = *(const LAS bf16x8*)(kp_ + d0 * 2048); kf[2 * d0 + 1] = *(const LAS bf16x8*)(kp_ + d0 * 2048 + 512); } } while (0)
#define ATT_QK(d0_, d1_) do { _Pragma("unroll") for (int r = 0; r < 16; ++r) { d0_[r] = 0.f; d1_[r] = 0.f; } \
        _Pragma("unroll") for (int d0 = 0; d0 < NQ; ++d0) { d0_ = __builtin_amdgcn_mfma_f32_32x32x16_bf16(kf[2 * d0], qr[d0], d0_, 0, 0, 0); d1_ = __builtin_amdgcn_mfma_f32_32x32x16_bf16(kf[2 * d0 + 1], qr[d0], d1_, 0, 0, 0); } } while (0)
    ATT_WAIT_V(0);
    asm volatile("s_waitcnt lgkmcnt(0)" ::: "memory");
    __builtin_amdgcn_s_barrier();
    asm volatile("" ::: "memory");
    ATT_KLOAD(t0);
    ATT_QK(sc0, sc1);
    ATT_KLOAD(t0 + 1);
    for (int t = t0; t < t1; ++t) {
        const int cur = (t - t0) & (NSLOT - 1);
        {
            if (t + 3 < t1) { if (PG == 2) ATT_WAIT_V(2); else ATT_WAIT_V(3); } else ATT_WAIT_V(0);
            asm volatile("s_waitcnt lgkmcnt(0)" ::: "memory");
            __builtin_amdgcn_s_barrier();
            asm volatile("" ::: "memory");
        }
        if (t + 4 < t1) ATT_DMA_K(t + 4);
        if (t + 2 < t1) ATT_DMA_V(t + 2);
        const bool vcur = ATT_VALID(t), vnext = (t + 1 < t1) && ATT_VALID(t + 1);
        f32x16 sn0, sn1;
        if (vnext) ATT_QK(sn0, sn1);
        if (t + 2 < t1) ATT_KLOAD(t + 2);
        if (vcur) {
            f32x16 p0 = sc0, p1 = sc1;
            if (MODE == 2) {
                const LAS float* gp = (const LAS float*)(lds + L_GB + (cur * 8 + wid) * 256) + 4 * hi;
#pragma unroll
                for (int g4 = 0; g4 < 4; ++g4) {
                    const f32x4 a = *(const LAS f32x4*)(gp + 8 * g4), b = *(const LAS f32x4*)(gp + 32 + 8 * g4);
#pragma unroll
                    for (int i = 0; i < 4; ++i) { p0[4 * g4 + i] += a[i]; p1[4 * g4 + i] += b[i]; }
                }
                if (t == cw) {
#pragma unroll
                    for (int r = 0; r < 16; ++r) { const int kj = (r & 3) + 8 * (r >> 2) + 4 * hi; if (kj > qrel) p0[r] = NEG; if (kj + 32 > qrel) p1[r] = NEG; }
                }
            }
            if (MODE == 1) {
                const LAS float* tb = (const LAS float*)(lds + L_TB);
                const int mm = cw - t;
                if (mm >= 3) {
                    const float c = tb[256];
#pragma unroll
                    for (int r = 0; r < 16; ++r) { p0[r] += c; p1[r] += c; }
                } else {
                    const int base = 64 * mm + qrel - 4 * hi;
#pragma unroll
                    for (int r = 0; r < 16; ++r) {
                        const int c0 = (r & 3) + 8 * (r >> 2);
                        int i0 = base - c0; i0 = (i0 > 128 ? 128 : i0) + 128;
                        int i1 = base - c0 - 32; i1 = (i1 > 128 ? 128 : i1) + 128;
                        p0[r] += tb[i0]; p1[r] += tb[i1];
                    }
                }
            }
            float rm = fmaxf(p0[0], p1[0]);
#pragma unroll
            for (int r = 1; r < 16; ++r) rm = fmaxf(rm, fmaxf(p0[r], p1[r]));
            rm = fmaxf(rm, shfl_xor_l(rm, 32, lane));
            if (__any(rm > m_run + THR)) {
                const float mn = fmaxf(m_run, rm);
                const float f = __builtin_amdgcn_exp2f(m_run - mn);
                m_run = mn; l_run *= f;
                if (hi == 0) wsf[r32] = f;
                asm volatile("" ::: "memory");
#pragma unroll
                for (int g4 = 0; g4 < 4; ++g4) {
                    const f32x4 fv = *(const LAS f32x4*)(wsf + 8 * g4 + 4 * hi);
#pragma unroll
                    for (int i = 0; i < 4; ++i) { o0[4 * g4 + i] *= fv[i]; o1[4 * g4 + i] *= fv[i]; }
                }
            }
            float s = 0.f;
#pragma unroll
            for (int r = 0; r < 16; ++r) { p0[r] = __builtin_amdgcn_exp2f(p0[r] - m_run); p1[r] = __builtin_amdgcn_exp2f(p1[r] - m_run); s += p0[r] + p1[r]; }
            l_run += s;
            u32x4 pw[4];
            pw[0] = (u32x4){cvtpk(p0[0], p0[1]), cvtpk(p0[2], p0[3]), cvtpk(p0[4], p0[5]), cvtpk(p0[6], p0[7])};
            pw[1] = (u32x4){cvtpk(p0[8], p0[9]), cvtpk(p0[10], p0[11]), cvtpk(p0[12], p0[13]), cvtpk(p0[14], p0[15])};
            pw[2] = (u32x4){cvtpk(p1[0], p1[1]), cvtpk(p1[2], p1[3]), cvtpk(p1[4], p1[5]), cvtpk(p1[6], p1[7])};
            pw[3] = (u32x4){cvtpk(p1[8], p1[9]), cvtpk(p1[10], p1[11]), cvtpk(p1[12], p1[13]), cvtpk(p1[14], p1[15])};
            const unsigned vb = (unsigned)(uintptr_t)(lds + L_V + cur * VSLOT + vboff);
#pragma unroll
            for (int d0 = 0; d0 < 2; ++d0) {
                s16x4 lo[4], hh[4];
#pragma unroll
                for (int ks = 0; ks < 4; ++ks) {
                    asm volatile("ds_read_b64_tr_b16 %0, %1 offset:%c2" : "=&v"(lo[ks]) : "v"(vb), "i"(d0 * 4096 + ks * 1024) : "memory");
                    asm volatile("ds_read_b64_tr_b16 %0, %1 offset:%c2" : "=&v"(hh[ks]) : "v"(vb), "i"(d0 * 4096 + ks * 1024 + 512) : "memory");
                }
                asm volatile("s_waitcnt lgkmcnt(0)" ::: "memory"); __builtin_amdgcn_sched_barrier(0);
#pragma unroll
                for (int ks = 0; ks < 4; ++ks) {
                    const bf16x8 pa = __builtin_bit_cast(bf16x8, pw[ks]);
                    const bf16x8 vf = {lo[ks][0], lo[ks][1], lo[ks][2], lo[ks][3], hh[ks][0], hh[ks][1], hh[ks][2], hh[ks][3]};
                    if (d0 == 0) o0 = __builtin_amdgcn_mfma_f32_32x32x16_bf16(pa, vf, o0, 0, 0, 0);
                    else o1 = __builtin_amdgcn_mfma_f32_32x32x16_bf16(pa, vf, o1, 0, 0, 0);
                }
            }
        }
        if (vnext) { sc0 = sn0; sc1 = sn1; }
    }
    unsigned nxt_unit = 0u;
    if (tid == 0) nxt_unit = __hip_atomic_fetch_add(P.ctr, 1u, __ATOMIC_RELAXED, __HIP_MEMORY_SCOPE_AGENT);
    l_run += shfl_xor_l(l_run, 32, lane);
    if (hi == 0) wsf[32 + r32] = l_run;
    asm volatile("" ::: "memory");
    float rli[16];
#pragma unroll
    for (int g4 = 0; g4 < 4; ++g4) {
        const f32x4 lv = *(const LAS f32x4*)(wsf + 32 + 8 * g4 + 4 * hi);
#pragma unroll
        for (int i = 0; i < 4; ++i) rli[4 * g4 + i] = 1.0f / lv[i];
    }
    LAS bf16_t* stg = (LAS bf16_t*)(lds + L_OST) + wid * 2048;
#pragma unroll
    for (int r = 0; r < 16; ++r) {
        const int orow = (r & 3) + 8 * (r >> 2) + 4 * hi;
        stg[orow * 64 + r32] = (bf16_t)(cvtpk(o0[r] * rli[r], 0.f) & 0xffffu);
        stg[orow * 64 + 32 + r32] = (bf16_t)(cvtpk(o1[r] * rli[r], 0.f) & 0xffffu);
    }
    asm volatile("" ::: "memory");
#pragma unroll
    for (int i = 0; i < 4; ++i) {
        const int row = i * 8 + (lane >> 3), ch = lane & 7;
        const u32x4 v = *(const LAS u32x4*)(stg + row * 64 + ch * 8);
        const size_t grow = (size_t)(q0 + wid * 32 + row);
        const u32x4 gt = *(const u32x4*)(P.gate + grow * NZ + ch * 8);
        u32x4 w;
        w.x = cvtpk(bf_lo(v.x) * bf_lo(gt.x), bf_hi(v.x) * bf_hi(gt.x));
        w.y = cvtpk(bf_lo(v.y) * bf_lo(gt.y), bf_hi(v.y) * bf_hi(gt.y));
        w.z = cvtpk(bf_lo(v.z) * bf_lo(gt.z), bf_hi(v.z) * bf_hi(gt.z));
        w.w = cvtpk(bf_lo(v.w) * bf_lo(gt.w), bf_hi(v.w) * bf_hi(gt.w));
        *(u32x4*)(P.out + grow * DM + ch * 8) = w;
    }
    if (tid == 0) *(volatile LAS unsigned*)(lds + L_NEXT) = nxt_unit;
    __syncthreads();
#undef ATT_DMA_K
#undef ATT_DMA_V
#undef ATT_VALID
#undef ATT_KLOAD
#undef ATT_QK
}
}


namespace fa {
constexpr int NW = 8, QBLK = 32, KVBLK = 64;
constexpr int NSLOT = 3, SLOTB = 8192;
template <int MODE> struct Map {
    static constexpr int KSLOT = (MODE == 0) ? 12288 : 8192;
    static constexpr int LDS_K = 0, LDS_V = NSLOT * KSLOT, LDS_WS = LDS_V + NSLOT * SLOTB, LDS_OST = LDS_WS + NW * 64 * 4, LDS_TB = LDS_OST + NW * 4096, LDS_G = LDS_TB + 2048, LDS_END = LDS_G + 8192;
    static_assert(LDS_END <= 131072, "fast attention LDS map");
};
typedef LAS const unsigned char* lds_cptr;
#define SBAR() __builtin_amdgcn_sched_barrier(0)
__device__ __forceinline__ int crow(int r, int hi) { return (r & 3) + 8 * (r >> 2) + 4 * hi; }
__device__ __forceinline__ void glds16(const void* gsrc, unsigned lds_dst) { unsigned keep;
    asm volatile("s_mov_b32 %0, m0\n\ts_mov_b32 m0, %2\n\ts_nop 0\n\tglobal_load_lds_dwordx4 %1, off\n\ts_mov_b32 m0, %0" : "=&s"(keep) : "v"(gsrc), "s"(lds_dst) : "memory"); }
__device__ __forceinline__ void glds16s(const void* sbase, unsigned voff, unsigned lds_dst) { unsigned keep;
    asm volatile("s_mov_b32 %0, m0\n\ts_mov_b32 m0, %3\n\ts_nop 0\n\tglobal_load_lds_dwordx4 %1, %2\n\ts_mov_b32 m0, %0" : "=&s"(keep) : "v"(voff), "s"(sbase), "s"(lds_dst) : "memory"); }
__device__ __forceinline__ float max3f(float a, float b, float c) { float r; asm("v_max3_f32 %0, %1, %2, %3" : "=v"(r) : "v"(a), "v"(b), "v"(c)); return r; }
__device__ __forceinline__ float max2f(float a, float b) { float r; asm("v_max_f32_e32 %0, %1, %2" : "=v"(r) : "v"(a), "v"(b)); return r; }
__device__ __forceinline__ float fadd_s(float a, float b) { float r; asm("v_add_f32_e32 %0, %1, %2" : "=v"(r) : "v"(a), "v"(b)); return r; }
__device__ __forceinline__ float fsub_s(float a, float b) { float r; asm("v_sub_f32_e32 %0, %1, %2" : "=v"(r) : "v"(a), "v"(b)); return r; }
#define WAIT_BAR(N) asm volatile("s_waitcnt vmcnt(" #N ") lgkmcnt(0)\n\ts_barrier" ::: "memory")
__device__ __forceinline__ void kx_init(int* kx, int r32, int hi) {
    const int a0 = (r32 >> 3) * 1024 + (r32 & 7) * 128, sw = (r32 >> 1) & 7;
#pragma unroll
    for (int d0 = 0; d0 < 4; ++d0) kx[d0] = a0 + (((2 * d0 + hi) ^ sw) << 4);
}
template <int NQ>
__device__ __forceinline__ void qkt(f32x16& p0, f32x16& p1, lds_cptr Kslot, const bf16x8* qr, const f32x16& negm, int r32, int hi, const int* kx) {
    lds_cptr kb = Kslot + hi * 1024 + r32 * 16;
#pragma unroll
    for (int d0 = 0; d0 < NQ; ++d0) {
        const bf16x8 b0 = (d0 < 4) ? *(const LAS bf16x8*)(Kslot + kx[d0 & 3]) : *(const LAS bf16x8*)(kb + d0 * 2048);
        const bf16x8 b1 = (d0 < 4) ? *(const LAS bf16x8*)(Kslot + kx[d0 & 3] + 4096) : *(const LAS bf16x8*)(kb + d0 * 2048 + 512);
        if (d0 == 0) { p0 = __builtin_amdgcn_mfma_f32_32x32x16_bf16(b0, qr[0], negm, 0, 0, 0); p1 = __builtin_amdgcn_mfma_f32_32x32x16_bf16(b1, qr[0], negm, 0, 0, 0); }
        else { p0 = __builtin_amdgcn_mfma_f32_32x32x16_bf16(b0, qr[d0], p0, 0, 0, 0); p1 = __builtin_amdgcn_mfma_f32_32x32x16_bf16(b1, qr[d0], p1, 0, 0, 0); } }
}
__device__ __forceinline__ void kload2(bf16x8* kf, lds_cptr kslot, int j, const int* kx) { kf[2 * j] = *(const LAS bf16x8*)(kslot + kx[j]); kf[2 * j + 1] = *(const LAS bf16x8*)(kslot + kx[j] + 4096); }
__device__ __forceinline__ void kload8(bf16x8* kf, lds_cptr kslot, const int* kx) {
#pragma unroll
    for (int j = 0; j < 4; ++j) kload2(kf, kslot, j, kx);
}
__device__ __forceinline__ s16x4 vtr(lds_cptr p) { return __builtin_bit_cast(s16x4, __builtin_amdgcn_ds_read_tr16_b64_v4i16((LAS s16x4*)p)); }
__device__ __forceinline__ float rowmax(const f32x16& p0, const f32x16& p1) {
    float a = max3f(p0[0], p0[1], p1[0]), b = max3f(p0[2], p0[3], p1[1]); a = max3f(a, p1[2], p1[3]);
#pragma unroll
    for (int r = 4; r < 16; r += 4) { a = max3f(a, p0[r], p0[r + 1]); b = max3f(b, p0[r + 2], p0[r + 3]); a = max3f(a, p1[r], p1[r + 1]); b = max3f(b, p1[r + 2], p1[r + 3]); }
    const float m = max2f(a, b);
    auto rr = __builtin_amdgcn_permlane32_swap(__float_as_uint(m), __float_as_uint(m), false, false);
    return max2f(__uint_as_float(rr[0]), __uint_as_float(rr[1]));
}
__device__ __forceinline__ void pv(f32x16* o, int vb, bf16x8 pa0, bf16x8 pa1, bf16x8 pa2, bf16x8 pa3) {
#pragma unroll
    for (int d0 = 0; d0 < 2; ++d0) { s16x4 lo[4], hi[4];
#pragma unroll
        for (int ks = 0; ks < 4; ++ks) {
            asm volatile("ds_read_b64_tr_b16 %0,%1 offset:%c2" : "=&v"(lo[ks]) : "v"(vb), "i"(d0 * 4096 + ks * 1024) : "memory");
            asm volatile("ds_read_b64_tr_b16 %0,%1 offset:%c2" : "=&v"(hi[ks]) : "v"(vb), "i"(d0 * 4096 + ks * 1024 + 512) : "memory"); }
        asm volatile("s_waitcnt lgkmcnt(0)" ::: "memory"); SBAR();
#define PK(k) (bf16x8){lo[k][0], lo[k][1], lo[k][2], lo[k][3], hi[k][0], hi[k][1], hi[k][2], hi[k][3]}
        o[d0] = __builtin_amdgcn_mfma_f32_32x32x16_bf16(pa0, PK(0), o[d0], 0, 0, 0);
        o[d0] = __builtin_amdgcn_mfma_f32_32x32x16_bf16(pa1, PK(1), o[d0], 0, 0, 0);
        o[d0] = __builtin_amdgcn_mfma_f32_32x32x16_bf16(pa2, PK(2), o[d0], 0, 0, 0);
        o[d0] = __builtin_amdgcn_mfma_f32_32x32x16_bf16(pa3, PK(3), o[d0], 0, 0, 0);
#undef PK
    }
}
template <int MODE>
__device__ __forceinline__ void bias_mask(f32x16& p0, f32x16& p1, int ta, int qb, int cw, int qrelu, int qrel64, int hi, const LAS float* tab) {
    if (MODE == 0) {
        if (ta > cw) {
            asm volatile("" ::: "memory");
            const float NEGI = -INFINITY;
#pragma unroll
            for (int r = 0; r < 16; ++r) { p0[r] = NEGI; p1[r] = NEGI; }
        }
    } else if (MODE == 2) {
        const LAS float* gp = tab + 64 * ta + 4 * hi;
#pragma unroll
        for (int g4 = 0; g4 < 4; ++g4) {
            const f32x4 a = *(const LAS f32x4*)(gp + 8 * g4), b = *(const LAS f32x4*)(gp + 32 + 8 * g4);
#pragma unroll
            for (int i = 0; i < 4; ++i) { p0[4 * g4 + i] += a[i]; p1[4 * g4 + i] += b[i]; }
            if (g4 == 1) { asm volatile("" : "+v"(p0), "+v"(p1) :: "memory"); }
        }
        const int jb = ta - 4 * qb;
        if (jb >= 0) {
            const float NEGI = -INFINITY; const int kb = 64 * jb + 4 * hi;
#pragma unroll
            for (int r = 0; r < 16; ++r) { const int kv = kb + (r & 3) + 8 * (r >> 2); if (kv > qrelu) p0[r] = NEGI; if (kv + 32 > qrelu) p1[r] = NEGI; }
        }
    } else {
        const int mm = cw - ta;
        if (mm < 0 || mm > 8) {
            const float NEGI = -INFINITY;
#pragma unroll
            for (int r = 0; r < 16; ++r) { p0[r] = NEGI; p1[r] = NEGI; }
        } else if (mm >= 3) {
            const float c = tab[256];
#pragma unroll
            for (int r = 0; r < 16; ++r) { p0[r] += c; p1[r] += c; }
        } else {
            const int base = 64 * mm + qrel64 - 4 * hi;
            const LAS float* tp = tab + (base + 128 - 59);
#pragma unroll
            for (int r = 0; r < 16; ++r) {
                const int c0 = (r & 3) + 8 * (r >> 2);
                p0[r] += tp[59 - c0]; p1[r] += tp[27 - c0];
            }
        }
    }
}

template <int MODE, int THRL>
__device__ __forceinline__ void attn_unit(const att::AP P, const int qb, LAS unsigned char* lds, const int wv) {
    constexpr int NQ = (MODE == 0) ? 6 : 4;
    constexpr int LDS_K = Map<MODE>::LDS_K, LDS_V = Map<MODE>::LDS_V, LDS_WS = Map<MODE>::LDS_WS, LDS_OST = Map<MODE>::LDS_OST, LDS_TB = Map<MODE>::LDS_TB, LDS_G = Map<MODE>::LDS_G;
    const int lane = lane_now(), r32 = lane & 31, hi = lane >> 5;
    const int wid = wv, tid = wv * 64 + lane;
    const int q0 = qb * 256;
    const int cw = 4 * qb + (wid >> 1);
    int t0 = 0; const int t1 = 4 * qb + 4;
    if (MODE == 1) t0 = (4 * qb - 8) > 0 ? (4 * qb - 8) : 0;
    const int NT = t1 - t0;
#define KOFF(sl) ((MODE == 0) ? ((sl) + ((sl) >> 1)) : (sl))
    const int qrelu = wid * QBLK + r32;
    const int qrel64 = 32 * (wid & 1) + r32;
    LAS float* tab = (LAS float*)(lds + (MODE == 2 ? LDS_G : LDS_TB));
    const bf16_t* Qw = P.Q + (size_t)(q0 + wid * QBLK) * P.qp;
    const bf16_t* Kh = P.K + (size_t)(t1 - 1) * KVBLK * P.kp; const bf16_t* Vh = P.V + (size_t)(t1 - 1) * KVBLK * P.vp;
    const unsigned lds0 = (unsigned)(uintptr_t)lds;
    LAS float* wsf = (LAS float*)(lds + LDS_WS) + wid * 64;
    const unsigned kvo = (unsigned)((8 * wid + (lane >> 3)) * P.kp + (((lane & 7) ^ (((wid & 1) << 2) | (lane >> 4))) * 8)) * 2u, vvo = (unsigned)((16 * (wid & 3) + (lane >> 2)) * P.vp + (wid >> 2) * 32 + (lane & 3) * 8) * 2u;
    const unsigned kdst = lds0 + LDS_K + wid * 1024, vdst = lds0 + LDS_V + wid * 1024;
    const bf16_t* K2h = (MODE == 0) ? (P.K2 + (size_t)(t1 - 1) * KVBLK * P.k2p) : nullptr; const unsigned k2vo = (MODE == 0) ? (unsigned)(lane * P.k2p + (wid & 3) * 8) * 2u : 0u;
    const unsigned k2dst = lds0 + LDS_K + 8192 + (wid & 3) * 1024;
#define DMA_K(t, slot) glds16s(Kh - (size_t)(t) * KVBLK * P.kp, kvo, (unsigned)__builtin_amdgcn_readfirstlane(kdst + KOFF(slot)))
#define DMA_K2(t, slot) glds16s(K2h - (size_t)(t) * KVBLK * P.k2p, k2vo, (unsigned)__builtin_amdgcn_readfirstlane(k2dst + KOFF(slot)))
#define DMA_V(t, slot) glds16s(Vh - (size_t)(t) * KVBLK * P.vp, vvo, (unsigned)__builtin_amdgcn_readfirstlane(vdst + (slot)))
    const int vb0 = (int)(lds0 + LDS_V) + ((lane >> 4) & 1) * 32 + (lane & 3) * 8 + (4 * hi + ((lane & 15) >> 2)) * 64;
    lds_cptr Kbase = lds + LDS_K; bf16x8 kf[8];
    int kx[4]; kx_init(kx, r32, hi);
    lds_cptr kp0 = lds + LDS_K + hi * 1024 + r32 * 16; lds_cptr vp0 = lds + LDS_V + ((lane >> 4) & 1) * 32 + (lane & 3) * 8 + (4 * hi + ((lane & 15) >> 2)) * 64;
    DMA_K(0, 0); if (MODE == 0) DMA_K2(0, 0); DMA_V(0, 0); DMA_K(1, SLOTB); if (MODE == 0) DMA_K2(1, SLOTB);
    bf16x8 qr[NQ];
#pragma unroll
    for (int d0 = 0; d0 < NQ; ++d0) qr[d0] = *(const bf16x8*)(Qw + (size_t)r32 * P.qp + d0 * 16 + hi * 8);
    if (MODE == 2) { if (4 * tid < t1 * 64) { const f32x4 g = *(const f32x4*)(P.kb + 4 * tid); *(LAS f32x4*)(tab + 4 * tid) = g; } }
    else if (MODE == 1) { if (tid < 320) tab[tid] = P.kb[tid < 256 ? tid : 256] * LOG2E; }
    float mhat = 0.f, l_reg = 0.f; f32x16 o[2];
#pragma unroll
    for (int r = 0; r < 16; ++r) { o[0][r] = 0.f; o[1][r] = 0.f; }
    f32x16 negm;
#pragma unroll
    for (int r = 0; r < 16; ++r) negm[r] = 0.f;
    asm volatile("" : "+v"(negm));
#define BMASK(P0, P1, t, BAND) bias_mask<MODE>(P0, P1, t1 - 1 - (t), qb, cw, qrelu, qrel64, hi, tab)
    bool resc = false;
#define START(P0, P1) do { const float rm = rowmax(P0, P1); resc = false; \
    { const float dl = __builtin_fmaxf(rm, -1.0e4f); mhat = fadd_s(mhat, dl); \
      _Pragma("unroll") for (int r = 0; r < 16; ++r) { P0[r] = fsub_s(P0[r], dl); P1[r] = fsub_s(P1[r], dl); } \
      _Pragma("unroll") for (int r = 0; r < 16; ++r) negm[r] = -mhat; asm volatile("" : "+v"(negm)); } \
    _Pragma("unroll") for (int r = 0; r < 16; ++r) P0[r] = __builtin_amdgcn_exp2f(P0[r]); } while (0)
#define RESC() do { if (resc) { asm volatile("s_waitcnt lgkmcnt(0)" ::: "memory"); \
      _Pragma("unroll") for (int d_ = 0; d_ < 2; ++d_) _Pragma("unroll") for (int r = 0; r < 16; ++r) o[d_][r] *= wsf[crow(r, hi)]; } } while (0)
    f32x16 pA0, pA1, pB0, pB1;
    int sl_prev = 0, sl_cur = 0, sl_next = SLOTB;
#define ROT() do { sl_prev = sl_cur; sl_cur = sl_next; sl_next = (sl_next == (NSLOT - 1) * SLOTB) ? 0 : sl_next + SLOTB; } while (0)
    DMA_K(2, 2 * SLOTB);
    if (MODE == 0) WAIT_BAR(4); else WAIT_BAR(3);
    qkt<NQ>(pA0, pA1, Kbase, qr, negm, r32, hi, kx); asm volatile("s_nop 15\n\ts_nop 7" : "+v"(pA0), "+v"(pA1)); BMASK(pA0, pA1, 0, true);
    START(pA0, pA1);
#pragma unroll
    for (int r = 0; r < 16; ++r) pA1[r] = __builtin_amdgcn_exp2f(pA1[r]);
    WAIT_BAR(0);
    DMA_K(3, 0); if (MODE == 0) DMA_K2(2, 2 * SLOTB); DMA_V(1, SLOTB);
    ROT();
    kload8(kf, Kbase + KOFF(sl_cur), kx);
    if (MODE == 0) WAIT_BAR(3); else WAIT_BAR(2);
    s16x4 vlo[8], vhi[8]; u32x4 pw0, pw1, pw2, pw3;
#define PKW(P, B) cvtpk(P[B], P[B + 1])
#define PAF(k) __builtin_bit_cast(bf16x8, pw##k)
#define VFR(i) (bf16x8){vlo[i][0], vlo[i][1], vlo[i][2], vlo[i][3], vhi[i][0], vhi[i][1], vhi[i][2], vhi[i][3]}
#define PIN(x) asm volatile("" : "+v"(x))
#define MX3(a, b, c) __builtin_fmaxf(__builtin_fmaxf((a), (b)), (c))
#define GAPA(MF, A0, A1, A2, A3, W0, W1, PW) do { MF; sacc += A0; sacc += A1; sacc += A2; sacc += A3; PIN(sacc); W0; W1; PIN(PW); SBAR(); } while (0)
#define EX(v) __builtin_amdgcn_exp2f(v)
#define GAPB(MF, X, B) do { MF; X[B] = EX(X[B]); X[B + 1] = EX(X[B + 1]); X[B + 2] = EX(X[B + 2]); X[B + 3] = EX(X[B + 3]); PIN(X); SBAR(); } while (0)
#define VRD(i) do { vlo[i] = vtr(vp_ + (((i) >> 2) * 4096 + ((i) & 3) * 1024)); vhi[i] = vtr(vp_ + (((i) >> 2) * 4096 + ((i) & 3) * 1024 + 512)); } while (0)
#define KRD(G, j) do { if (G) { kload2(kf, Kbase + KOFF(sl_next), j, kx); SBAR(); } } while (0)
#define STEP(C0, C1, P0, P1, t, GK, GK2, GV, GL, BAND) do { SBAR(); \
    lds_cptr vp_ = vp0 + sl_prev; \
    bf16x8 kr0, kr1, kr2, kr3; \
    if (MODE == 0) { lds_cptr kq_ = kp0 + KOFF(sl_cur) + 8192; kr0 = *(const LAS bf16x8*)(kq_); kr1 = *(const LAS bf16x8*)(kq_ + 512); kr2 = *(const LAS bf16x8*)(kq_ + 2048); kr3 = *(const LAS bf16x8*)(kq_ + 2560); SBAR(); } \
    VRD(0); SBAR(); float sacc = (P0[0] + P0[1]); \
    GAPA(C0 = __builtin_amdgcn_mfma_f32_32x32x16_bf16(kf[0], qr[0], negm, 0, 0, 0), P0[2], P0[3], P0[4], P0[5],     pw0[0] = PKW(P0, 0), pw0[1] = PKW(P0, 2), pw0); \
    VRD(4); SBAR(); GAPA(C1 = __builtin_amdgcn_mfma_f32_32x32x16_bf16(kf[1], qr[0], negm, 0, 0, 0), P0[6], P0[7], P0[8], P0[9],     pw0[2] = PKW(P0, 4), pw0[3] = PKW(P0, 6), pw0); \
    VRD(1); SBAR(); GAPA(C0 = __builtin_amdgcn_mfma_f32_32x32x16_bf16(kf[2], qr[1], C0, 0, 0, 0),   P0[10], P0[11], P0[12], P0[13], pw1[0] = PKW(P0, 8), pw1[1] = PKW(P0, 10), pw1); \
    VRD(5); SBAR(); GAPA(C1 = __builtin_amdgcn_mfma_f32_32x32x16_bf16(kf[3], qr[1], C1, 0, 0, 0),   P0[14], P0[15], P1[0], P1[1],   pw1[2] = PKW(P0, 12), pw1[3] = PKW(P0, 14), pw1); \
    VRD(2); SBAR(); GAPA(C0 = __builtin_amdgcn_mfma_f32_32x32x16_bf16(kf[4], qr[2], C0, 0, 0, 0),   P1[2], P1[3], P1[4], P1[5],     pw2[0] = PKW(P1, 0), pw2[1] = PKW(P1, 2), pw2); \
    VRD(6); SBAR(); GAPA(C1 = __builtin_amdgcn_mfma_f32_32x32x16_bf16(kf[5], qr[2], C1, 0, 0, 0),   P1[6], P1[7], P1[8], P1[9],     pw2[2] = PKW(P1, 4), pw2[3] = PKW(P1, 6), pw2); \
    VRD(3); SBAR(); GAPA(C0 = __builtin_amdgcn_mfma_f32_32x32x16_bf16(kf[6], qr[3], C0, 0, 0, 0),   P1[10], P1[11], P1[12], P1[13], pw3[0] = PKW(P1, 8), pw3[1] = PKW(P1, 10), pw3); \
    VRD(7); SBAR(); GAPA(C1 = __builtin_amdgcn_mfma_f32_32x32x16_bf16(kf[7], qr[3], C1, 0, 0, 0),   P1[14], P1[15], 0.f, 0.f,       pw3[2] = PKW(P1, 12), pw3[3] = PKW(P1, 14), pw3); \
    if (MODE == 0) { \
        C0 = __builtin_amdgcn_mfma_f32_32x32x16_bf16(kr0, qr[NQ - 2], C0, 0, 0, 0); C1 = __builtin_amdgcn_mfma_f32_32x32x16_bf16(kr1, qr[NQ - 2], C1, 0, 0, 0); \
        C0 = __builtin_amdgcn_mfma_f32_32x32x16_bf16(kr2, qr[NQ - 1], C0, 0, 0, 0); C1 = __builtin_amdgcn_mfma_f32_32x32x16_bf16(kr3, qr[NQ - 1], C1, 0, 0, 0); SBAR(); } \
    l_reg += sacc; \
    if (GK) { DMA_K((t) + 3, sl_cur); } if (MODE == 0 && (GK2)) { DMA_K2((t) + 2, sl_prev); } if (GV) { DMA_V((t) + 1, sl_next); } \
    BMASK(C0, C1, t, BAND); \
    { float a = MX3(C0[0], C0[1], C1[0]), b = MX3(C0[2], C0[3], C1[1]); a = MX3(a, C1[2], C1[3]); \
      _Pragma("unroll") for (int r = 4; r < 16; r += 4) { a = MX3(a, C0[r], C0[r + 1]); b = MX3(b, C0[r + 2], C0[r + 3]); a = MX3(a, C1[r], C1[r + 1]); b = MX3(b, C1[r + 2], C1[r + 3]); } \
      float rm = __builtin_fmaxf(a, b); { auto rr = __builtin_amdgcn_permlane32_swap(__float_as_uint(rm), __float_as_uint(rm), false, false); rm = __builtin_fmaxf(__uint_as_float(rr[0]), __uint_as_float(rr[1])); } \
      resc = false; \
      if (__builtin_expect(__any(rm > (float)THRL), 0)) { const float dl = __builtin_fmaxf(rm, 0.f); mhat += dl; \
        _Pragma("unroll") for (int r = 0; r < 16; ++r) { C0[r] -= dl; C1[r] -= dl; } \
        _Pragma("unroll") for (int r = 0; r < 16; ++r) negm[r] = -mhat; asm volatile("" : "+v"(negm)); \
        const float f = __builtin_amdgcn_exp2f(-dl); l_reg *= f; if (hi == 0) wsf[r32] = f; resc = true; } } \
    SBAR(); \
    GAPB(o[0] = __builtin_amdgcn_mfma_f32_32x32x16_bf16(PAF(0), VFR(0), o[0], 0, 0, 0), C0, 0); \
    GAPB(o[1] = __builtin_amdgcn_mfma_f32_32x32x16_bf16(PAF(0), VFR(4), o[1], 0, 0, 0), C0, 4); \
    KRD(GL, 0); GAPB(o[0] = __builtin_amdgcn_mfma_f32_32x32x16_bf16(PAF(1), VFR(1), o[0], 0, 0, 0), C0, 8); \
    KRD(GL, 1); GAPB(o[1] = __builtin_amdgcn_mfma_f32_32x32x16_bf16(PAF(1), VFR(5), o[1], 0, 0, 0), C0, 12); \
    KRD(GL, 2); GAPB(o[0] = __builtin_amdgcn_mfma_f32_32x32x16_bf16(PAF(2), VFR(2), o[0], 0, 0, 0), C1, 0); \
    KRD(GL, 3); GAPB(o[1] = __builtin_amdgcn_mfma_f32_32x32x16_bf16(PAF(2), VFR(6), o[1], 0, 0, 0), C1, 4); \
    GAPB(o[0] = __builtin_amdgcn_mfma_f32_32x32x16_bf16(PAF(3), VFR(3), o[0], 0, 0, 0), C1, 8); \
    GAPB(o[1] = __builtin_amdgcn_mfma_f32_32x32x16_bf16(PAF(3), VFR(7), o[1], 0, 0, 0), C1, 12); \
    } while (0)
    int t = 1;
#define ENDW(tt) do { if ((tt) + 3 < NT) { if (MODE == 0) WAIT_BAR(3); else WAIT_BAR(2); } else if ((tt) + 2 < NT) { if (MODE == 0) WAIT_BAR(2); else WAIT_BAR(1); } else { WAIT_BAR(0); } } while (0)
    for (; t + 1 < NT; t += 2) {
        STEP(pB0, pB1, pA0, pA1, t, (t + 3 < NT), (t + 2 < NT), (t + 1 < NT), (t + 1 < NT), true);         ENDW(t);     RESC(); ROT();
        STEP(pA0, pA1, pB0, pB1, t + 1, (t + 4 < NT), (t + 3 < NT), (t + 2 < NT), (t + 2 < NT), true);     ENDW(t + 1); RESC(); ROT();
    }
    STEP(pB0, pB1, pA0, pA1, NT - 1, false, false, false, false, true); RESC();
    u32x4 gtv[4];
#pragma unroll
    for (int i = 0; i < 4; ++i) gtv[i] = __builtin_nontemporal_load((const u32x4*)(P.gate + (size_t)(q0 + wid * QBLK + i * 8 + (lane >> 3)) * NZ + (lane & 7) * 8));
    { float sacc = pB0[0] + pB0[1];
#pragma unroll
      for (int r = 2; r < 16; ++r) sacc += pB0[r];
#pragma unroll
      for (int r = 0; r < 16; ++r) sacc += pB1[r];
      l_reg += sacc;
      pw0 = (u32x4){PKW(pB0, 0), PKW(pB0, 2), PKW(pB0, 4), PKW(pB0, 6)}; pw1 = (u32x4){PKW(pB0, 8), PKW(pB0, 10), PKW(pB0, 12), PKW(pB0, 14)};
      pw2 = (u32x4){PKW(pB1, 0), PKW(pB1, 2), PKW(pB1, 4), PKW(pB1, 6)}; pw3 = (u32x4){PKW(pB1, 8), PKW(pB1, 10), PKW(pB1, 12), PKW(pB1, 14)};
      SBAR(); pv(o, vb0 + sl_cur, PAF(0), PAF(1), PAF(2), PAF(3)); }
#undef PKW
#undef PAF
#undef VFR
#undef PIN
#undef MX3
#undef GAPA
#undef GAPB
#undef EX
#undef VRD
#undef KRD
#undef STEP
#undef ENDW
    unsigned nxt_unit = 0u;
    if (tid == 0) nxt_unit = __hip_atomic_fetch_add(P.ctr, 1u, __ATOMIC_RELAXED, __HIP_MEMORY_SCOPE_AGENT);
    { auto rr = __builtin_amdgcn_permlane32_swap(__float_as_uint(l_reg), __float_as_uint(l_reg), false, false); l_reg = __uint_as_float(rr[0]) + __uint_as_float(rr[1]); }
    if (hi == 0) wsf[32 + r32] = l_reg; asm volatile("s_waitcnt lgkmcnt(0)" ::: "memory");
    float rli[16];
#pragma unroll
    for (int r = 0; r < 16; ++r) rli[r] = __builtin_amdgcn_rcpf(wsf[32 + crow(r, hi)]);
    {
        LAS bf16_t* stg = (LAS bf16_t*)(lds + LDS_OST) + wid * 2048;
#pragma unroll
        for (int r = 0; r < 16; ++r) { const int orow = crow(r, hi);
#pragma unroll
            for (int d0 = 0; d0 < 2; ++d0) stg[orow * 64 + d0 * 32 + r32] = (bf16_t)(cvtpk(o[d0][r] * rli[r], 0.f) & 0xffffu); }
        asm volatile("s_waitcnt lgkmcnt(0)" ::: "memory");
#pragma unroll
        for (int i = 0; i < 4; ++i) { const int row = i * 8 + (lane >> 3), ch = lane & 7; const u32x4 v = *(const LAS u32x4*)(stg + row * 64 + ch * 8);
            const size_t grow = (size_t)(q0 + wid * QBLK + row);
            const u32x4 gt = gtv[i];
            u32x4 w;
            w.x = cvtpk(bf_lo(v.x) * bf_lo(gt.x), bf_hi(v.x) * bf_hi(gt.x));
            w.y = cvtpk(bf_lo(v.y) * bf_lo(gt.y), bf_hi(v.y) * bf_hi(gt.y));
            w.z = cvtpk(bf_lo(v.z) * bf_lo(gt.z), bf_hi(v.z) * bf_hi(gt.z));
            w.w = cvtpk(bf_lo(v.w) * bf_lo(gt.w), bf_hi(v.w) * bf_hi(gt.w));
            *(u32x4*)(P.out + grow * DM + ch * 8) = w; }
    }
    if (tid == 0) *(volatile LAS unsigned*)(lds + att::L_NEXT) = nxt_unit;
    asm volatile("s_waitcnt lgkmcnt(0)\n\ts_barrier" ::: "memory");
#undef DMA_K
#undef DMA_K2
#undef DMA_V
#undef BMASK
#undef START
#undef RESC
#undef ROT
#undef KOFF
}
#undef SBAR
#undef WAIT_BAR
}

struct Args {
    const float* x; const float* c; const int* pos; const float* w_ada; const float* b_ada; const float* norm_g; const float* w_in;
    const float* qng; const float* w_uq; const float* kvng; const float* w_ukv; const float* relb; const float* fgb; const float* w_out; const float* final_g;
    float* out; unsigned char* ws; int ph_lo, ph_hi;
};

__device__ __forceinline__ int src_col(int kind, int n, float& sc) {
    sc = 1.f;
    if (kind == 4) { if (n < 32) { kind = 0; n = ZC_KPE + n; } else if (n < 37) { kind = 0; n = (ZC_CF - ZPAD) + (n - 32); } else return -1; }
    else if (kind == 0) { n = n + (n >= ZC_KPE ? 32 : 0); }
    if (kind == 0) {
        if (n < ZC_KPE) return n;
        if (n < (ZC_GATE - ZPAD)) { const int i = (n - ZC_KPE) >> 1, odd = (n - ZC_KPE) & 1; return 640 + i + 16 * odd; }
        if (n < 1056) return n;
        if (n < 1376) return 2016 + (n - 1056);
        if (n < (ZC_BQ - ZPAD)) return 3301 + (n - 1376);
        if (n < (ZC_BK - ZPAD)) { sc = 0.125f * LOG2E; return 1056 + (n - (ZC_BQ - ZPAD)); }
        if (n < (ZC_BV - ZPAD)) return 1376 + (n - (ZC_BK - ZPAD));
        if (n < (ZC_CQ2 - ZPAD)) return 1696 + (n - (ZC_BV - ZPAD));
        if (n < (ZC_CK - ZPAD)) { sc = 0.125f * LOG2E; return 2336 + (n - (ZC_CQ2 - ZPAD)); }
        if (n < (ZC_CV - ZPAD)) return 2656 + (n - (ZC_CK - ZPAD));
        if (n < (ZC_CF - ZPAD)) return 2976 + (n - (ZC_CV - ZPAD));
        if (n < (ZC_CF - ZPAD) + 5) return 3296 + (n - (ZC_CF - ZPAD));
        return -1;
    } else if (kind == 1) {
        if (n >= 576) return -1;
        sc = 0.10206207261596577f * LOG2E;
        const int h = n / 96, d = n % 96;
        if (d < 64) return n;
        const int i = (d - 64) >> 1, odd = (d - 64) & 1; return h * 96 + 64 + i + 16 * odd;
    } else if (kind == 2) {
        if (n < 384) { const int h = n >> 6, d = n & 63; return h * 128 + d; }
        const int m = n - 384, h = m >> 6, d = m & 63; return h * 128 + 64 + d;
    }
    return n;
}
__device__ __forceinline__ void transpose_item(const float* W, int N, int K, bf16_t* WT, LAS float* scr, int kind, const float* rowscale, int item, int nblk, int lane, int pitch = 0) {
    if (pitch == 0) pitch = K;
    const int kb = item / nblk, nb = item % nblk, k0 = 64 * kb, n0 = 32 * nb;
    float csc; const int sc = src_col(kind, n0 + (lane & 31), csc);
    float v[32], rsc[32];
    const float* wp = W + (size_t)(k0 + (lane >> 5)) * N + (sc >= 0 ? sc : 0);
#pragma unroll
    for (int i = 0; i < 32; ++i) v[i] = __builtin_nontemporal_load(wp + (size_t)(2 * i) * N);
    if (rowscale) {
#pragma unroll
        for (int i = 0; i < 32; ++i) rsc[i] = rowscale[k0 + 2 * i + (lane >> 5)];
    } else {
#pragma unroll
        for (int i = 0; i < 32; ++i) rsc[i] = 1.f;
    }
    if (sc < 0) csc = 0.f;
#pragma unroll
    for (int i = 0; i < 32; ++i) scr[(2 * i + (lane >> 5)) * 33 + (lane & 31)] = v[i] * csc * rsc[i];
    __builtin_amdgcn_s_waitcnt(0xc07f);
    asm volatile("" ::: "memory");
    const int c = lane & 7;
#pragma unroll
    for (int j = 0; j < 4; ++j) {
        const int n = (lane >> 3) + 8 * j; const LAS float* s = scr + (8 * c) * 33 + n;
        u32x4 o; o.x = cvtpk(s[0 * 33], s[1 * 33]); o.y = cvtpk(s[2 * 33], s[3 * 33]); o.z = cvtpk(s[4 * 33], s[5 * 33]); o.w = cvtpk(s[6 * 33], s[7 * 33]);
        *(u32x4*)(WT + (size_t)(n0 + n) * pitch + k0 + 8 * c) = o;
    }
    __builtin_amdgcn_s_waitcnt(0xc07f);
    asm volatile("" ::: "memory");
}

__device__ __forceinline__ void phase0(const Args& a, LAS unsigned char* lds, const int wv, const int bid) {
    const int lane = lane_now(), wave = wv, tid = wv * 64 + lane;
    float* mod = (float*)(a.ws + WS_MOD);
    if (bid < 192) {
        LAS float* cact = (LAS float*)lds;
        for (int i = tid; i < 16 * 1024; i += 512) { const int b = i >> 10, k = i & 1023; const float v = a.c[i]; cact[k * 16 + b] = v / (1.f + __expf(-v)); }
        __syncthreads();
        const int q = bid, l = q / 96, j0 = (q % 96) * 32, ks = wave * 2 + (lane >> 5), jc = lane & 31;
        float acc[16];
#pragma unroll
        for (int b = 0; b < 16; ++b) acc[b] = 0.f;
        const float* w = a.w_ada + (size_t)l * 1024 * 3072 + (size_t)(ks * 64) * 3072 + j0 + jc;
#pragma unroll 8
        for (int kk = 0; kk < 64; ++kk) {
            const float wv = __builtin_nontemporal_load(w + (size_t)kk * 3072);
            const LAS f32x4* cp = (const LAS f32x4*)(cact + (ks * 64 + kk) * 16);
            const f32x4 c0 = cp[0], c1 = cp[1], c2 = cp[2], c3 = cp[3];
#pragma unroll
            for (int i = 0; i < 4; ++i) { acc[i] += wv * c0[i]; acc[4 + i] += wv * c1[i]; acc[8 + i] += wv * c2[i]; acc[12 + i] += wv * c3[i]; }
        }
        LAS float* part = (LAS float*)(lds + 65536);
#pragma unroll
        for (int b = 0; b < 16; ++b) part[(ks * 16 + b) * 32 + jc] = acc[b];
        __syncthreads();
        {
            const int b = tid >> 5, jj = tid & 31; float sacc = a.b_ada[l * 3072 + j0 + jj];
#pragma unroll
            for (int k2 = 0; k2 < 16; ++k2) sacc += part[(k2 * 16 + b) * 32 + jj];
            mod[((size_t)l * 16 + b) * 3072 + j0 + jj] = sacc;
        }
        __syncthreads();
    }
    {
        LAS float* scr = (LAS float*)(lds + wave * 8448);
        const int gw = bid * 8 + wave, NGW = gridDim.x * 8;
        constexpr int I_IN = 16 * 112, I_37 = 16 * 2, I_UQ = 6 * 24, I_UKV = 4 * 24, I_OUT = 16 * 32, I_L = I_IN + I_37 + I_UQ + I_UKV + I_OUT;
        for (int it = gw; it < 2 * I_L; it += NGW) {
            const int l = it / I_L; int r = it % I_L;
            if (r < I_IN) { transpose_item(a.w_in + (size_t)l * 1024 * NIN, NIN, 1024, (bf16_t*)(a.ws + WS_WIN) + (size_t)l * NZG * 1024, scr, 0, nullptr, r, 112, lane); continue; } r -= I_IN;
            if (r < I_37) { transpose_item(a.w_in + (size_t)l * 1024 * NIN, NIN, 1024, (bf16_t*)(a.ws + WS_W37) + (size_t)l * 64 * 1024, scr, 4, nullptr, r, 2, lane); continue; } r -= I_37;
            if (r < I_UQ) { transpose_item(a.w_uq + (size_t)l * 384 * 576, 576, 384, (bf16_t*)(a.ws + WS_WUQ) + (size_t)l * 768 * 384, scr, 1, a.qng + l * 384, r, 24, lane); continue; } r -= I_UQ;
            if (r < I_UKV) { transpose_item(a.w_ukv + (size_t)l * 256 * 768, 768, 256, (bf16_t*)(a.ws + WS_WUKV) + (size_t)l * 768 * 384, scr, 2, a.kvng + l * 256, r, 24, lane, 384); continue; } r -= I_UKV;
            transpose_item(a.w_out + (size_t)l * 1024 * 1024, 1024, 1024, (bf16_t*)(a.ws + WS_WOUT) + (size_t)l * 1024 * 1024, scr, 3, nullptr, r, 32, lane);
        }
    }
    {
        float* cs = (float*)(a.ws + WS_CS);
        const int gt = bid * 512 + tid, NGT = gridDim.x * 512;
        for (int i = gt; i < NTOK * 16; i += NGT) {
            const int tok = i >> 4, j = i & 15;
            const float inv = exp2f(-(float)j * (13.287712379549449f / 16.f));
            const float ang = (float)a.pos[tok] * inv;
            double r = (double)ang; r -= 6.283185307179586 * rint(r * 0.15915494309189535);
            cs[(size_t)tok * 32 + j] = cosf((float)r); cs[(size_t)tok * 32 + 16 + j] = sinf((float)r);
        }
    }
}


__device__ __forceinline__ void side37(const Args& a, const int L, const bf16_t* H, LAS unsigned char* lds, const int wv, const int bid) {
    const int lane = lane_now(), lr = lane & 15, fq = lane >> 4, tid = wv * 64 + lane;
    const int row = bid * 128 + wv * 16 + lr;
    const bf16_t* hp = H + (size_t)row * 1024 + 8 * fq;
    bf16x8 hf[32];
#pragma unroll
    for (int k = 0; k < 32; ++k) hf[k] = *(const bf16x8*)(hp + 32 * k);
    {
        const bf16_t* wsrc = (const bf16_t*)(a.ws + WS_W37) + (size_t)L * 64 * 1024;
#pragma unroll
        for (int j = 0; j < 12; ++j) { const int i = tid + 512 * j, r = i >> 7, ch = i & 127;
            const u32x4 v = *(const u32x4*)(wsrc + (size_t)r * 1024 + ch * 8); *(LAS u32x4*)(lds + r * 2064 + ch * 16) = v; }
    }
    __syncthreads();
    f32x4 acc0 = {0.f, 0.f, 0.f, 0.f}, acc1 = acc0, acc2 = acc0;
    const LAS unsigned char* wl = lds + lr * 2064 + fq * 16;
#pragma unroll
    for (int k = 0; k < 32; ++k) {
        const bf16x8 w0 = *(const LAS bf16x8*)(wl + k * 64), w1 = *(const LAS bf16x8*)(wl + 16 * 2064 + k * 64), w2 = *(const LAS bf16x8*)(wl + 32 * 2064 + k * 64);
        acc0 = __builtin_amdgcn_mfma_f32_16x16x32_bf16(w0, hf[k], acc0, 0, 0, 0);
        acc1 = __builtin_amdgcn_mfma_f32_16x16x32_bf16(w1, hf[k], acc1, 0, 0, 0);
        acc2 = __builtin_amdgcn_mfma_f32_16x16x32_bf16(w2, hf[k], acc2, 0, 0, 0);
    }
    __syncthreads();
    bf16_t* Z = (bf16_t*)(a.ws + WS_Z);
    const float* cs = (const float*)(a.ws + WS_CS) + (size_t)row * 32;
#pragma unroll
    for (int n = 0; n < 2; ++n) {
        const f32x4 v = n == 0 ? acc0 : acc1;
        const int i0 = 8 * n + 2 * fq;
        const f32x2 co = *(const f32x2*)(cs + i0), si = *(const f32x2*)(cs + 16 + i0);
        u32x2 w;
        w.x = cvtpk(v[0] * co[0] - v[1] * si[0], v[0] * si[0] + v[1] * co[0]);
        w.y = cvtpk(v[2] * co[1] - v[3] * si[1], v[2] * si[1] + v[3] * co[1]);
        *(u32x2*)(Z + (size_t)row * NZ + ZC_KPE + 16 * n + 4 * fq) = w;
    }
    if (fq < 2) {
        float* LF = (float*)(a.ws + WS_LF) + (size_t)row * 8;
        const float* fb = a.fgb + L * 5;
        const int nh = fq == 0 ? 4 : 1;
#pragma unroll
        for (int i = 0; i < 4; ++i) if (i < nh) { const float t = acc2[i] + fb[4 * fq + i]; LF[4 * fq + i] = fminf(t, 0.f) - log1pf(__expf(-fabsf(t))); }
    }
}

__device__ __forceinline__ void phase_norm(const Args& a, int l, const float* xin, const int wv, const int bid) {
    const int lane = lane_now(), wave = wv;
    const int gw = bid * 8 + wave, NGW = gridDim.x * 8, wpb = NGW / NB;
    const int b = gw / wpb, wi = gw % wpb;
    if (b >= NB) return;
    const float* mod = (const float*)(a.ws + WS_MOD) + ((size_t)l * 16 + b) * 3072;
    bf16_t* H = (bf16_t*)(a.ws + WS_H);
    f32x4 G[4], SH[4];
#pragma unroll
    for (int j = 0; j < 4; ++j) {
        const int col = 4 * lane + 256 * j;
        const f32x4 g = *(const f32x4*)(a.norm_g + l * 1024 + col), sc = *(const f32x4*)(mod + 1024 + col);
        G[j] = g * (sc + 1.0f); SH[j] = *(const f32x4*)(mod + col);
    }
    for (int row = wi; row < SEQ; row += wpb) {
        const size_t tok = (size_t)b * SEQ + row;
        const f32x4* xr = (const f32x4*)(xin + tok * DM) + lane;
        f32x4 v[4]; float s = 0.f;
#pragma unroll
        for (int j = 0; j < 4; ++j) { v[j] = __builtin_nontemporal_load(xr + 64 * j); s += (v[j].x * v[j].x + v[j].y * v[j].y) + (v[j].z * v[j].z + v[j].w * v[j].w); }
        const float rstd = 1.0f / sqrtf(wave_sum(s, lane) * (1.f / DM) + EPS);
        if (lane == 0) *(f32x2*)((float*)(a.ws + WS_RQ) + tok * 2) = (f32x2){0.f, 0.f};
        u32x2* o8 = (u32x2*)(H + tok * DM) + lane;
#pragma unroll
        for (int j = 0; j < 4; ++j) { const f32x4 h = v[j] * rstd * G[j] + SH[j]; u32x2 w; w.x = cvtpk(h.x, h.y); w.y = cvtpk(h.z, h.w); o8[64 * j] = w; }
    }
}

__device__ __forceinline__ void phase_stats(const Args& a, const int wv, const int bid) {
    const int lane = lane_now(), wave = wv;
    const int gw = bid * 8 + wave;
    if (gw < 80) {
        const int b = gw / 5, h = gw % 5;
        const float* LF = (const float*)(a.ws + WS_LF) + ((size_t)b * SEQ + lane * 32) * 8 + h;
        float* Gp = (float*)(a.ws + WS_G) + (size_t)gw * SEQ + lane * 32;
        float v[32]; float run = 0.f;
#pragma unroll
        for (int i = 0; i < 32; ++i) { run += LF[i * 8]; v[i] = run; }
        float incl = run;
#pragma unroll
        for (int o = 1; o < 64; o <<= 1) { const float t = shfl_up_l(incl, o, lane); if (lane >= o) incl += t; }
        const float excl = incl - run;
#pragma unroll
        for (int i = 0; i < 32; ++i) Gp[i] = -(excl + v[i]) * LOG2E;
    }
}

__device__ __forceinline__ void phase_attn(const Args& a, int l, LAS unsigned char* lds, const int wv, const int bid, const int crep) {
    const bf16_t* Z = (const bf16_t*)(a.ws + WS_Z);
    const bf16_t* QA = (const bf16_t*)(a.ws + WS_QA);
    const bf16_t* KVA = (const bf16_t*)(a.ws + WS_KVA);
    bf16_t* MIX = (bf16_t*)(a.ws + WS_H);
    const float* Gt = (const float*)(a.ws + WS_G);
    unsigned* ctr0 = (unsigned*)(a.ws + WS_CTL) + 8192 + 64 * (l * 8) + 1024 * crep;
    const int myx = (int)((unsigned)__builtin_amdgcn_s_getreg((3 << 11) | 20) & 7u);
    volatile LAS unsigned* nxt = (volatile LAS unsigned*)(lds + att::L_NEXT);
    int curx = myx;
    if (wv == 0 && lane_now() == 0) *nxt = __hip_atomic_fetch_add(ctr0 + 64 * curx, 1u, __ATOMIC_RELAXED, __HIP_MEMORY_SCOPE_AGENT);
    __syncthreads();
    for (;;) {
        const int u = __builtin_amdgcn_readfirstlane((int)*nxt);
        if (u >= 256) {
            __syncthreads();
            if (wv == 0 && lane_now() == 0) {
                unsigned c[8];
#pragma unroll
                for (int j = 0; j < 8; ++j) c[j] = __hip_atomic_load(ctr0 + 64 * j, __ATOMIC_RELAXED, __HIP_MEMORY_SCOPE_AGENT);
                int pick = -1;
#pragma unroll
                for (int k = 7; k >= 1; --k) { const int x = (curx + k) & 7; unsigned cx = 0u;
#pragma unroll
                    for (int j = 0; j < 8; ++j) cx = (j == x) ? c[j] : cx;
                    if (cx < 256u) pick = x; }
                nxt[1] = (unsigned)pick;
                nxt[0] = pick >= 0 ? __hip_atomic_fetch_add(ctr0 + 64 * pick, 1u, __ATOMIC_RELAXED, __HIP_MEMORY_SCOPE_AGENT) : 0u;
            }
            __syncthreads();
            const int pk = __builtin_amdgcn_readfirstlane((int)nxt[1]);
            if (pk < 0) break;
            curx = pk;
            continue;
        }
        unsigned* ctr = ctr0 + 64 * curx;
        int mode, qb, bh;
        { const int g = u >> 5, w = u & 31, hh = 4 * g + (w & 3); qb = 7 - (w >> 2);
          if (hh < 12) { mode = 0; bh = curx * 12 + hh; } else if (hh < 22) { mode = 2; bh = curx * 10 + (hh - 12); } else { mode = 1; bh = curx * 10 + (hh - 22); } }
        att::AP P;
        if (mode == 0) {
            const int b = bh / 6, h = bh % 6; const size_t rb = (size_t)b * SEQ;
            P.Q = QA + rb * QAP + h * 96; P.qp = QAP;
            P.K = KVA + rb * QAP + h * 64; P.kp = QAP;
            P.K2 = Z + rb * NZ + ZC_KPE; P.k2p = NZ;
            P.V = KVA + rb * QAP + 384 + h * 64; P.vp = QAP;
            P.gate = Z + rb * NZ + ZC_GATE + h * 64; P.out = MIX + rb * DM + h * 64; P.kb = nullptr; P.ctr = ctr;
            fa::attn_unit<0, 8>(P, qb, lds, wv);
        } else if (mode == 1) {
            const int b = bh / 5, h = bh % 5; const size_t rb = (size_t)b * SEQ;
            P.Q = Z + rb * NZ + ZC_BQ + h * 64; P.qp = NZ;
            P.K = Z + rb * NZ + ZC_BK + h * 64; P.kp = NZ; P.K2 = nullptr; P.k2p = 0;
            P.V = Z + rb * NZ + ZC_BV + h * 64; P.vp = NZ;
            P.gate = Z + rb * NZ + ZC_GATE + 384 + h * 64; P.out = MIX + rb * DM + 384 + h * 64; P.kb = a.relb + ((size_t)l * 5 + h) * 257; P.ctr = ctr;
            fa::attn_unit<1, 8>(P, qb, lds, wv);
        } else {
            const int b = bh / 5, h = bh % 5; const size_t rb = (size_t)b * SEQ;
            P.Q = Z + rb * NZ + ZC_CQ2 + h * 64; P.qp = NZ;
            P.K = Z + rb * NZ + ZC_CK + h * 64; P.kp = NZ; P.K2 = nullptr; P.k2p = 0;
            P.V = Z + rb * NZ + ZC_CV + h * 64; P.vp = NZ;
            P.gate = Z + rb * NZ + ZC_GATE + 704 + h * 64; P.out = MIX + rb * DM + 704 + h * 64; P.kb = Gt + (size_t)bh * SEQ; P.ctr = ctr;
            fa::attn_unit<2, 8>(P, qb, lds, wv);
        }
    }
    __syncthreads();
}

__device__ __forceinline__ void phase_final(const Args& a, const int wv, const int bid) {
    const int lane = lane_now(), wave = wv;
    const int gw = bid * 8 + wave, NGW = gridDim.x * 8;
    f32x4 G[4];
#pragma unroll
    for (int j = 0; j < 4; ++j) G[j] = *(const f32x4*)(a.final_g + 4 * lane + 256 * j);
    for (int row = gw; row < NTOK; row += NGW) {
        f32x4* xr = (f32x4*)(a.out + (size_t)row * DM) + lane;
        f32x4 v[4]; float s = 0.f;
#pragma unroll
        for (int j = 0; j < 4; ++j) { v[j] = xr[64 * j]; s += (v[j].x * v[j].x + v[j].y * v[j].y) + (v[j].z * v[j].z + v[j].w * v[j].w); }
        const float rstd = 1.0f / sqrtf(wave_sum(s, lane) * (1.f / DM) + EPS);
#pragma unroll
        for (int j = 0; j < 4; ++j) xr[64 * j] = v[j] * rstd * G[j];
    }
}


#define XB_TMO      128
#define XB_XCNT(j)  (256  + 64 * (j))
#define XB_XSUB(j)  (1280 + 64 * (j))
#define XB_XGEN(j)  (2304 + 64 * (j))
#define XB_TOP      3328
#define XB_TOPGEN   3392
#define XCD_BAR_WORDS 3456
#define XB_SPIN_CAP (1u << 18)
__device__ __forceinline__ unsigned xb_ld(unsigned* p)              { return __hip_atomic_load(p, __ATOMIC_RELAXED, __HIP_MEMORY_SCOPE_AGENT); }
__device__ __forceinline__ unsigned xb_add(unsigned* p, unsigned v) { return __hip_atomic_fetch_add(p, v, __ATOMIC_RELAXED, __HIP_MEMORY_SCOPE_AGENT); }
__device__ __forceinline__ unsigned xb_xcc_id() { return (unsigned)__builtin_amdgcn_s_getreg((3 << 11) | 20) & 0xFu; }
#define XB_SPIN(cond, bar) do { unsigned _sp = 0; while (cond) { __builtin_amdgcn_s_sleep(4); \
    if ((++_sp & 255u) == 0u) { if (xb_ld(&(bar)[XB_TMO])) break; if (_sp > XB_SPIN_CAP) { atomicAdd(&(bar)[XB_TMO], 1u); break; } } } } while (0)
struct XcdBarrier { unsigned* bar; unsigned x; volatile LAS unsigned* st; };
__device__ __forceinline__ void xcd_barrier_complete(unsigned* bar, unsigned x, unsigned& nloc, unsigned& nx) {
    const unsigned G = gridDim.x * gridDim.y * gridDim.z;
    unsigned sum, cnt, mine, sp = 0u;
    for (;;) {
        sum = 0u; cnt = 0u; mine = 0u;
#pragma unroll
        for (unsigned j = 0; j < 16; ++j) { const unsigned c = xb_ld(&bar[XB_XCNT(j)]); sum += c; cnt += (c > 0u) ? 1u : 0u; mine = (j == x) ? c : mine; }
        if (sum == G) break;
        __builtin_amdgcn_s_sleep(1);
        if ((++sp & 255u) == 0u) { if (xb_ld(&bar[XB_TMO])) break; if (sp > XB_SPIN_CAP) { atomicAdd(&bar[XB_TMO], 1u); break; } }
    }
    nloc = mine > 0u ? mine : 1u; nx = cnt > 0u ? cnt : 1u;
}
__device__ __forceinline__ void xcd_barrier(const XcdBarrier& b, const bool first) {
    asm volatile("s_waitcnt vmcnt(0)" ::: "memory");
    __syncthreads();
    if (first) {
        unsigned* bar = b.bar;
        __builtin_amdgcn_s_waitcnt(0);
        unsigned nloc = b.st[0], nx = b.st[1];
        if (nloc == 0u) { xcd_barrier_complete(bar, b.x, nloc, nx); b.st[0] = nloc; b.st[1] = nx; }
        const unsigned old = xb_add(&bar[XB_XSUB(b.x)], 1u);
        const unsigned gen = old / nloc;
        if (old + 1u == (gen + 1u) * nloc) {
            __builtin_amdgcn_fence(__ATOMIC_RELEASE, "agent");
            asm volatile("s_waitcnt vmcnt(0)" ::: "memory");
            const unsigned og = xb_add(&bar[XB_TOP], 1u);
            const unsigned tg = og / nx;
            if (og + 1u == (tg + 1u) * nx) xb_add(&bar[XB_TOPGEN], 1u);
            else XB_SPIN(xb_ld(&bar[XB_TOPGEN]) == tg, bar);
            __builtin_amdgcn_fence(__ATOMIC_ACQUIRE, "agent");
            xb_add(&bar[XB_XGEN(b.x)], 1u);
            asm volatile("s_waitcnt vmcnt(0)" ::: "memory");
        } else {
            XB_SPIN(xb_ld(&bar[XB_XGEN(b.x)]) == gen, bar);
            __builtin_amdgcn_fence(__ATOMIC_ACQUIRE, "agent");
            asm volatile("s_waitcnt vmcnt(0)" ::: "memory");
        }
    }
    __syncthreads();
}

#ifndef ONLY
#define ONLY -1
#endif
#define EN(n) (ONLY < 0 || ONLY == (n))
#ifndef DBLMASK
#define DBLMASK 0
#endif
#define PH_IN(k) (lo <= (k) && (k) < hi)
#define SEAM(k) do { if constexpr (COOP) { if (lo <= (k) && (k) + 1 < hi) xcd_barrier(xb, wv == 0 && lane_now() == 0); } } while (0)
#define BAR() do { if constexpr (COOP) xcd_barrier(xb, wv == 0 && lane_now() == 0); } while (0)

template <bool COOP, int L>
__device__ __forceinline__ void layer_phases(const Args& a, LAS unsigned char* lds, const int wv, const int bid, const int lo, const int hi, const XcdBarrier& xb) {
    constexpr int P = (L == 0) ? 2 : 6;
    const float* mod = (const float*)(a.ws + WS_MOD);
    if (L == 0) { if (PH_IN(1) && EN(1)) phase_norm(a, 0, a.x, wv, bid); SEAM(1); }
    if (PH_IN(P + 0) && EN(2)) {
        const bool side_first = ((bid >> 3) & 1) == 0;
        if (side_first) side37(a, L, (const bf16_t*)(a.ws + (L == 0 ? WS_H : WS_HN)), lds, wv, bid);
        pg8::Gemm g{(const bf16_t*)(a.ws + (L == 0 ? WS_H : WS_HN)), (const bf16_t*)(a.ws + WS_WIN) + (size_t)L * NZG * 1024, NTOK, NZG, 1024, 1024, 1024};
        pg8::StaticOrder S; S.init(NTOK, NZG, gridDim.x, bid);
        pg8::EpiZ E{(bf16_t*)(a.ws + WS_Z), (const float*)(a.ws + WS_CS), (float*)(a.ws + WS_LF), a.fgb + L * 5, (float*)(a.ws + WS_RQ), lds + 131072 + 1024};
        pg8::gemm_phase<pg8::EpiZ>(lds, pg8::Prob1{g, S}, E, wv);
        if (!side_first) side37(a, L, (const bf16_t*)(a.ws + (L == 0 ? WS_H : WS_HN)), lds, wv, bid);
    }
    SEAM(P + 0);
    if (PH_IN(P + 1) && EN(4)) {
        phase_stats(a, wv, bid);
        {
            pg8::Gemm g0{(const bf16_t*)(a.ws + WS_Z) + ZC_CQ, (const bf16_t*)(a.ws + WS_WUQ) + (size_t)L * 768 * 384, NTOK, 768, 384, NZ, 384};
            pg8::Gemm g1{(const bf16_t*)(a.ws + WS_Z) + ZC_CKV, (const bf16_t*)(a.ws + WS_WUKV) + (size_t)L * 768 * 384, NTOK, 768, 256, NZ, 384};
            pg8::StaticOrder S; S.init(NTOK, 768, gridDim.x, bid);
            pg8::EpiUp E{pg8::EpiQ{(bf16_t*)(a.ws + WS_QA), (const float*)(a.ws + WS_CS), (const float*)(a.ws + WS_RQ)}, pg8::EpiKV{(bf16_t*)(a.ws + WS_KVA), (const float*)(a.ws + WS_RQ)}};
            pg8::gemm_phase<pg8::EpiUp>(lds, pg8::Prob2{g0, g1, S}, E, wv);
        }
    }
    SEAM(P + 1);
    if (PH_IN(P + 2) && EN(5)) phase_attn(a, L, lds, wv, bid, 0);
#ifdef ATT2
    if (PH_IN(P + 2) && EN(5)) phase_attn(a, L, lds, wv, bid, 1);
#endif
    SEAM(P + 2);
    if (PH_IN(P + 3) && EN(6)) {
        pg8::Gemm g{(const bf16_t*)(a.ws + WS_H), (const bf16_t*)(a.ws + WS_WOUT) + (size_t)L * 1024 * 1024, NTOK, 1024, 1024, 1024, 1024};
        pg8::StaticOrder S; S.init(NTOK, 1024, gridDim.x, bid);
        unsigned* cnt = (unsigned*)(a.ws + WS_CTL) + 16384 + L * 8192;
        float* xbuf = (float*)(a.ws + WS_X) + (size_t)L * NTOK * 4;
        if (L == 0) {
            pg8::EpiOutN<false> E{a.x, a.out, mod + 2048, a.norm_g + 1024, mod + (size_t)16 * 3072, (bf16_t*)(a.ws + WS_HN), (float*)(a.ws + WS_RQ), xbuf, cnt, lds + 131072 + 1024};
            pg8::gemm_phase<pg8::EpiOutN<false>>(lds, pg8::Prob1{g, S}, E, wv);
        } else {
            pg8::EpiOutN<true> E{a.out, a.out, mod + (size_t)16 * 3072 + 2048, a.final_g, nullptr, nullptr, nullptr, xbuf, cnt, lds + 131072 + 1024};
            pg8::gemm_phase<pg8::EpiOutN<true>>(lds, pg8::Prob1{g, S}, E, wv);
        }
    }
    if (L == 0) SEAM(P + 3);
}

template <bool COOP>
__global__ void __launch_bounds__(512, 2) fwd(Args a) {
    extern __shared__ __attribute__((aligned(16))) unsigned char lds_raw[];
    LAS unsigned char* lds = (LAS unsigned char*)lds_raw;
    const int wv = __builtin_amdgcn_readfirstlane(threadIdx.x >> 6);
    const int bid = blockIdx.x, lo = a.ph_lo, hi = a.ph_hi;
    XcdBarrier xb; xb.bar = (unsigned*)(a.ws + WS_CTL) + 1024; xb.x = xb_xcc_id(); xb.st = (volatile LAS unsigned*)(lds + 131072 + 64);
    if constexpr (COOP) {
        if (threadIdx.x == 0) { xb.st[0] = 0u; xb.st[1] = 0u; (void)xb_add(&xb.bar[XB_XCNT(xb.x)], 1u); }
        __syncthreads();
    }
    if (PH_IN(0) && EN(0)) phase0(a, lds, wv, bid);
    SEAM(0);
    layer_phases<COOP, 0>(a, lds, wv, bid, lo, hi, xb);
    layer_phases<COOP, 1>(a, lds, wv, bid, lo, hi, xb);
}

extern "C" void kernel_launch(void* const* d_in, const int* in_sizes, int n_in, void* d_out, int out_size, void* d_ws, size_t ws_size, hipStream_t stream) {
    static int grid = 0;
    if (grid == 0) {
        if (n_in != 15 || in_sizes[0] != NTOK * DM || out_size != NTOK * DM || ws_size < WS_END) { fprintf(stderr, "kernel_launch: unexpected shapes (n_in %d, ws %zu)\n", n_in, ws_size); grid = -1; return; }
        int dev = 0, cus = 0, per_cu = 0;
        hipGetDevice(&dev); hipDeviceGetAttribute(&cus, hipDeviceAttributeMultiprocessorCount, dev);
        hipFuncSetAttribute((const void*)fwd<true>, hipFuncAttributeMaxDynamicSharedMemorySize, LDS_BYTES);
        hipFuncSetAttribute((const void*)fwd<false>, hipFuncAttributeMaxDynamicSharedMemorySize, LDS_BYTES);
        hipOccupancyMaxActiveBlocksPerMultiprocessor(&per_cu, (const void*)fwd<true>, 512, LDS_BYTES);
        (void)hipGetLastError();
        if (per_cu < 1) fprintf(stderr, "kernel_launch: occupancy query reports %d blocks per CU\n", per_cu);
        grid = cus > 256 ? 256 : cus;
        if (grid != 256) fprintf(stderr, "kernel_launch: %d CUs; this kernel is laid out for 256\n", cus);
    }
    if (grid < 0) return;
    Args a{};
    a.x = (const float*)d_in[0]; a.c = (const float*)d_in[1]; a.pos = (const int*)d_in[2]; a.w_ada = (const float*)d_in[3]; a.b_ada = (const float*)d_in[4];
    a.norm_g = (const float*)d_in[5]; a.w_in = (const float*)d_in[6]; a.qng = (const float*)d_in[7]; a.w_uq = (const float*)d_in[8]; a.kvng = (const float*)d_in[9];
    a.w_ukv = (const float*)d_in[10]; a.relb = (const float*)d_in[11]; a.fgb = (const float*)d_in[12]; a.w_out = (const float*)d_in[13]; a.final_g = (const float*)d_in[14];
    a.out = (float*)d_out; a.ws = (unsigned char*)d_ws;
    if (hipMemsetAsync((char*)d_ws + WS_CTL, 0, 196608, stream) != hipSuccess) { fprintf(stderr, "kernel_launch: memset failed\n"); return; }
#if ONE_LAUNCH
    a.ph_lo = 0; a.ph_hi = NPHASE;
    void* args[] = {&a};
    hipError_t e = hipLaunchCooperativeKernel((const void*)fwd<true>, dim3(grid), dim3(512), args, LDS_BYTES, stream);
    if (e != hipSuccess) fprintf(stderr, "cooperative launch failed: %s\n", hipGetErrorString(e));
#else
    for (int ph = 0; ph < NPHASE; ++ph) {
        a.ph_lo = ph; a.ph_hi = ph + 1;
        hipLaunchKernelGGL(fwd<false>, dim3(grid), dim3(512), LDS_BYTES, stream, a);
    }
#endif
}
```

```cpp
#include <hip/hip_runtime.h>
#include <hip/hip_cooperative_groups.h>
#include <cstdio>
#include <cstdint>
namespace cg = cooperative_groups;

#ifndef ONE_LAUNCH
#define ONE_LAUNCH 1
#endif

#define LAS __attribute__((address_space(3)))
typedef unsigned short bf16_t;
typedef short bf16x8 __attribute__((ext_vector_type(8)));
typedef short s16x4 __attribute__((ext_vector_type(4)));
typedef float f32x2 __attribute__((ext_vector_type(2)));
typedef float f32x4 __attribute__((ext_vector_type(4)));
typedef float f32x16 __attribute__((ext_vector_type(16)));
typedef unsigned u32x2 __attribute__((ext_vector_type(2)));
typedef unsigned u32x4 __attribute__((ext_vector_type(4)));
typedef __bf16 bf16x2_t __attribute__((ext_vector_type(2)));

constexpr int DM = 1024, NB = 16, SEQ = 2048, NTOK = NB * SEQ;
constexpr int NIN = 3621, NZ = 3840, NZG = 3584;
constexpr int ZPAD = 32;
constexpr int ZC_CQ = 0, ZC_CKV = 384, ZC_KPE = 640, ZC_GATE = 672 + ZPAD, ZC_BQ = 1696 + ZPAD, ZC_BK = 2016 + ZPAD, ZC_BV = 2336 + ZPAD, ZC_CQ2 = 2656 + ZPAD, ZC_CK = 2976 + ZPAD, ZC_CV = 3296 + ZPAD, ZC_CF = 3616 + ZPAD;
constexpr int QAP = 768;
constexpr float LOG2E = 1.4426950408889634f;
constexpr float EPS = 1e-6f;

constexpr size_t MiB = 1u << 20;
constexpr size_t WS_CTL = 0;
constexpr size_t WS_MOD = 1 * MiB;
constexpr size_t WS_CS = 2 * MiB;
constexpr size_t WS_RQ = 6 * MiB;
constexpr size_t WS_RKV = 6 * MiB + 256 * 1024;
constexpr size_t WS_LF = 7 * MiB;
constexpr size_t WS_G = 8 * MiB;
constexpr size_t WS_WIN = 10 * MiB;
constexpr size_t WS_WUQ = 25 * MiB;
constexpr size_t WS_WUKV = 26 * MiB + 512 * 1024;
constexpr size_t WS_W37 = 26 * MiB + 256 * 1024;
constexpr size_t WS_WOUT = 28 * MiB;
constexpr size_t WS_H = 32 * MiB;
constexpr size_t WS_QA = 96 * MiB;
constexpr size_t WS_KVA = 144 * MiB;
constexpr size_t WS_Z = 192 * MiB;
constexpr size_t WS_HN = 432 * MiB;
constexpr size_t WS_X = 9 * MiB;
constexpr size_t WS_END = 496 * MiB;

constexpr int LDS_BYTES = 147456;
constexpr int NPHASE = 10;

__device__ __forceinline__ unsigned cvtpk(float lo, float hi) { f32x2 v = {lo, hi}; bf16x2_t b = __builtin_convertvector(v, bf16x2_t); return __builtin_bit_cast(unsigned, b); }
__device__ __forceinline__ float bf_lo(unsigned u) { return __builtin_bit_cast(float, u << 16); }
__device__ __forceinline__ float bf_hi(unsigned u) { return __builtin_bit_cast(float, u & 0xffff0000u); }
__device__ __forceinline__ float shfl_xor_l(float v, int o, int lane) { return __builtin_bit_cast(float, __builtin_amdgcn_ds_bpermute((lane ^ o) << 2, __builtin_bit_cast(int, v))); }
__device__ __forceinline__ float shfl_up_l(float v, int o, int lane) { const int src = lane >= o ? lane - o : lane; return __builtin_bit_cast(float, __builtin_amdgcn_ds_bpermute(src << 2, __builtin_bit_cast(int, v))); }
__device__ __forceinline__ int lane_now() { int l; asm volatile("v_mbcnt_lo_u32_b32 %0, -1, 0\n\tv_mbcnt_hi_u32_b32 %0, -1, %0" : "=v"(l)); return l; }
__device__ __forceinline__ float wave_sum(float v, int lane) {
#pragma unroll
    for (int o = 1; o < 64; o <<= 1) v += shfl_xor_l(v, o, lane);
    return v;
}

namespace pg8 {
constexpr int BM = 256, BK = 64, HALF = 128, HTB = HALF * BK * 2, STAGE_BYTES = 8 * HTB, NXCD = 8, WGM = 8;
__device__ __forceinline__ int lds_byte(int r, int c) { return (r >> 3) * 1024 + (r & 7) * 128 + ((((c >> 3) ^ (r >> 1)) & 7) << 4) + (c & 7) * 2; }
__device__ __forceinline__ void stage_rc(int b, int& R, int& C) { const int st = b / 1024, sb = b % 1024; R = st * 8 + sb / 128; const int slot = (sb % 128) / 16; C = ((slot ^ (R >> 1)) & 7) * 8 + (sb % 16) / 2; }
__device__ __forceinline__ int perm32(int rho) { const int n = rho >> 4, i = rho & 15; return 8 * (i >> 2) + 4 * n + (i & 3); }

struct Unit { int pm, pn, kind; };
struct Gemm { const bf16_t* A; const bf16_t* Bt; int M, N, K, lda, ldb; };

struct StaticOrder {
    int nM, nN, nwg, G, c;
    __device__ void init(int M, int N, int G_, int c_) { nM = M / BM; nN = N / BM; nwg = nM * nN; G = G_; c = c_; }
    __device__ bool next(int i, Unit& u) const { const long L = (long)i * G + c; if (L >= nwg) return false; u.kind = 0; map((int)L, u); return true; }
    __device__ void map(int L, Unit& u) const {
        int wgid = L; { const int q = nwg / NXCD, r = nwg % NXCD, xcd = wgid % NXCD, off = wgid / NXCD; wgid = (xcd < r ? xcd * (q + 1) : r * (q + 1) + (xcd - r) * q) + off; }
        const int nig = WGM * nN, gid = wgid / nig, fm = gid * WGM, gsz = (nM - fm) < WGM ? (nM - fm) : WGM;
        u.pm = fm + ((wgid % nig) % gsz); u.pn = (wgid % nig) / gsz;
    }
};
struct Prob1 {
    Gemm g; StaticOrder S;
    __device__ bool next(int i, Unit& u) const { return S.next(i, u); }
    __device__ const char* a_tile(const Unit& u) const { return (const char*)g.A + (size_t)u.pm * BM * g.lda * 2; }
    __device__ const char* b_tile(const Unit& u) const { return (const char*)g.Bt + (size_t)u.pn * BM * g.ldb * 2; }
    __device__ int nt(const Unit&) const { return g.K / BK; }
    __device__ int lda() const { return g.lda; }
    __device__ int ldb() const { return g.ldb; }
};
struct Prob2 {
    Gemm g0, g1; StaticOrder S;
    __device__ bool next(int i, Unit& u) const { const long L = (long)i * S.G + S.c; if (L >= 2 * S.nwg) return false; u.kind = L >= S.nwg ? 1 : 0; S.map((int)(L - u.kind * S.nwg), u); return true; }
    __device__ const char* a_tile(const Unit& u) const { return (const char*)(u.kind ? g1.A : g0.A) + (size_t)u.pm * BM * g0.lda * 2; }
    __device__ const char* b_tile(const Unit& u) const { return (const char*)(u.kind ? g1.Bt : g0.Bt) + (size_t)u.pn * BM * g0.ldb * 2; }
    __device__ int nt(const Unit& u) const { return (u.kind ? g1.K : g0.K) / BK; }
    __device__ int lda() const { return g0.lda; }
    __device__ int ldb() const { return g0.ldb; }
};

template <class Epi, class Prob>
__device__ __forceinline__ void gemm_phase(LAS unsigned char* lds, const Prob& S, const Epi& E, const int wv) {
    const int lane = lane_now(), wid = wv, tid = wv * 64 + lane, wr = wid >> 2, wc = wid & 3, fr = lane & 15, fq = lane >> 4;
    unsigned voffA[2], voffB[2];
#pragma unroll
    for (int i = 0; i < 2; ++i) { int R, C; stage_rc(tid * 16 + i * 8192, R, C); const int Rb = Epi::PERM ? ((R & ~31) + perm32(R & 31)) : R;
        voffA[i] = (unsigned)(R * S.lda() + C) * 2u; voffB[i] = (unsigned)(Rb * S.ldb() + C) * 2u; }
    const size_t kstep = (size_t)(BK * 2);
    const size_t hstepA = (size_t)HALF * S.lda() * 2, hstepB = (size_t)HALF * S.ldb() * 2;
    const unsigned ldsw = (unsigned)wid * 1024u;
    const int aoff = lds_byte(wr * 64 + fr, fq * 8), boff = lds_byte(wc * 32 + fr, fq * 8);
#define PG8_SA(b, h) (((b) * 2 + (h)) * HTB)
#define PG8_SB(b, h) ((4 + (b) * 2 + (h)) * HTB)
#define PG8_STAGE(bufoff, gbase, voff) do { const char* _g = (const char*)(gbase); asm volatile("" : "+s"(_g)); _Pragma("unroll") for (int _i = 0; _i < 2; ++_i) \
        __builtin_amdgcn_global_load_lds((const unsigned*)(_g + (voff)[_i]), (LAS unsigned*)(lds + (bufoff) + ldsw + _i * 8192), 16, 0, 0); } while (0)
#define PG8_LDA(dst, b, h) do { _Pragma("unroll") for (int m = 0; m < 4; ++m) _Pragma("unroll") for (int k = 0; k < 2; ++k) dst[m][k] = *(const LAS bf16x8*)(lds + PG8_SA(b, h) + (k ? (aoff ^ 64) : aoff) + m * 2048); } while (0)
#define PG8_LDB(dst, b, h) do { _Pragma("unroll") for (int n = 0; n < 2; ++n) _Pragma("unroll") for (int k = 0; k < 2; ++k) dst[n][k] = *(const LAS bf16x8*)(lds + PG8_SB(b, h) + (k ? (boff ^ 64) : boff) + n * 2048); } while (0)
#define PG8_MMA(ai, bj, At, Bt) do { __builtin_amdgcn_s_setprio(1); _Pragma("unroll") for (int m = 0; m < 4; ++m) _Pragma("unroll") for (int n = 0; n < 2; ++n) _Pragma("unroll") for (int k = 0; k < 2; ++k) \
        acc[ai][bj][m][n] = __builtin_amdgcn_mfma_f32_16x16x32_bf16(Bt[n][k], At[m][k], acc[ai][bj][m][n], 0, 0, 0); __builtin_amdgcn_s_setprio(0); } while (0)
#define PG8_WAIT_V(n) asm volatile("s_waitcnt vmcnt(" #n ")" ::: "memory")
#define PG8_WAIT_L(n) asm volatile("s_waitcnt lgkmcnt(" #n ")" ::: "memory")
#define PG8_BAR __builtin_amdgcn_s_barrier()
#define PG8_SCHED __builtin_amdgcn_sched_barrier(0)
    Unit cur, nxt; int ui = 0;
    if (!S.next(0, cur)) return;
    f32x4 acc[2][2][4][2];
#pragma unroll
    for (int a = 0; a < 2; ++a)
#pragma unroll
        for (int b = 0; b < 2; ++b)
#pragma unroll
            for (int m = 0; m < 4; ++m)
#pragma unroll
                for (int n = 0; n < 2; ++n) acc[a][b][m][n] = (f32x4){0.f, 0.f, 0.f, 0.f};
    bf16x8 At[4][2], B0[2][2], B1[2][2];
    const char* cA = S.a_tile(cur); const char* cB = S.b_tile(cur);
    int nt = S.nt(cur);
    PG8_STAGE(PG8_SB(0, 0), cB, voffB); PG8_STAGE(PG8_SB(0, 1), cB + hstepB, voffB); PG8_STAGE(PG8_SA(0, 0), cA, voffA); PG8_STAGE(PG8_SA(0, 1), cA + hstepA, voffA);
    if (wr == 1) PG8_BAR;
    PG8_WAIT_V(2); PG8_BAR;
    PG8_STAGE(PG8_SB(1, 0), cB + kstep, voffB); PG8_STAGE(PG8_SA(1, 0), cA + kstep, voffA); PG8_STAGE(PG8_SB(1, 1), cB + hstepB + kstep, voffB);
    PG8_WAIT_V(6); PG8_BAR;
    for (;;) {
        const bool has_next = S.next(ui + 1, nxt);
        const char* nA = has_next ? S.a_tile(nxt) : cA; const char* nB = has_next ? S.b_tile(nxt) : cB;
        for (int t = 0; t < nt; t += 2) {
            const bool last = (t == nt - 2);
            const char* a1 = cA + (size_t)(t + 1) * kstep;
            const char* a2 = last ? nA : cA + (size_t)(t + 2) * kstep; const char* b2 = last ? nB : cB + (size_t)(t + 2) * kstep;
            const char* a3 = a2 + kstep; const char* b3 = b2 + kstep;
            PG8_LDB(B0, 0, 0); PG8_LDB(B1, 0, 1); PG8_SCHED; PG8_LDA(At, 0, 0); PG8_STAGE(PG8_SA(1, 1), a1 + hstepA, voffA);
            PG8_WAIT_V(8); PG8_WAIT_L(0); PG8_BAR; PG8_MMA(0, 0, At, B0); PG8_MMA(0, 1, At, B1); PG8_BAR; PG8_SCHED;
            PG8_LDA(At, 0, 1); PG8_STAGE(PG8_SB(0, 0), b2, voffB); PG8_STAGE(PG8_SB(0, 1), b2 + hstepB, voffB); PG8_STAGE(PG8_SA(0, 0), a2, voffA);
            PG8_WAIT_V(8); PG8_WAIT_L(0); PG8_BAR; PG8_MMA(1, 0, At, B0); PG8_MMA(1, 1, At, B1); PG8_BAR; PG8_SCHED;
            PG8_LDB(B0, 1, 0); PG8_LDB(B1, 1, 1); PG8_SCHED; PG8_LDA(At, 1, 0); PG8_STAGE(PG8_SA(0, 1), a2 + hstepA, voffA);
            PG8_WAIT_V(8); PG8_WAIT_L(0); PG8_BAR; PG8_MMA(0, 0, At, B0); PG8_MMA(0, 1, At, B1); PG8_BAR; PG8_SCHED;
            PG8_LDA(At, 1, 1); PG8_STAGE(PG8_SB(1, 0), b3, voffB); PG8_STAGE(PG8_SB(1, 1), b3 + hstepB, voffB); PG8_STAGE(PG8_SA(1, 0), a3, voffA);
            PG8_WAIT_V(8); PG8_WAIT_L(0); PG8_BAR; PG8_MMA(1, 0, At, B0); PG8_MMA(1, 1, At, B1); PG8_BAR; PG8_SCHED;
        }
        if (wr == 0) PG8_BAR;
        { const int le = lane_now();
          E(acc, cur, wid >> 2, wid & 3, le & 15, le >> 4); }
        if (!has_next) break;
#pragma unroll
        for (int a = 0; a < 2; ++a)
#pragma unroll
            for (int b = 0; b < 2; ++b)
#pragma unroll
                for (int m = 0; m < 4; ++m)
#pragma unroll
                    for (int n = 0; n < 2; ++n) acc[a][b][m][n] = (f32x4){0.f, 0.f, 0.f, 0.f};
        cur = nxt; cA = nA; cB = nB; ++ui; nt = S.nt(cur);
        if (wr == 1) PG8_BAR;
    }
    PG8_WAIT_V(0);
    PG8_BAR;
#undef PG8_SA
#undef PG8_SB
#undef PG8_STAGE
#undef PG8_LDA
#undef PG8_LDB
#undef PG8_MMA
#undef PG8_WAIT_V
#undef PG8_WAIT_L
#undef PG8_BAR
#undef PG8_SCHED
}

struct EpiZ {
    static constexpr bool PERM = true;
    bf16_t* Z; const float* cs; float* LF; const float* fb; float* ssq; LAS unsigned char* xl;
    __device__ __forceinline__ void operator()(const f32x4 (&acc)[2][2][4][2], const Unit& u, int wr, int wc, int fr, int fq) const {
        const int row0 = u.pm * BM + wr * 64 + fr;
        if (u.pn <= 2) {
            const int lane = fr + 16 * fq;
            LAS f32x2* Pp = (LAS f32x2*)xl;
#pragma unroll
            for (int ai = 0; ai < 2; ++ai)
#pragma unroll
                for (int m = 0; m < 4; ++m) {
                    float sq = 0.f, sk = 0.f;
#pragma unroll
                    for (int bj = 0; bj < 2; ++bj) {
                        const int colg = u.pn * BM + bj * HALF + wc * 32 + 8 * fq;
                        const f32x4 a = acc[ai][bj][m][0], b = acc[ai][bj][m][1];
                        const float t = (a[0] * a[0] + a[1] * a[1]) + (a[2] * a[2] + a[3] * a[3]) + (b[0] * b[0] + b[1] * b[1]) + (b[2] * b[2] + b[3] * b[3]);
                        if (colg < ZC_CKV) sq += t; else if (colg < ZC_KPE) sk += t;
                    }
                    sq += shfl_xor_l(sq, 16, lane); sq += shfl_xor_l(sq, 32, lane);
                    sk += shfl_xor_l(sk, 16, lane); sk += shfl_xor_l(sk, 32, lane);
                    if (fq == 0) Pp[(ai * HALF + wr * 64 + m * 16 + fr) * 4 + wc] = (f32x2){sq, sk};
                }
            asm volatile("s_waitcnt lgkmcnt(0)" ::: "memory"); __builtin_amdgcn_s_barrier(); asm volatile("" ::: "memory");
            const int tid = (wr * 4 + wc) * 64 + lane;
            if (tid < 256) {
                const f32x2 a = Pp[tid * 4 + 0], b = Pp[tid * 4 + 1], c = Pp[tid * 4 + 2], d = Pp[tid * 4 + 3];
                float* dst = ssq + (size_t)(u.pm * BM + tid) * 2;
                if (u.pn <= 1) __hip_atomic_fetch_add(dst, (a[0] + b[0]) + (c[0] + d[0]), __ATOMIC_RELAXED, __HIP_MEMORY_SCOPE_AGENT);
                if (u.pn >= 1) __hip_atomic_fetch_add(dst + 1, (a[1] + b[1]) + (c[1] + d[1]), __ATOMIC_RELAXED, __HIP_MEMORY_SCOPE_AGENT);
            }
            asm volatile("" ::: "memory");
        }
#pragma unroll
        for (int bj = 0; bj < 2; ++bj) {
            const int colg = u.pn * BM + bj * HALF + wc * 32 + 8 * fq;
            const int zc = colg + (colg >= ZC_KPE ? 32 + ZPAD : 0);
            const bool gatecol = (zc >= ZC_GATE && zc < ZC_BQ);
            const bool kvcol = (zc >= ZC_BK && zc < ZC_CQ2) || (zc >= ZC_CK);
#pragma unroll
            for (int ai = 0; ai < 2; ++ai)
#pragma unroll
                for (int m = 0; m < 4; ++m) {
                    const int row = row0 + ai * HALF + m * 16;
                    f32x4 v0 = acc[ai][bj][m][0], v1 = acc[ai][bj][m][1];
                    if (gatecol) {
#pragma unroll
                        for (int i = 0; i < 4; ++i) { v0[i] = v0[i] * __builtin_amdgcn_rcpf(1.f + __builtin_amdgcn_exp2f(-LOG2E * v0[i])); v1[i] = v1[i] * __builtin_amdgcn_rcpf(1.f + __builtin_amdgcn_exp2f(-LOG2E * v1[i])); }
                    }
                    u32x4 w; w.x = cvtpk(v0[0], v0[1]); w.y = cvtpk(v0[2], v0[3]); w.z = cvtpk(v1[0], v1[1]); w.w = cvtpk(v1[2], v1[3]);
                    if (kvcol) *(u32x4*)(Z + (size_t)row * NZ + zc) = w; else __builtin_nontemporal_store(w, (u32x4*)(Z + (size_t)row * NZ + zc));
                    if (m == 3) asm volatile("" ::: "memory");
                }
        }
    }
};
struct EpiQ {
    static constexpr bool PERM = true;
    bf16_t* O; const float* cs; const float* rs;
    __device__ __forceinline__ void operator()(const f32x4 (&acc)[2][2][4][2], const Unit& u, int wr, int wc, int fr, int fq) const {
        const int row0 = u.pm * BM + wr * 64 + fr;
        float rr[8];
#pragma unroll
        for (int j = 0; j < 8; ++j) rr[j] = rs[(size_t)(row0 + (j >> 2) * HALF + (j & 3) * 16) * 2];
#pragma unroll
        for (int j = 0; j < 8; ++j) rr[j] = __builtin_amdgcn_rsqf(rr[j] * (1.f / 384.f) + EPS);
#pragma unroll
        for (int bj = 0; bj < 2; ++bj) {
            const int colg = u.pn * BM + bj * HALF + wc * 32 + 8 * fq;
            if (colg >= 576) continue;
            const int hd = colg % 96;
            const bool rope = hd >= 64;
            const int i0 = rope ? ((hd - 64) >> 1) : 0;
#pragma unroll
            for (int ai = 0; ai < 2; ++ai) {
                f32x4 co[4], si[4];
                if (rope) {
#pragma unroll
                    for (int m = 0; m < 4; ++m) { const size_t row = (size_t)(row0 + ai * HALF + m * 16); co[m] = *(const f32x4*)(cs + row * 32 + i0); si[m] = *(const f32x4*)(cs + row * 32 + 16 + i0); }
                }
#pragma unroll
                for (int m = 0; m < 4; ++m) {
                    const int row = row0 + ai * HALF + m * 16;
                    const float r = rr[ai * 4 + m];
                    f32x4 v0 = acc[ai][bj][m][0] * r, v1 = acc[ai][bj][m][1] * r;
                    if (rope) {
                        f32x4 a, b;
                        a[0] = v0[0] * co[m][0] - v0[1] * si[m][0]; a[1] = v0[0] * si[m][0] + v0[1] * co[m][0];
                        a[2] = v0[2] * co[m][1] - v0[3] * si[m][1]; a[3] = v0[2] * si[m][1] + v0[3] * co[m][1];
                        b[0] = v1[0] * co[m][2] - v1[1] * si[m][2]; b[1] = v1[0] * si[m][2] + v1[1] * co[m][2];
                        b[2] = v1[2] * co[m][3] - v1[3] * si[m][3]; b[3] = v1[2] * si[m][3] + v1[3] * co[m][3];
                        v0 = a; v1 = b;
                    }
                    u32x4 w; w.x = cvtpk(v0[0], v0[1]); w.y = cvtpk(v0[2], v0[3]); w.z = cvtpk(v1[0], v1[1]); w.w = cvtpk(v1[2], v1[3]);
                    *(u32x4*)(O + (size_t)row * QAP + colg) = w;
                }
                asm volatile("" ::: "memory");
            }
        }
    }
};
struct EpiKV {
    static constexpr bool PERM = true;
    bf16_t* O; const float* rs;
    __device__ __forceinline__ void operator()(const f32x4 (&acc)[2][2][4][2], const Unit& u, int wr, int wc, int fr, int fq) const {
        const int row0 = u.pm * BM + wr * 64 + fr;
        float rr[8];
#pragma unroll
        for (int j = 0; j < 8; ++j) rr[j] = rs[(size_t)(row0 + (j >> 2) * HALF + (j & 3) * 16) * 2 + 1];
#pragma unroll
        for (int j = 0; j < 8; ++j) rr[j] = __builtin_amdgcn_rsqf(rr[j] * (1.f / 256.f) + EPS);
#pragma unroll
        for (int bj = 0; bj < 2; ++bj) {
            const int colg = u.pn * BM + bj * HALF + wc * 32 + 8 * fq;
#pragma unroll
            for (int ai = 0; ai < 2; ++ai)
#pragma unroll
                for (int m = 0; m < 4; ++m) {
                    const int row = row0 + ai * HALF + m * 16;
                    const float r = rr[ai * 4 + m];
                    const f32x4 v0 = acc[ai][bj][m][0] * r, v1 = acc[ai][bj][m][1] * r;
                    u32x4 w; w.x = cvtpk(v0[0], v0[1]); w.y = cvtpk(v0[2], v0[3]); w.z = cvtpk(v1[0], v1[1]); w.w = cvtpk(v1[2], v1[3]);
                    *(u32x4*)(O + (size_t)row * QAP + colg) = w;
                    asm volatile("" ::: "memory");
                }
        }
    }
};
struct EpiUp {
    static constexpr bool PERM = true;
    EpiQ q; EpiKV kv;
    __device__ __forceinline__ void operator()(const f32x4 (&acc)[2][2][4][2], const Unit& u, int wr, int wc, int fr, int fq) const { if (u.kind == 0) q(acc, u, wr, wc, fr, fq); else kv(acc, u, wr, wc, fr, fq); }
};
struct EpiOut {
    static constexpr bool PERM = true;
    const float* xold; float* xnew; const float* gate;
    __device__ __forceinline__ void operator()(const f32x4 (&acc)[2][2][4][2], const Unit& u, int wr, int wc, int fr, int fq) const {
        const int row0 = u.pm * BM + wr * 64 + fr;
        const int b = (u.pm * BM) / SEQ;
#pragma unroll
        for (int bj = 0; bj < 2; ++bj) {
            const int colg = u.pn * BM + bj * HALF + wc * 32 + 8 * fq;
            const f32x4 g0 = *(const f32x4*)(gate + (size_t)b * 3072 + colg), g1 = *(const f32x4*)(gate + (size_t)b * 3072 + colg + 4);
#pragma unroll
            for (int ai = 0; ai < 2; ++ai)
#pragma unroll
                for (int m = 0; m < 4; ++m) {
                    const int row = row0 + ai * HALF + m * 16;
                    const size_t off = (size_t)row * DM + colg;
                    const f32x4 x0 = *(const f32x4*)(xold + off), x1 = *(const f32x4*)(xold + off + 4);
                    *(f32x4*)(xnew + off) = x0 + g0 * acc[ai][bj][m][0];
                    *(f32x4*)(xnew + off + 4) = x1 + g1 * acc[ai][bj][m][1];
                    if (m & 1) asm volatile("" ::: "memory");
                }
        }
    }
};

template <bool LAST>
struct EpiOutN {
    static constexpr bool PERM = true;
    const float* xold; float* xnew; const float* gate; const float* ng; const float* modn; bf16_t* H; float* ssq;
    float* xbuf; unsigned* cnt; LAS unsigned char* xl;
    __device__ __forceinline__ void operator()(f32x4 (&acc)[2][2][4][2], const Unit& u, int wr, int wc, int fr, int fq) const {
        const int lane = fr + 16 * fq, wid = wr * 4 + wc;
        const int row0 = u.pm * BM + wr * 64 + fr;
        const int b = (u.pm * BM) / SEQ;
        LAS float* Pp = (LAS float*)xl;
        LAS float* Sp = (LAS float*)(xl + 4096);
        volatile LAS unsigned* flag = (volatile LAS unsigned*)(xl + 5120);
#pragma unroll
        for (int bj = 0; bj < 2; ++bj) {
            const int colg = u.pn * BM + bj * HALF + wc * 32 + 8 * fq;
            const f32x4 g0 = *(const f32x4*)(gate + (size_t)b * 3072 + colg), g1 = *(const f32x4*)(gate + (size_t)b * 3072 + colg + 4);
#pragma unroll
            for (int ai = 0; ai < 2; ++ai) {
                f32x4 x0[4], x1[4];
#pragma unroll
                for (int m = 0; m < 4; ++m) {
                    const size_t r = (size_t)(row0 + ai * HALF + m * 16);
                    if (LAST) {
                        const u32x4 xb = __builtin_nontemporal_load((const u32x4*)((const bf16_t*)xold + r * (2 * DM) + colg));
                        x0[m] = (f32x4){bf_lo(xb.x), bf_hi(xb.x), bf_lo(xb.y), bf_hi(xb.y)}; x1[m] = (f32x4){bf_lo(xb.z), bf_hi(xb.z), bf_lo(xb.w), bf_hi(xb.w)};
                    } else { x0[m] = __builtin_nontemporal_load((const f32x4*)(xold + r * DM + colg)); x1[m] = __builtin_nontemporal_load((const f32x4*)(xold + r * DM + colg + 4)); }
                }
#pragma unroll
                for (int m = 0; m < 4; ++m) {
                    acc[ai][bj][m][0] = x0[m] + g0 * acc[ai][bj][m][0];
                    acc[ai][bj][m][1] = x1[m] + g1 * acc[ai][bj][m][1];
                    asm volatile("" : "+v"(acc[ai][bj][m][0]), "+v"(acc[ai][bj][m][1]));
                }
                asm volatile("" ::: "memory");
            }
        }
#pragma unroll
        for (int ai = 0; ai < 2; ++ai)
#pragma unroll
            for (int m = 0; m < 4; ++m) {
                float t = 0.f;
#pragma unroll
                for (int bj = 0; bj < 2; ++bj) { const f32x4 p = acc[ai][bj][m][0], q = acc[ai][bj][m][1];
                    t += (p[0] * p[0] + p[1] * p[1]) + (p[2] * p[2] + p[3] * p[3]) + (q[0] * q[0] + q[1] * q[1]) + (q[2] * q[2] + q[3] * q[3]); }
                t += shfl_xor_l(t, 16, lane); t += shfl_xor_l(t, 32, lane);
                if (fq == 0) Pp[(ai * HALF + wr * 64 + m * 16 + fr) * 4 + wc] = t;
            }
        asm volatile("s_waitcnt lgkmcnt(0)" ::: "memory"); __builtin_amdgcn_s_barrier(); asm volatile("" ::: "memory");
        const int row = wid * 32 + (lane & 31);
        if (lane < 32) {
            const f32x4 p = *(const LAS f32x4*)(Pp + row * 4);
            __hip_atomic_store(xbuf + (size_t)(u.pm * BM + row) * 4 + u.pn, (p[0] + p[1]) + (p[2] + p[3]), __ATOMIC_RELAXED, __HIP_MEMORY_SCOPE_AGENT);
        }
        asm volatile("s_waitcnt vmcnt(0)" ::: "memory");
        if (lane == 0) __hip_atomic_fetch_add(cnt + 64 * u.pm, 1u, __ATOMIC_RELAXED, __HIP_MEMORY_SCOPE_AGENT);
        if (!LAST) {
#pragma unroll
            for (int bj = 0; bj < 2; ++bj) {
                const int colg = u.pn * BM + bj * HALF + wc * 32 + 8 * fq;
#pragma unroll
                for (int ai = 0; ai < 2; ++ai)
#pragma unroll
                    for (int m = 0; m < 4; ++m) {
                        const int rt = ai * HALF + wr * 64 + m * 16 + fr;
                        const f32x4 v0 = acc[ai][bj][m][0], v1 = acc[ai][bj][m][1];
                        u32x4 xw; xw.x = cvtpk(v0[0], v0[1]); xw.y = cvtpk(v0[2], v0[3]); xw.z = cvtpk(v1[0], v1[1]); xw.w = cvtpk(v1[2], v1[3]);
                        *(u32x4*)((bf16_t*)xnew + (size_t)(u.pm * BM + rt) * (2 * DM) + colg) = xw;
                        if (m & 1) asm volatile("" ::: "memory");
                    }
            }
        }
        if (wid == 0) {
            bool dead = false; unsigned spins = 0u;
            for (;;) {
                if ((unsigned)__builtin_amdgcn_readfirstlane(__hip_atomic_load(cnt + 64 * u.pm, __ATOMIC_RELAXED, __HIP_MEMORY_SCOPE_AGENT)) >= 32u) break;
                if (++spins > (1u << 22)) { dead = true; break; }
                __builtin_amdgcn_s_sleep(2);
            }
            __builtin_amdgcn_fence(__ATOMIC_ACQUIRE, "agent");
            if (lane == 0) flag[0] = dead ? 1u : 0u;
        }
        asm volatile("s_waitcnt vmcnt(0) lgkmcnt(0)" ::: "memory"); __builtin_amdgcn_s_barrier(); asm volatile("" ::: "memory");
        const bool bad = flag[0] != 0u;
        if (lane < 32) {
            const float* slot = xbuf + (size_t)(u.pm * BM + row) * 4;
            float t = 0.f;
#pragma unroll
            for (int k = 0; k < 4; ++k) t += __hip_atomic_load(slot + k, __ATOMIC_RELAXED, __HIP_MEMORY_SCOPE_AGENT);
            Sp[row] = 1.0f / sqrtf(t * (1.f / DM) + EPS);
            if (!LAST && u.pn == 0) *(f32x2*)(ssq + (size_t)(u.pm * BM + row) * 2) = (f32x2){0.f, 0.f};
        }
        asm volatile("s_waitcnt vmcnt(0) lgkmcnt(0)" ::: "memory"); __builtin_amdgcn_s_barrier(); asm volatile("" ::: "memory");
        const float qnan = __builtin_nanf("");
#pragma unroll
        for (int bj = 0; bj < 2; ++bj) {
            const int colg = u.pn * BM + bj * HALF + wc * 32 + 8 * fq;
            f32x4 G0, G1, S0, S1;
            if (LAST) { G0 = *(const f32x4*)(ng + colg); G1 = *(const f32x4*)(ng + colg + 4); S0 = (f32x4){0.f, 0.f, 0.f, 0.f}; S1 = S0; }
            else {
                const float* mb = modn + (size_t)b * 3072;
                G0 = *(const f32x4*)(ng + colg) * (*(const f32x4*)(mb + 1024 + colg) + 1.0f); G1 = *(const f32x4*)(ng + colg + 4) * (*(const f32x4*)(mb + 1024 + colg + 4) + 1.0f);
                S0 = *(const f32x4*)(mb + colg); S1 = *(const f32x4*)(mb + colg + 4);
            }
#pragma unroll
            for (int ai = 0; ai < 2; ++ai)
#pragma unroll
                for (int m = 0; m < 4; ++m) {
                    const int rt = ai * HALF + wr * 64 + m * 16 + fr;
                    const float rs = Sp[rt];
                    const size_t off = (size_t)(u.pm * BM + rt) * DM + colg;
                    f32x4 v0 = acc[ai][bj][m][0], v1 = acc[ai][bj][m][1];
                    if (bad) { v0 = (f32x4){qnan, qnan, qnan, qnan}; v1 = v0; }
                    if (LAST) {
                        *(f32x4*)(xnew + off) = v0 * rs * G0; *(f32x4*)(xnew + off + 4) = v1 * rs * G1;
                    } else {
                        const f32x4 h0 = v0 * rs * G0 + S0, h1 = v1 * rs * G1 + S1;
                        u32x4 w; w.x = cvtpk(h0[0], h0[1]); w.y = cvtpk(h0[2], h0[3]); w.z = cvtpk(h1[0], h1[1]); w.w = cvtpk(h1[2], h1[3]);
                        *(u32x4*)(H + off) = w;
                    }
                    if (m & 1) asm volatile("" ::: "memory");
                }
        }
    }
};
}

namespace att {
constexpr int KSLOT = 12288, VSLOT = 8192, NSLOT = 4;
constexpr int L_K = 0, L_V = NSLOT * KSLOT, L_WS = L_V + NSLOT * VSLOT, L_OST = L_WS + 2048, L_TB = L_OST + 8 * 4096, L_GB = L_TB + 2048, L_END = L_GB + NSLOT * 8 * 256;
static_assert(L_END <= 131072, "attention LDS map");
constexpr float NEG = -1e30f;
constexpr float THR = 8.0f;

struct AP { const bf16_t* Q; int qp; const bf16_t* K; int kp; const bf16_t* K2; int k2p; const bf16_t* V; int vp; const bf16_t* gate; bf16_t* out; const float* kb; unsigned* ctr; };
constexpr int L_NEXT = 131072 + 128;

#define ATT_WAIT_V(n) asm volatile("s_waitcnt vmcnt(" #n ")" ::: "memory")

template <int MODE>
__device__ __forceinline__ void attn_unit(const AP P, const int qb, LAS unsigned char* lds, const int wv) {
    constexpr int DQK = (MODE == 0) ? 96 : 64, NQ = DQK / 16;
    constexpr int PG = (MODE == 1) ? 2 : 3;
    const int lane = lane_now(), r32 = lane & 31, hi = lane >> 5;
    const int wid = wv, tid = wv * 64 + lane;
    const int q0 = qb * 256;
    const int cw = 4 * qb + (wid >> 1);
    int t0 = 0; const int t1 = 4 * qb + 4;
    if (MODE == 1) t0 = (4 * qb - 8) > 0 ? (4 * qb - 8) : 0;
    const int qrel = 32 * (wid & 1) + r32;
    const bf16_t* ksrc = P.K + (size_t)lane * P.kp + wid * 8;
    const bf16_t* k2src = (MODE == 0) ? (P.K2 + (size_t)lane * P.k2p + (wid & 3) * 8) : nullptr;
    const bf16_t* vsrc = P.V + (size_t)(16 * (wid & 3) + (lane >> 2)) * P.vp + (wid >> 2) * 32 + (lane & 3) * 8;
    const float* gsrc = (MODE == 2) ? (P.kb + lane) : nullptr;
#define ATT_DMA_K(t) do { const int sl_ = ((t) - t0) & (NSLOT - 1); \
        __builtin_amdgcn_global_load_lds((const unsigned*)(ksrc + (size_t)(t) * 64 * P.kp), (LAS unsigned*)(lds + L_K + sl_ * KSLOT + wid * 1024), 16, 0, 0); \
        if (MODE == 0) __builtin_amdgcn_global_load_lds((const unsigned*)(k2src + (size_t)(t) * 64 * P.k2p), (LAS unsigned*)(lds + L_K + sl_ * KSLOT + 8192 + (wid & 3) * 1024), 16, 0, 0); } while (0)
#define ATT_DMA_V(t) do { const int sl_ = ((t) - t0) & (NSLOT - 1); \
        __builtin_amdgcn_global_load_lds((const unsigned*)(vsrc + (size_t)(t) * 64 * P.vp), (LAS unsigned*)(lds + L_V + sl_ * VSLOT + wid * 1024), 16, 0, 0); \
        if (MODE == 2) __builtin_amdgcn_global_load_lds((const unsigned*)(gsrc + (t) * 64), (LAS unsigned*)(lds + L_GB + (sl_ * 8 + wid) * 256), 4, 0, 0); } while (0)
#define ATT_VALID(t) (((t) <= cw) && (MODE != 1 || (t) >= cw - 8))
    ATT_DMA_K(t0); ATT_DMA_K(t0 + 1); ATT_DMA_K(t0 + 2); ATT_DMA_K(t0 + 3); ATT_DMA_V(t0); ATT_DMA_V(t0 + 1);
    bf16x8 qr[NQ];
    {
        const bf16_t* Qw = P.Q + (size_t)(q0 + wid * 32 + r32) * P.qp + hi * 8;
#pragma unroll
        for (int d0 = 0; d0 < NQ; ++d0) qr[d0] = *(const bf16x8*)(Qw + d0 * 16);
    }
    if (MODE == 1) { LAS float* tb = (LAS float*)(lds + L_TB); for (int i = tid; i < 257; i += 512) tb[i] = P.kb[i] * LOG2E; }
    float m_run = NEG, l_run = 0.f;
    f32x16 o0, o1;
#pragma unroll
    for (int r = 0; r < 16; ++r) { o0[r] = 0.f; o1[r] = 0.f; }
    LAS float* wsf = (LAS float*)(lds + L_WS) + wid * 64;
    const int vboff = ((lane >> 4) & 1) * 32 + (lane & 3) * 8 + (4 * hi + ((lane & 15) >> 2)) * 64;
    const LAS unsigned char* kbase = lds + L_K + hi * 1024 + r32 * 16;
    bf16x8 kf[2 * NQ];
    f32x16 sc0, sc1;
#define ATT_KLOAD(t) do { const LAS unsigned char* kp_ = kbase + (((t) - t0) & (NSLOT - 1)) * KSLOT; \
        _Pragma("unroll") for (int d0 = 0; d0 < NQ; ++d0) { kf[2 * d0] = *(const LAS bf16x8*)(kp_ + d0 * 2048); kf[2 * d0 + 1] = *(const LAS bf16x8*)(kp_ + d0 * 2048 + 512); } } while (0)
#define ATT_QK(d0_, d1_) do { _Pragma("unroll") for (int r = 0; r < 16; ++r) { d0_[r] = 0.f; d1_[r] = 0.f; } \
        _Pragma("unroll") for (int d0 = 0; d0 < NQ; ++d0) { d0_ = __builtin_amdgcn_mfma_f32_32x32x16_bf16(kf[2 * d0], qr[d0], d0_, 0, 0, 0); d1_ = __builtin_amdgcn_mfma_f32_32x32x16_bf16(kf[2 * d0 + 1], qr[d0], d1_, 0, 0, 0); } } while (0)
    ATT_WAIT_V(0);
    asm volatile("s_waitcnt lgkmcnt(0)" ::: "memory");
    __builtin_amdgcn_s_barrier();
    asm volatile("" ::: "memory");
    ATT_KLOAD(t0);
    ATT_QK(sc0, sc1);
    ATT_KLOAD(t0 + 1);
    for (int t = t0; t < t1; ++t) {
        const int cur = (t - t0) & (NSLOT - 1);
        {
            if (t + 3 < t1) { if (PG == 2) ATT_WAIT_V(2); else ATT_WAIT_V(3); } else ATT_WAIT_V(0);
            asm volatile("s_waitcnt lgkmcnt(0)" ::: "memory");
            __builtin_amdgcn_s_barrier();
            asm volatile("" ::: "memory");
        }
        if (t + 4 < t1) ATT_DMA_K(t + 4);
        if (t + 2 < t1) ATT_DMA_V(t + 2);
        const bool vcur = ATT_VALID(t), vnext = (t + 1 < t1) && ATT_VALID(t + 1);
        f32x16 sn0, sn1;
        if (vnext) ATT_QK(sn0, sn1);
        if (t + 2 < t1) ATT_KLOAD(t + 2);
        if (vcur) {
            f32x16 p0 = sc0, p1 = sc1;
            if (MODE == 2) {
                const LAS float* gp = (const LAS float*)(lds + L_GB + (cur * 8 + wid) * 256) + 4 * hi;
#pragma unroll
                for (int g4 = 0; g4 < 4; ++g4) {
                    const f32x4 a = *(const LAS f32x4*)(gp + 8 * g4), b = *(const LAS f32x4*)(gp + 32 + 8 * g4);
#pragma unroll
                    for (int i = 0; i < 4; ++i) { p0[4 * g4 + i] += a[i]; p1[4 * g4 + i] += b[i]; }
                }
                if (t == cw) {
#pragma unroll
                    for (int r = 0; r < 16; ++r) { const int kj = (r & 3) + 8 * (r >> 2) + 4 * hi; if (kj > qrel) p0[r] = NEG; if (kj + 32 > qrel) p1[r] = NEG; }
                }
            }
            if (MODE == 1) {
                const LAS float* tb = (const LAS float*)(lds + L_TB);
                const int mm = cw - t;
                if (mm >= 3) {
                    const float c = tb[256];
#pragma unroll
                    for (int r = 0; r < 16; ++r) { p0[r] += c; p1[r] += c; }
                } else {
                    const int base = 64 * mm + qrel - 4 * hi;
#pragma unroll
                    for (int r = 0; r < 16; ++r) {
                        const int c0 = (r & 3) + 8 * (r >> 2);
                        int i0 = base - c0; i0 = (i0 > 128 ? 128 : i0) + 128;
                        int i1 = base - c0 - 32; i1 = (i1 > 128 ? 128 : i1) + 128;
                        p0[r] += tb[i0]; p1[r] += tb[i1];
                    }
                }
            }
            float rm = fmaxf(p0[0], p1[0]);
#pragma unroll
            for (int r = 1; r < 16; ++r) rm = fmaxf(rm, fmaxf(p0[r], p1[r]));
            rm = fmaxf(rm, shfl_xor_l(rm, 32, lane));
            if (__any(rm > m_run + THR)) {
                const float mn = fmaxf(m_run, rm);
                const float f = __builtin_amdgcn_exp2f(m_run - mn);
                m_run = mn; l_run *= f;
                if (hi == 0) wsf[r32] = f;
                asm volatile("" ::: "memory");
#pragma unroll
                for (int g4 = 0; g4 < 4; ++g4) {
                    const f32x4 fv = *(const LAS f32x4*)(wsf + 8 * g4 + 4 * hi);
#pragma unroll
                    for (int i = 0; i < 4; ++i) { o0[4 * g4 + i] *= fv[i]; o1[4 * g4 + i] *= fv[i]; }
                }
            }
            float s = 0.f;
#pragma unroll
            for (int r = 0; r < 16; ++r) { p0[r] = __builtin_amdgcn_exp2f(p0[r] - m_run); p1[r] = __builtin_amdgcn_exp2f(p1[r] - m_run); s += p0[r] + p1[r]; }
            l_run += s;
            u32x4 pw[4];
            pw[0] = (u32x4){cvtpk(p0[0], p0[1]), cvtpk(p0[2], p0[3]), cvtpk(p0[4], p0[5]), cvtpk(p0[6], p0[7])};
            pw[1] = (u32x4){cvtpk(p0[8], p0[9]), cvtpk(p0[10], p0[11]), cvtpk(p0[12], p0[13]), cvtpk(p0[14], p0[15])};
            pw[2] = (u32x4){cvtpk(p1[0], p1[1]), cvtpk(p1[2], p1[3]), cvtpk(p1[4], p1[5]), cvtpk(p1[6], p1[7])};
            pw[3] = (u32x4){cvtpk(p1[8], p1[9]), cvtpk(p1[10], p1[11]), cvtpk(p1[12], p1[13]), cvtpk(p1[14], p1[15])};
            const unsigned vb = (unsigned)(uintptr_t)(lds + L_V + cur * VSLOT + vboff);
#pragma unroll
            for (int d0 = 0; d0 < 2; ++d0) {
                s16x4 lo[4], hh[4];
#pragma unroll
                for (int ks = 0; ks < 4; ++ks) {
                    asm volatile("ds_read_b64_tr_b16 %0, %1 offset:%c2" : "=&v"(lo[ks]) : "v"(vb), "i"(d0 * 4096 + ks * 1024) : "memory");
                    asm volatile("ds_read_b64_tr_b16 %0, %1 offset:%c2" : "=&v"(hh[ks]) : "v"(vb), "i"(d0 * 4096 + ks * 1024 + 512) : "memory");
                }
                asm volatile("s_waitcnt lgkmcnt(0)" ::: "memory"); __builtin_amdgcn_sched_barrier(0);
#pragma unroll
                for (int ks = 0; ks < 4; ++ks) {
                    const bf16x8 pa = __builtin_bit_cast(bf16x8, pw[ks]);
                    const bf16x8 vf = {lo[ks][0], lo[ks][1], lo[ks][2], lo[ks][3], hh[ks][0], hh[ks][1], hh[ks][2], hh[ks][3]};
                    if (d0 == 0) o0 = __builtin_amdgcn_mfma_f32_32x32x16_bf16(pa, vf, o0, 0, 0, 0);
                    else o1 = __builtin_amdgcn_mfma_f32_32x32x16_bf16(pa, vf, o1, 0, 0, 0);
                }
            }
        }
        if (vnext) { sc0 = sn0; sc1 = sn1; }
    }
    unsigned nxt_unit = 0u;
    if (tid == 0) nxt_unit = __hip_atomic_fetch_add(P.ctr, 1u, __ATOMIC_RELAXED, __HIP_MEMORY_SCOPE_AGENT);
    l_run += shfl_xor_l(l_run, 32, lane);
    if (hi == 0) wsf[32 + r32] = l_run;
    asm volatile("" ::: "memory");
    float rli[16];
#pragma unroll
    for (int g4 = 0; g4 < 4; ++g4) {
        const f32x4 lv = *(const LAS f32x4*)(wsf + 32 + 8 * g4 + 4 * hi);
#pragma unroll
        for (int i = 0; i < 4; ++i) rli[4 * g4 + i] = 1.0f / lv[i];
    }
    LAS bf16_t* stg = (LAS bf16_t*)(lds + L_OST) + wid * 2048;
#pragma unroll
    for (int r = 0; r < 16; ++r) {
        const int orow = (r & 3) + 8 * (r >> 2) + 4 * hi;
        stg[orow * 64 + r32] = (bf16_t)(cvtpk(o0[r] * rli[r], 0.f) & 0xffffu);
        stg[orow * 64 + 32 + r32] = (bf16_t)(cvtpk(o1[r] * rli[r], 0.f) & 0xffffu);
    }
    asm volatile("" ::: "memory");
#pragma unroll
    for (int i = 0; i < 4; ++i) {
        const int row = i * 8 + (lane >> 3), ch = lane & 7;
        const u32x4 v = *(const LAS u32x4*)(stg + row * 64 + ch * 8);
        const size_t grow = (size_t)(q0 + wid * 32 + row);
        const u32x4 gt = *(const u32x4*)(P.gate + grow * NZ + ch * 8);
        u32x4 w;
        w.x = cvtpk(bf_lo(v.x) * bf_lo(gt.x), bf_hi(v.x) * bf_hi(gt.x));
        w.y = cvtpk(bf_lo(v.y) * bf_lo(gt.y), bf_hi(v.y) * bf_hi(gt.y));
        w.z = cvtpk(bf_lo(v.z) * bf_lo(gt.z), bf_hi(v.z) * bf_hi(gt.z));
        w.w = cvtpk(bf_lo(v.w) * bf_lo(gt.w), bf_hi(v.w) * bf_hi(gt.w));
        *(u32x4*)(P.out + grow * DM + ch * 8) = w;
    }
    if (tid == 0) *(volatile LAS unsigned*)(lds + L_NEXT) = nxt_unit;
    __syncthreads();
#undef ATT_DMA_K
#undef ATT_DMA_V
#undef ATT_VALID
#undef ATT_KLOAD
#undef ATT_QK
}
}


namespace fa {
constexpr int NW = 8, QBLK = 32, KVBLK = 64;
constexpr int NSLOT = 3, SLOTB = 8192;
template <int MODE> struct Map {
    static constexpr int KSLOT = (MODE == 0) ? 12288 : 8192;
    static constexpr int LDS_K = 0, LDS_V = NSLOT * KSLOT, LDS_WS = LDS_V + NSLOT * SLOTB, LDS_OST = LDS_WS + NW * 64 * 4, LDS_TB = LDS_OST + NW * 4096, LDS_G = LDS_TB + 2048, LDS_END = LDS_G + 8192;
    static_assert(LDS_END <= 131072, "fast attention LDS map");
};
typedef LAS const unsigned char* lds_cptr;
#define SBAR() __builtin_amdgcn_sched_barrier(0)
__device__ __forceinline__ int crow(int r, int hi) { return (r & 3) + 8 * (r >> 2) + 4 * hi; }
__device__ __forceinline__ void glds16(const void* gsrc, unsigned lds_dst) { unsigned keep;
    asm volatile("s_mov_b32 %0, m0\n\ts_mov_b32 m0, %2\n\ts_nop 0\n\tglobal_load_lds_dwordx4 %1, off\n\ts_mov_b32 m0, %0" : "=&s"(keep) : "v"(gsrc), "s"(lds_dst) : "memory"); }
__device__ __forceinline__ void glds16s(const void* sbase, unsigned voff, unsigned lds_dst) { unsigned keep;
    asm volatile("s_mov_b32 %0, m0\n\ts_mov_b32 m0, %3\n\ts_nop 0\n\tglobal_load_lds_dwordx4 %1, %2\n\ts_mov_b32 m0, %0" : "=&s"(keep) : "v"(voff), "s"(sbase), "s"(lds_dst) : "memory"); }
__device__ __forceinline__ float max3f(float a, float b, float c) { float r; asm("v_max3_f32 %0, %1, %2, %3" : "=v"(r) : "v"(a), "v"(b), "v"(c)); return r; }
__device__ __forceinline__ float max2f(float a, float b) { float r; asm("v_max_f32_e32 %0, %1, %2" : "=v"(r) : "v"(a), "v"(b)); return r; }
__device__ __forceinline__ float fadd_s(float a, float b) { float r; asm("v_add_f32_e32 %0, %1, %2" : "=v"(r) : "v"(a), "v"(b)); return r; }
__device__ __forceinline__ float fsub_s(float a, float b) { float r; asm("v_sub_f32_e32 %0, %1, %2" : "=v"(r) : "v"(a), "v"(b)); return r; }
#define WAIT_BAR(N) asm volatile("s_waitcnt vmcnt(" #N ") lgkmcnt(0)\n\ts_barrier" ::: "memory")
__device__ __forceinline__ void kx_init(int* kx, int r32, int hi) {
    const int a0 = (r32 >> 3) * 1024 + (r32 & 7) * 128, sw = (r32 >> 1) & 7;
#pragma unroll
    for (int d0 = 0; d0 < 4; ++d0) kx[d0] = a0 + (((2 * d0 + hi) ^ sw) << 4);
}
template <int NQ>
__device__ __forceinline__ void qkt(f32x16& p0, f32x16& p1, lds_cptr Kslot, const bf16x8* qr, const f32x16& negm, int r32, int hi, const int* kx) {
    lds_cptr kb = Kslot + hi * 1024 + r32 * 16;
#pragma unroll
    for (int d0 = 0; d0 < NQ; ++d0) {
        const bf16x8 b0 = (d0 < 4) ? *(const LAS bf16x8*)(Kslot + kx[d0 & 3]) : *(const LAS bf16x8*)(kb + d0 * 2048);
        const bf16x8 b1 = (d0 < 4) ? *(const LAS bf16x8*)(Kslot + kx[d0 & 3] + 4096) : *(const LAS bf16x8*)(kb + d0 * 2048 + 512);
        if (d0 == 0) { p0 = __builtin_amdgcn_mfma_f32_32x32x16_bf16(b0, qr[0], negm, 0, 0, 0); p1 = __builtin_amdgcn_mfma_f32_32x32x16_bf16(b1, qr[0], negm, 0, 0, 0); }
        else { p0 = __builtin_amdgcn_mfma_f32_32x32x16_bf16(b0, qr[d0], p0, 0, 0, 0); p1 = __builtin_amdgcn_mfma_f32_32x32x16_bf16(b1, qr[d0], p1, 0, 0, 0); } }
}
__device__ __forceinline__ void kload2(bf16x8* kf, lds_cptr kslot, int j, const int* kx) { kf[2 * j] = *(const LAS bf16x8*)(kslot + kx[j]); kf[2 * j + 1] = *(const LAS bf16x8*)(kslot + kx[j] + 4096); }
__device__ __forceinline__ void kload8(bf16x8* kf, lds_cptr kslot, const int* kx) {
#pragma unroll
    for (int j = 0; j < 4; ++j) kload2(kf, kslot, j, kx);
}
__device__ __forceinline__ s16x4 vtr(lds_cptr p) { return __builtin_bit_cast(s16x4, __builtin_amdgcn_ds_read_tr16_b64_v4i16((LAS s16x4*)p)); }
__device__ __forceinline__ float rowmax(const f32x16& p0, const f32x16& p1) {
    float a = max3f(p0[0], p0[1], p1[0]), b = max3f(p0[2], p0[3], p1[1]); a = max3f(a, p1[2], p1[3]);
#pragma unroll
    for (int r = 4; r < 16; r += 4) { a = max3f(a, p0[r], p0[r + 1]); b = max3f(b, p0[r + 2], p0[r + 3]); a = max3f(a, p1[r], p1[r + 1]); b = max3f(b, p1[r + 2], p1[r + 3]); }
    const float m = max2f(a, b);
    auto rr = __builtin_amdgcn_permlane32_swap(__float_as_uint(m), __float_as_uint(m), false, false);
    return max2f(__uint_as_float(rr[0]), __uint_as_float(rr[1]));
}
__device__ __forceinline__ void pv(f32x16* o, int vb, bf16x8 pa0, bf16x8 pa1, bf16x8 pa2, bf16x8 pa3) {
#pragma unroll
    for (int d0 = 0; d0 < 2; ++d0) { s16x4 lo[4], hi[4];
#pragma unroll
        for (int ks = 0; ks < 4; ++ks) {
            asm volatile("ds_read_b64_tr_b16 %0,%1 offset:%c2" : "=&v"(lo[ks]) : "v"(vb), "i"(d0 * 4096 + ks * 1024) : "memory");
            asm volatile("ds_read_b64_tr_b16 %0,%1 offset:%c2" : "=&v"(hi[ks]) : "v"(vb), "i"(d0 * 4096 + ks * 1024 + 512) : "memory"); }
        asm volatile("s_waitcnt lgkmcnt(0)" ::: "memory"); SBAR();
#define PK(k) (bf16x8){lo[k][0], lo[k][1], lo[k][2], lo[k][3], hi[k][0], hi[k][1], hi[k][2], hi[k][3]}
        o[d0] = __builtin_amdgcn_mfma_f32_32x32x16_bf16(pa0, PK(0), o[d0], 0, 0, 0);
        o[d0] = __builtin_amdgcn_mfma_f32_32x32x16_bf16(pa1, PK(1), o[d0], 0, 0, 0);
        o[d0] = __builtin_amdgcn_mfma_f32_32x32x16_bf16(pa2, PK(2), o[d0], 0, 0, 0);
        o[d0] = __builtin_amdgcn_mfma_f32_32x32x16_bf16(pa3, PK(3), o[d0], 0, 0, 0);
#undef PK
    }
}
template <int MODE>
__device__ __forceinline__ void bias_mask(f32x16& p0, f32x16& p1, int ta, int qb, int cw, int qrelu, int qrel64, int hi, const LAS float* tab) {
    if (MODE == 0) {
        if (ta > cw) {
            asm volatile("" ::: "memory");
            const float NEGI = -INFINITY;
#pragma unroll
            for (int r = 0; r < 16; ++r) { p0[r] = NEGI; p1[r] = NEGI; }
        }
    } else if (MODE == 2) {
        const LAS float* gp = tab + 64 * ta + 4 * hi;
#pragma unroll
        for (int g4 = 0; g4 < 4; ++g4) {
            const f32x4 a = *(const LAS f32x4*)(gp + 8 * g4), b = *(const LAS f32x4*)(gp + 32 + 8 * g4);
#pragma unroll
            for (int i = 0; i < 4; ++i) { p0[4 * g4 + i] += a[i]; p1[4 * g4 + i] += b[i]; }
            if (g4 == 1) { asm volatile("" : "+v"(p0), "+v"(p1) :: "memory"); }
        }
        const int jb = ta - 4 * qb;
        if (jb >= 0) {
            const float NEGI = -INFINITY; const int kb = 64 * jb + 4 * hi;
#pragma unroll
            for (int r = 0; r < 16; ++r) { const int kv = kb + (r & 3) + 8 * (r >> 2); if (kv > qrelu) p0[r] = NEGI; if (kv + 32 > qrelu) p1[r] = NEGI; }
        }
    } else {
        const int mm = cw - ta;
        if (mm < 0 || mm > 8) {
            const float NEGI = -INFINITY;
#pragma unroll
            for (int r = 0; r < 16; ++r) { p0[r] = NEGI; p1[r] = NEGI; }
        } else if (mm >= 3) {
            const float c = tab[256];
#pragma unroll
            for (int r = 0; r < 16; ++r) { p0[r] += c; p1[r] += c; }
        } else {
            const int base = 64 * mm + qrel64 - 4 * hi;
            const LAS float* tp = tab + (base + 128 - 59);
#pragma unroll
            for (int r = 0; r < 16; ++r) {
                const int c0 = (r & 3) + 8 * (r >> 2);
                p0[r] += tp[59 - c0]; p1[r] += tp[27 - c0];
            }
        }
    }
}

template <int MODE, int THRL>
__device__ __forceinline__ void attn_unit(const att::AP P, const int qb, LAS unsigned char* lds, const int wv) {
    constexpr int NQ = (MODE == 0) ? 6 : 4;
    constexpr int LDS_K = Map<MODE>::LDS_K, LDS_V = Map<MODE>::LDS_V, LDS_WS = Map<MODE>::LDS_WS, LDS_OST = Map<MODE>::LDS_OST, LDS_TB = Map<MODE>::LDS_TB, LDS_G = Map<MODE>::LDS_G;
    const int lane = lane_now(), r32 = lane & 31, hi = lane >> 5;
    const int wid = wv, tid = wv * 64 + lane;
    const int q0 = qb * 256;
    const int cw = 4 * qb + (wid >> 1);
    int t0 = 0; const int t1 = 4 * qb + 4;
    if (MODE == 1) t0 = (4 * qb - 8) > 0 ? (4 * qb - 8) : 0;
    const int NT = t1 - t0;
#define KOFF(sl) ((MODE == 0) ? ((sl) + ((sl) >> 1)) : (sl))
    const int qrelu = wid * QBLK + r32;
    const int qrel64 = 32 * (wid & 1) + r32;
    LAS float* tab = (LAS float*)(lds + (MODE == 2 ? LDS_G : LDS_TB));
    const bf16_t* Qw = P.Q + (size_t)(q0 + wid * QBLK) * P.qp;
    const bf16_t* Kh = P.K + (size_t)(t1 - 1) * KVBLK * P.kp; const bf16_t* Vh = P.V + (size_t)(t1 - 1) * KVBLK * P.vp;
    const unsigned lds0 = (unsigned)(uintptr_t)lds;
    LAS float* wsf = (LAS float*)(lds + LDS_WS) + wid * 64;
    const unsigned kvo = (unsigned)((8 * wid + (lane >> 3)) * P.kp + (((lane & 7) ^ (((wid & 1) << 2) | (lane >> 4))) * 8)) * 2u, vvo = (unsigned)((16 * (wid & 3) + (lane >> 2)) * P.vp + (wid >> 2) * 32 + (lane & 3) * 8) * 2u;
    const unsigned kdst = lds0 + LDS_K + wid * 1024, vdst = lds0 + LDS_V + wid * 1024;
    const bf16_t* K2h = (MODE == 0) ? (P.K2 + (size_t)(t1 - 1) * KVBLK * P.k2p) : nullptr; const unsigned k2vo = (MODE == 0) ? (unsigned)(lane * P.k2p + (wid & 3) * 8) * 2u : 0u;
    const unsigned k2dst = lds0 + LDS_K + 8192 + (wid & 3) * 1024;
#define DMA_K(t, slot) glds16s(Kh - (size_t)(t) * KVBLK * P.kp, kvo, (unsigned)__builtin_amdgcn_readfirstlane(kdst + KOFF(slot)))
#define DMA_K2(t, slot) glds16s(K2h - (size_t)(t) * KVBLK * P.k2p, k2vo, (unsigned)__builtin_amdgcn_readfirstlane(k2dst + KOFF(slot)))
#define DMA_V(t, slot) glds16s(Vh - (size_t)(t) * KVBLK * P.vp, vvo, (unsigned)__builtin_amdgcn_readfirstlane(vdst + (slot)))
    const int vb0 = (int)(lds0 + LDS_V) + ((lane >> 4) & 1) * 32 + (lane & 3) * 8 + (4 * hi + ((lane & 15) >> 2)) * 64;
    lds_cptr Kbase = lds + LDS_K; bf16x8 kf[8];
    int kx[4]; kx_init(kx, r32, hi);
    lds_cptr kp0 = lds + LDS_K + hi * 1024 + r32 * 16; lds_cptr vp0 = lds + LDS_V + ((lane >> 4) & 1) * 32 + (lane & 3) * 8 + (4 * hi + ((lane & 15) >> 2)) * 64;
    DMA_K(0, 0); if (MODE == 0) DMA_K2(0, 0); DMA_V(0, 0); DMA_K(1, SLOTB); if (MODE == 0) DMA_K2(1, SLOTB);
    bf16x8 qr[NQ];
#pragma unroll
    for (int d0 = 0; d0 < NQ; ++d0) qr[d0] = *(const bf16x8*)(Qw + (size_t)r32 * P.qp + d0 * 16 + hi * 8);
    if (MODE == 2) { if (4 * tid < t1 * 64) { const f32x4 g = *(const f32x4*)(P.kb + 4 * tid); *(LAS f32x4*)(tab + 4 * tid) = g; } }
    else if (MODE == 1) { if (tid < 320) tab[tid] = P.kb[tid < 256 ? tid : 256] * LOG2E; }
    float mhat = 0.f, l_reg = 0.f; f32x16 o[2];
#pragma unroll
    for (int r = 0; r < 16; ++r) { o[0][r] = 0.f; o[1][r] = 0.f; }
    f32x16 negm;
#pragma unroll
    for (int r = 0; r < 16; ++r) negm[r] = 0.f;
    asm volatile("" : "+v"(negm));
#define BMASK(P0, P1, t, BAND) bias_mask<MODE>(P0, P1, t1 - 1 - (t), qb, cw, qrelu, qrel64, hi, tab)
    bool resc = false;
#define START(P0, P1) do { const float rm = rowmax(P0, P1); resc = false; \
    { const float dl = __builtin_fmaxf(rm, -1.0e4f); mhat = fadd_s(mhat, dl); \
      _Pragma("unroll") for (int r = 0; r < 16; ++r) { P0[r] = fsub_s(P0[r], dl); P1[r] = fsub_s(P1[r], dl); } \
      _Pragma("unroll") for (int r = 0; r < 16; ++r) negm[r] = -mhat; asm volatile("" : "+v"(negm)); } \
    _Pragma("unroll") for (int r = 0; r < 16; ++r) P0[r] = __builtin_amdgcn_exp2f(P0[r]); } while (0)
#define RESC() do { if (resc) { asm volatile("s_waitcnt lgkmcnt(0)" ::: "memory"); \
      _Pragma("unroll") for (int d_ = 0; d_ < 2; ++d_) _Pragma("unroll") for (int r = 0; r < 16; ++r) o[d_][r] *= wsf[crow(r, hi)]; } } while (0)
    f32x16 pA0, pA1, pB0, pB1;
    int sl_prev = 0, sl_cur = 0, sl_next = SLOTB;
#define ROT() do { sl_prev = sl_cur; sl_cur = sl_next; sl_next = (sl_next == (NSLOT - 1) * SLOTB) ? 0 : sl_next + SLOTB; } while (0)
    DMA_K(2, 2 * SLOTB);
    if (MODE == 0) WAIT_BAR(4); else WAIT_BAR(3);
    qkt<NQ>(pA0, pA1, Kbase, qr, negm, r32, hi, kx); asm volatile("s_nop 15\n\ts_nop 7" : "+v"(pA0), "+v"(pA1)); BMASK(pA0, pA1, 0, true);
    START(pA0, pA1);
#pragma unroll
    for (int r = 0; r < 16; ++r) pA1[r] = __builtin_amdgcn_exp2f(pA1[r]);
    WAIT_BAR(0);
    DMA_K(3, 0); if (MODE == 0) DMA_K2(2, 2 * SLOTB); DMA_V(1, SLOTB);
    ROT();
    kload8(kf, Kbase + KOFF(sl_cur), kx);
    if (MODE == 0) WAIT_BAR(3); else WAIT_BAR(2);
    s16x4 vlo[8], vhi[8]; u32x4 pw0, pw1, pw2, pw3;
#define PKW(P, B) cvtpk(P[B], P[B + 1])
#define PAF(k) __builtin_bit_cast(bf16x8, pw##k)
#define VFR(i) (bf16x8){vlo[i][0], vlo[i][1], vlo[i][2], vlo[i][3], vhi[i][0], vhi[i][1], vhi[i][2], vhi[i][3]}
#define PIN(x) asm volatile("" : "+v"(x))
#define MX3(a, b, c) __builtin_fmaxf(__builtin_fmaxf((a), (b)), (c))
#define GAPA(MF, A0, A1, A2, A3, W0, W1, PW) do { MF; sacc += A0; sacc += A1; sacc += A2; sacc += A3; PIN(sacc); W0; W1; PIN(PW); SBAR(); } while (0)
#define EX(v) __builtin_amdgcn_exp2f(v)
#define GAPB(MF, X, B) do { MF; X[B] = EX(X[B]); X[B + 1] = EX(X[B + 1]); X[B + 2] = EX(X[B + 2]); X[B + 3] = EX(X[B + 3]); PIN(X); SBAR(); } while (0)
#define VRD(i) do { vlo[i] = vtr(vp_ + (((i) >> 2) * 4096 + ((i) & 3) * 1024)); vhi[i] = vtr(vp_ + (((i) >> 2) * 4096 + ((i) & 3) * 1024 + 512)); } while (0)
#define KRD(G, j) do { if (G) { kload2(kf, Kbase + KOFF(sl_next), j, kx); SBAR(); } } while (0)
#define STEP(C0, C1, P0, P1, t, GK, GK2, GV, GL, BAND) do { SBAR(); \
    lds_cptr vp_ = vp0 + sl_prev; \
    bf16x8 kr0, kr1, kr2, kr3; \
    if (MODE == 0) { lds_cptr kq_ = kp0 + KOFF(sl_cur) + 8192; kr0 = *(const LAS bf16x8*)(kq_); kr1 = *(const LAS bf16x8*)(kq_ + 512); kr2 = *(const LAS bf16x8*)(kq_ + 2048); kr3 = *(const LAS bf16x8*)(kq_ + 2560); SBAR(); } \
    VRD(0); SBAR(); float sacc = (P0[0] + P0[1]); \
    GAPA(C0 = __builtin_amdgcn_mfma_f32_32x32x16_bf16(kf[0], qr[0], negm, 0, 0, 0), P0[2], P0[3], P0[4], P0[5],     pw0[0] = PKW(P0, 0), pw0[1] = PKW(P0, 2), pw0); \
    VRD(4); SBAR(); GAPA(C1 = __builtin_amdgcn_mfma_f32_32x32x16_bf16(kf[1], qr[0], negm, 0, 0, 0), P0[6], P0[7], P0[8], P0[9],     pw0[2] = PKW(P0, 4), pw0[3] = PKW(P0, 6), pw0); \
    VRD(1); SBAR(); GAPA(C0 = __builtin_amdgcn_mfma_f32_32x32x16_bf16(kf[2], qr[1], C0, 0, 0, 0),   P0[10], P0[11], P0[12], P0[13], pw1[0] = PKW(P0, 8), pw1[1] = PKW(P0, 10), pw1); \
    VRD(5); SBAR(); GAPA(C1 = __builtin_amdgcn_mfma_f32_32x32x16_bf16(kf[3], qr[1], C1, 0, 0, 0),   P0[14], P0[15], P1[0], P1[1],   pw1[2] = PKW(P0, 12), pw1[3] = PKW(P0, 14), pw1); \
    VRD(2); SBAR(); GAPA(C0 = __builtin_amdgcn_mfma_f32_32x32x16_bf16(kf[4], qr[2], C0, 0, 0, 0),   P1[2], P1[3], P1[4], P1[5],     pw2[0] = PKW(P1, 0), pw2[1] = PKW(P1, 2), pw2); \
    VRD(6); SBAR(); GAPA(C1 = __builtin_amdgcn_mfma_f32_32x32x16_bf16(kf[5], qr[2], C1, 0, 0, 0),   P1[6], P1[7], P1[8], P1[9],     pw2[2] = PKW(P1, 4), pw2[3] = PKW(P1, 6), pw2); \
    VRD(3); SBAR(); GAPA(C0 = __builtin_amdgcn_mfma_f32_32x32x16_bf16(kf[6], qr[3], C0, 0, 0, 0),   P1[10], P1[11], P1[12], P1[13], pw3[0] = PKW(P1, 8), pw3[1] = PKW(P1, 10), pw3); \
    VRD(7); SBAR(); GAPA(C1 = __builtin_amdgcn_mfma_f32_32x32x16_bf16(kf[7], qr[3], C1, 0, 0, 0),   P1[14], P1[15], 0.f, 0.f,       pw3[2] = PKW(P1, 12), pw3[3] = PKW(P1, 14), pw3); \
    if (MODE == 0) { \
        C0 = __builtin_amdgcn_mfma_f32_32x32x16_bf16(kr0, qr[NQ - 2], C0, 0, 0, 0); C1 = __builtin_amdgcn_mfma_f32_32x32x16_bf16(kr1, qr[NQ - 2], C1, 0, 0, 0); \
        C0 = __builtin_amdgcn_mfma_f32_32x32x16_bf16(kr2, qr[NQ - 1], C0, 0, 0, 0); C1 = __builtin_amdgcn_mfma_f32_32x32x16_bf16(kr3, qr[NQ - 1], C1, 0, 0, 0); SBAR(); } \
    l_reg += sacc; \
    if (GK) { DMA_K((t) + 3, sl_cur); } if (MODE == 0 && (GK2)) { DMA_K2((t) + 2, sl_prev); } if (GV) { DMA_V((t) + 1, sl_next); } \
    BMASK(C0, C1, t, BAND); \
    { float a = MX3(C0[0], C0[1], C1[0]), b = MX3(C0[2], C0[3], C1[1]); a = MX3(a, C1[2], C1[3]); \
      _Pragma("unroll") for (int r = 4; r < 16; r += 4) { a = MX3(a, C0[r], C0[r + 1]); b = MX3(b, C0[r + 2], C0[r + 3]); a = MX3(a, C1[r], C1[r + 1]); b = MX3(b, C1[r + 2], C1[r + 3]); } \
      float rm = __builtin_fmaxf(a, b); { auto rr = __builtin_amdgcn_permlane32_swap(__float_as_uint(rm), __float_as_uint(rm), false, false); rm = __builtin_fmaxf(__uint_as_float(rr[0]), __uint_as_float(rr[1])); } \
      resc = false; \
      if (__builtin_expect(__any(rm > (float)THRL), 0)) { const float dl = __builtin_fmaxf(rm, 0.f); mhat += dl; \
        _Pragma("unroll") for (int r = 0; r < 16; ++r) { C0[r] -= dl; C1[r] -= dl; } \
        _Pragma("unroll") for (int r = 0; r < 16; ++r) negm[r] = -mhat; asm volatile("" : "+v"(negm)); \
        const float f = __builtin_amdgcn_exp2f(-dl); l_reg *= f; if (hi == 0) wsf[r32] = f; resc = true; } } \
    SBAR(); \
    GAPB(o[0] = __builtin_amdgcn_mfma_f32_32x32x16_bf16(PAF(0), VFR(0), o[0], 0, 0, 0), C0, 0); \
    GAPB(o[1] = __builtin_amdgcn_mfma_f32_32x32x16_bf16(PAF(0), VFR(4), o[1], 0, 0, 0), C0, 4); \
    KRD(GL, 0); GAPB(o[0] = __builtin_amdgcn_mfma_f32_32x32x16_bf16(PAF(1), VFR(1), o[0], 0, 0, 0), C0, 8); \
    KRD(GL, 1); GAPB(o[1] = __builtin_amdgcn_mfma_f32_32x32x16_bf16(PAF(1), VFR(5), o[1], 0, 0, 0), C0, 12); \
    KRD(GL, 2); GAPB(o[0] = __builtin_amdgcn_mfma_f32_32x32x16_bf16(PAF(2), VFR(2), o[0], 0, 0, 0), C1, 0); \
    KRD(GL, 3); GAPB(o[1] = __builtin_amdgcn_mfma_f32_32x32x16_bf16(PAF(2), VFR(6), o[1], 0, 0, 0), C1, 4); \
    GAPB(o[0] = __builtin_amdgcn_mfma_f32_32x32x16_bf16(PAF(3), VFR(3), o[0], 0, 0, 0), C1, 8); \
    GAPB(o[1] = __builtin_amdgcn_mfma_f32_32x32x16_bf16(PAF(3), VFR(7), o[1], 0, 0, 0), C1, 12); \
    } while (0)
    int t = 1;
#define ENDW(tt) do { if ((tt) + 3 < NT) { if (MODE == 0) WAIT_BAR(3); else WAIT_BAR(2); } else if ((tt) + 2 < NT) { if (MODE == 0) WAIT_BAR(2); else WAIT_BAR(1); } else { WAIT_BAR(0); } } while (0)
    for (; t + 1 < NT; t += 2) {
        STEP(pB0, pB1, pA0, pA1, t, (t + 3 < NT), (t + 2 < NT), (t + 1 < NT), (t + 1 < NT), true);         ENDW(t);     RESC(); ROT();
        STEP(pA0, pA1, pB0, pB1, t + 1, (t + 4 < NT), (t + 3 < NT), (t + 2 < NT), (t + 2 < NT), true);     ENDW(t + 1); RESC(); ROT();
    }
    STEP(pB0, pB1, pA0, pA1, NT - 1, false, false, false, false, true); RESC();
    u32x4 gtv[4];
#pragma unroll
    for (int i = 0; i < 4; ++i) gtv[i] = __builtin_nontemporal_load((const u32x4*)(P.gate + (size_t)(q0 + wid * QBLK + i * 8 + (lane >> 3)) * NZ + (lane & 7) * 8));
    { float sacc = pB0[0] + pB0[1];
#pragma unroll
      for (int r = 2; r < 16; ++r) sacc += pB0[r];
#pragma unroll
      for (int r = 0; r < 16; ++r) sacc += pB1[r];
      l_reg += sacc;
      pw0 = (u32x4){PKW(pB0, 0), PKW(pB0, 2), PKW(pB0, 4), PKW(pB0, 6)}; pw1 = (u32x4){PKW(pB0, 8), PKW(pB0, 10), PKW(pB0, 12), PKW(pB0, 14)};
      pw2 = (u32x4){PKW(pB1, 0), PKW(pB1, 2), PKW(pB1, 4), PKW(pB1, 6)}; pw3 = (u32x4){PKW(pB1, 8), PKW(pB1, 10), PKW(pB1, 12), PKW(pB1, 14)};
      SBAR(); pv(o, vb0 + sl_cur, PAF(0), PAF(1), PAF(2), PAF(3)); }
#undef PKW
#undef PAF
#undef VFR
#undef PIN
#undef MX3
#undef GAPA
#undef GAPB
#undef EX
#undef VRD
#undef KRD
#undef STEP
#undef ENDW
    unsigned nxt_unit = 0u;
    if (tid == 0) nxt_unit = __hip_atomic_fetch_add(P.ctr, 1u, __ATOMIC_RELAXED, __HIP_MEMORY_SCOPE_AGENT);
    { auto rr = __builtin_amdgcn_permlane32_swap(__float_as_uint(l_reg), __float_as_uint(l_reg), false, false); l_reg = __uint_as_float(rr[0]) + __uint_as_float(rr[1]); }
    if (hi == 0) wsf[32 + r32] = l_reg; asm volatile("s_waitcnt lgkmcnt(0)" ::: "memory");
    float rli[16];
#pragma unroll
    for (int r = 0; r < 16; ++r) rli[r] = __builtin_amdgcn_rcpf(wsf[32 + crow(r, hi)]);
    {
        LAS bf16_t* stg = (LAS bf16_t*)(lds + LDS_OST) + wid * 2048;
#pragma unroll
        for (int r = 0; r < 16; ++r) { const int orow = crow(r, hi);
#pragma unroll
            for (int d0 = 0; d0 < 2; ++d0) stg[orow * 64 + d0 * 32 + r32] = (bf16_t)(cvtpk(o[d0][r] * rli[r], 0.f) & 0xffffu); }
        asm volatile("s_waitcnt lgkmcnt(0)" ::: "memory");
#pragma unroll
        for (int i = 0; i < 4; ++i) { const int row = i * 8 + (lane >> 3), ch = lane & 7; const u32x4 v = *(const LAS u32x4*)(stg + row * 64 + ch * 8);
            const size_t grow = (size_t)(q0 + wid * QBLK + row);
            const u32x4 gt = gtv[i];
            u32x4 w;
            w.x = cvtpk(bf_lo(v.x) * bf_lo(gt.x), bf_hi(v.x) * bf_hi(gt.x));
            w.y = cvtpk(bf_lo(v.y) * bf_lo(gt.y), bf_hi(v.y) * bf_hi(gt.y));
            w.z = cvtpk(bf_lo(v.z) * bf_lo(gt.z), bf_hi(v.z) * bf_hi(gt.z));
            w.w = cvtpk(bf_lo(v.w) * bf_lo(gt.w), bf_hi(v.w) * bf_hi(gt.w));
            *(u32x4*)(P.out + grow * DM + ch * 8) = w; }
    }
    if (tid == 0) *(volatile LAS unsigned*)(lds + att::L_NEXT) = nxt_unit;
    asm volatile("s_waitcnt lgkmcnt(0)\n\ts_barrier" ::: "memory");
#undef DMA_K
#undef DMA_K2
#undef DMA_V
#undef BMASK
#undef START
#undef RESC
#undef ROT
#undef KOFF
}
#undef SBAR
#undef WAIT_BAR
}

struct Args {
    const float* x; const float* c; const int* pos; const float* w_ada; const float* b_ada; const float* norm_g; const float* w_in;
    const float* qng; const float* w_uq; const float* kvng; const float* w_ukv; const float* relb; const float* fgb; const float* w_out; const float* final_g;
    float* out; unsigned char* ws; int ph_lo, ph_hi;
};

__device__ __forceinline__ int src_col(int kind, int n, float& sc) {
    sc = 1.f;
    if (kind == 4) { if (n < 32) { kind = 0; n = ZC_KPE + n; } else if (n < 37) { kind = 0; n = (ZC_CF - ZPAD) + (n - 32); } else return -1; }
    else if (kind == 0) { n = n + (n >= ZC_KPE ? 32 : 0); }
    if (kind == 0) {
        if (n < ZC_KPE) return n;
        if (n < (ZC_GATE - ZPAD)) { const int i = (n - ZC_KPE) >> 1, odd = (n - ZC_KPE) & 1; return 640 + i + 16 * odd; }
        if (n < 1056) return n;
        if (n < 1376) return 2016 + (n - 1056);
        if (n < (ZC_BQ - ZPAD)) return 3301 + (n - 1376);
        if (n < (ZC_BK - ZPAD)) { sc = 0.125f * LOG2E; return 1056 + (n - (ZC_BQ - ZPAD)); }
        if (n < (ZC_BV - ZPAD)) return 1376 + (n - (ZC_BK - ZPAD));
        if (n < (ZC_CQ2 - ZPAD)) return 1696 + (n - (ZC_BV - ZPAD));
        if (n < (ZC_CK - ZPAD)) { sc = 0.125f * LOG2E; return 2336 + (n - (ZC_CQ2 - ZPAD)); }
        if (n < (ZC_CV - ZPAD)) return 2656 + (n - (ZC_CK - ZPAD));
        if (n < (ZC_CF - ZPAD)) return 2976 + (n - (ZC_CV - ZPAD));
        if (n < (ZC_CF - ZPAD) + 5) return 3296 + (n - (ZC_CF - ZPAD));
        return -1;
    } else if (kind == 1) {
        if (n >= 576) return -1;
        sc = 0.10206207261596577f * LOG2E;
        const int h = n / 96, d = n % 96;
        if (d < 64) return n;
        const int i = (d - 64) >> 1, odd = (d - 64) & 1; return h * 96 + 64 + i + 16 * odd;
    } else if (kind == 2) {
        if (n < 384) { const int h = n >> 6, d = n & 63; return h * 128 + d; }
        const int m = n - 384, h = m >> 6, d = m & 63; return h * 128 + 64 + d;
    }
    return n;
}
__device__ __forceinline__ void transpose_item(const float* W, int N, int K, bf16_t* WT, LAS float* scr, int kind, const float* rowscale, int item, int nblk, int lane, int pitch = 0) {
    if (pitch == 0) pitch = K;
    const int kb = item / nblk, nb = item % nblk, k0 = 64 * kb, n0 = 32 * nb;
    float csc; const int sc = src_col(kind, n0 + (lane & 31), csc);
    float v[32], rsc[32];
    const float* wp = W + (size_t)(k0 + (lane >> 5)) * N + (sc >= 0 ? sc : 0);
#pragma unroll
    for (int i = 0; i < 32; ++i) v[i] = __builtin_nontemporal_load(wp + (size_t)(2 * i) * N);
    if (rowscale) {
#pragma unroll
        for (int i = 0; i < 32; ++i) rsc[i] = rowscale[k0 + 2 * i + (lane >> 5)];
    } else {
#pragma unroll
        for (int i = 0; i < 32; ++i) rsc[i] = 1.f;
    }
    if (sc < 0) csc = 0.f;
#pragma unroll
    for (int i = 0; i < 32; ++i) scr[(2 * i + (lane >> 5)) * 33 + (lane & 31)] = v[i] * csc * rsc[i];
    __builtin_amdgcn_s_waitcnt(0xc07f);
    asm volatile("" ::: "memory");
    const int c = lane & 7;
#pragma unroll
    for (int j = 0; j < 4; ++j) {
        const int n = (lane >> 3) + 8 * j; const LAS float* s = scr + (8 * c) * 33 + n;
        u32x4 o; o.x = cvtpk(s[0 * 33], s[1 * 33]); o.y = cvtpk(s[2 * 33], s[3 * 33]); o.z = cvtpk(s[4 * 33], s[5 * 33]); o.w = cvtpk(s[6 * 33], s[7 * 33]);
        *(u32x4*)(WT + (size_t)(n0 + n) * pitch + k0 + 8 * c) = o;
    }
    __builtin_amdgcn_s_waitcnt(0xc07f);
    asm volatile("" ::: "memory");
}

__device__ __forceinline__ void phase0(const Args& a, LAS unsigned char* lds, const int wv, const int bid) {
    const int lane = lane_now(), wave = wv, tid = wv * 64 + lane;
    float* mod = (float*)(a.ws + WS_MOD);
    if (bid < 192) {
        LAS float* cact = (LAS float*)lds;
        for (int i = tid; i < 16 * 1024; i += 512) { const int b = i >> 10, k = i & 1023; const float v = a.c[i]; cact[k * 16 + b] = v / (1.f + __expf(-v)); }
        __syncthreads();
        const int q = bid, l = q / 96, j0 = (q % 96) * 32, ks = wave * 2 + (lane >> 5), jc = lane & 31;
        float acc[16];
#pragma unroll
        for (int b = 0; b < 16; ++b) acc[b] = 0.f;
        const float* w = a.w_ada + (size_t)l * 1024 * 3072 + (size_t)(ks * 64) * 3072 + j0 + jc;
#pragma unroll 8
        for (int kk = 0; kk < 64; ++kk) {
            const float wv = __builtin_nontemporal_load(w + (size_t)kk * 3072);
            const LAS f32x4* cp = (const LAS f32x4*)(cact + (ks * 64 + kk) * 16);
            const f32x4 c0 = cp[0], c1 = cp[1], c2 = cp[2], c3 = cp[3];
#pragma unroll
            for (int i = 0; i < 4; ++i) { acc[i] += wv * c0[i]; acc[4 + i] += wv * c1[i]; acc[8 + i] += wv * c2[i]; acc[12 + i] += wv * c3[i]; }
        }
        LAS float* part = (LAS float*)(lds + 65536);
#pragma unroll
        for (int b = 0; b < 16; ++b) part[(ks * 16 + b) * 32 + jc] = acc[b];
        __syncthreads();
        {
            const int b = tid >> 5, jj = tid & 31; float sacc = a.b_ada[l * 3072 + j0 + jj];
#pragma unroll
            for (int k2 = 0; k2 < 16; ++k2) sacc += part[(k2 * 16 + b) * 32 + jj];
            mod[((size_t)l * 16 + b) * 3072 + j0 + jj] = sacc;
        }
        __syncthreads();
    }
    {
        LAS float* scr = (LAS float*)(lds + wave * 8448);
        const int gw = bid * 8 + wave, NGW = gridDim.x * 8;
        constexpr int I_IN = 16 * 112, I_37 = 16 * 2, I_UQ = 6 * 24, I_UKV = 4 * 24, I_OUT = 16 * 32, I_L = I_IN + I_37 + I_UQ + I_UKV + I_OUT;
        for (int it = gw; it < 2 * I_L; it += NGW) {
            const int l = it / I_L; int r = it % I_L;
            if (r < I_IN) { transpose_item(a.w_in + (size_t)l * 1024 * NIN, NIN, 1024, (bf16_t*)(a.ws + WS_WIN) + (size_t)l * NZG * 1024, scr, 0, nullptr, r, 112, lane); continue; } r -= I_IN;
            if (r < I_37) { transpose_item(a.w_in + (size_t)l * 1024 * NIN, NIN, 1024, (bf16_t*)(a.ws + WS_W37) + (size_t)l * 64 * 1024, scr, 4, nullptr, r, 2, lane); continue; } r -= I_37;
            if (r < I_UQ) { transpose_item(a.w_uq + (size_t)l * 384 * 576, 576, 384, (bf16_t*)(a.ws + WS_WUQ) + (size_t)l * 768 * 384, scr, 1, a.qng + l * 384, r, 24, lane); continue; } r -= I_UQ;
            if (r < I_UKV) { transpose_item(a.w_ukv + (size_t)l * 256 * 768, 768, 256, (bf16_t*)(a.ws + WS_WUKV) + (size_t)l * 768 * 384, scr, 2, a.kvng + l * 256, r, 24, lane, 384); continue; } r -= I_UKV;
            transpose_item(a.w_out + (size_t)l * 1024 * 1024, 1024, 1024, (bf16_t*)(a.ws + WS_WOUT) + (size_t)l * 1024 * 1024, scr, 3, nullptr, r, 32, lane);
        }
    }
    {
        float* cs = (float*)(a.ws + WS_CS);
        const int gt = bid * 512 + tid, NGT = gridDim.x * 512;
        for (int i = gt; i < NTOK * 16; i += NGT) {
            const int tok = i >> 4, j = i & 15;
            const float inv = exp2f(-(float)j * (13.287712379549449f / 16.f));
            const float ang = (float)a.pos[tok] * inv;
            double r = (double)ang; r -= 6.283185307179586 * rint(r * 0.15915494309189535);
            cs[(size_t)tok * 32 + j] = cosf((float)r); cs[(size_t)tok * 32 + 16 + j] = sinf((float)r);
        }
    }
}


__device__ __forceinline__ void side37(const Args& a, const int L, const bf16_t* H, LAS unsigned char* lds, const int wv, const int bid) {
    const int lane = lane_now(), lr = lane & 15, fq = lane >> 4, tid = wv * 64 + lane;
    const int row = bid * 128 + wv * 16 + lr;
    const bf16_t* hp = H + (size_t)row * 1024 + 8 * fq;
    bf16x8 hf[32];
#pragma unroll
    for (int k = 0; k < 32; ++k) hf[k] = *(const bf16x8*)(hp + 32 * k);
    {
        const bf16_t* wsrc = (const bf16_t*)(a.ws + WS_W37) + (size_t)L * 64 * 1024;
#pragma unroll
        for (int j = 0; j < 12; ++j) { const int i = tid + 512 * j, r = i >> 7, ch = i & 127;
            const u32x4 v = *(const u32x4*)(wsrc + (size_t)r * 1024 + ch * 8); *(LAS u32x4*)(lds + r * 2064 + ch * 16) = v; }
    }
    __syncthreads();
    f32x4 acc0 = {0.f, 0.f, 0.f, 0.f}, acc1 = acc0, acc2 = acc0;
    const LAS unsigned char* wl = lds + lr * 2064 + fq * 16;
#pragma unroll
    for (int k = 0; k < 32; ++k) {
        const bf16x8 w0 = *(const LAS bf16x8*)(wl + k * 64), w1 = *(const LAS bf16x8*)(wl + 16 * 2064 + k * 64), w2 = *(const LAS bf16x8*)(wl + 32 * 2064 + k * 64);
        acc0 = __builtin_amdgcn_mfma_f32_16x16x32_bf16(w0, hf[k], acc0, 0, 0, 0);
        acc1 = __builtin_amdgcn_mfma_f32_16x16x32_bf16(w1, hf[k], acc1, 0, 0, 0);
        acc2 = __builtin_amdgcn_mfma_f32_16x16x32_bf16(w2, hf[k], acc2, 0, 0, 0);
    }
    __syncthreads();
    bf16_t* Z = (bf16_t*)(a.ws + WS_Z);
    const float* cs = (const float*)(a.ws + WS_CS) + (size_t)row * 32;
#pragma unroll
    for (int n = 0; n < 2; ++n) {
        const f32x4 v = n == 0 ? acc0 : acc1;
        const int i0 = 8 * n + 2 * fq;
        const f32x2 co = *(const f32x2*)(cs + i0), si = *(const f32x2*)(cs + 16 + i0);
        u32x2 w;
        w.x = cvtpk(v[0] * co[0] - v[1] * si[0], v[0] * si[0] + v[1] * co[0]);
        w.y = cvtpk(v[2] * co[1] - v[3] * si[1], v[2] * si[1] + v[3] * co[1]);
        *(u32x2*)(Z + (size_t)row * NZ + ZC_KPE + 16 * n + 4 * fq) = w;
    }
    if (fq < 2) {
        float* LF = (float*)(a.ws + WS_LF) + (size_t)row * 8;
        const float* fb = a.fgb + L * 5;
        const int nh = fq == 0 ? 4 : 1;
#pragma unroll
        for (int i = 0; i < 4; ++i) if (i < nh) { const float t = acc2[i] + fb[4 * fq + i]; LF[4 * fq + i] = fminf(t, 0.f) - log1pf(__expf(-fabsf(t))); }
    }
}

__device__ __forceinline__ void phase_norm(const Args& a, int l, const float* xin, const int wv, const int bid) {
    const int lane = lane_now(), wave = wv;
    const int gw = bid * 8 + wave, NGW = gridDim.x * 8, wpb = NGW / NB;
    const int b = gw / wpb, wi = gw % wpb;
    if (b >= NB) return;
    const float* mod = (const float*)(a.ws + WS_MOD) + ((size_t)l * 16 + b) * 3072;
    bf16_t* H = (bf16_t*)(a.ws + WS_H);
    f32x4 G[4], SH[4];
#pragma unroll
    for (int j = 0; j < 4; ++j) {
        const int col = 4 * lane + 256 * j;
        const f32x4 g = *(const f32x4*)(a.norm_g + l * 1024 + col), sc = *(const f32x4*)(mod + 1024 + col);
        G[j] = g * (sc + 1.0f); SH[j] = *(const f32x4*)(mod + col);
    }
    for (int row = wi; row < SEQ; row += wpb) {
        const size_t tok = (size_t)b * SEQ + row;
        const f32x4* xr = (const f32x4*)(xin + tok * DM) + lane;
        f32x4 v[4]; float s = 0.f;
#pragma unroll
        for (int j = 0; j < 4; ++j) { v[j] = __builtin_nontemporal_load(xr + 64 * j); s += (v[j].x * v[j].x + v[j].y * v[j].y) + (v[j].z * v[j].z + v[j].w * v[j].w); }
        const float rstd = 1.0f / sqrtf(wave_sum(s, lane) * (1.f / DM) + EPS);
        if (lane == 0) *(f32x2*)((float*)(a.ws + WS_RQ) + tok * 2) = (f32x2){0.f, 0.f};
        u32x2* o8 = (u32x2*)(H + tok * DM) + lane;
#pragma unroll
        for (int j = 0; j < 4; ++j) { const f32x4 h = v[j] * rstd * G[j] + SH[j]; u32x2 w; w.x = cvtpk(h.x, h.y); w.y = cvtpk(h.z, h.w); o8[64 * j] = w; }
    }
}

__device__ __forceinline__ void phase_stats(const Args& a, const int wv, const int bid) {
    const int lane = lane_now(), wave = wv;
    const int gw = bid * 8 + wave;
    if (gw < 80) {
        const int b = gw / 5, h = gw % 5;
        const float* LF = (const float*)(a.ws + WS_LF) + ((size_t)b * SEQ + lane * 32) * 8 + h;
        float* Gp = (float*)(a.ws + WS_G) + (size_t)gw * SEQ + lane * 32;
        float v[32]; float run = 0.f;
#pragma unroll
        for (int i = 0; i < 32; ++i) { run += LF[i * 8]; v[i] = run; }
        float incl = run;
#pragma unroll
        for (int o = 1; o < 64; o <<= 1) { const float t = shfl_up_l(incl, o, lane); if (lane >= o) incl += t; }
        const float excl = incl - run;
#pragma unroll
        for (int i = 0; i < 32; ++i) Gp[i] = -(excl + v[i]) * LOG2E;
    }
}

__device__ __forceinline__ void phase_attn(const Args& a, int l, LAS unsigned char* lds, const int wv, const int bid, const int crep) {
    const bf16_t* Z = (const bf16_t*)(a.ws + WS_Z);
    const bf16_t* QA = (const bf16_t*)(a.ws + WS_QA);
    const bf16_t* KVA = (const bf16_t*)(a.ws + WS_KVA);
    bf16_t* MIX = (bf16_t*)(a.ws + WS_H);
    const float* Gt = (const float*)(a.ws + WS_G);
    unsigned* ctr0 = (unsigned*)(a.ws + WS_CTL) + 8192 + 64 * (l * 8) + 1024 * crep;
    const int myx = (int)((unsigned)__builtin_amdgcn_s_getreg((3 << 11) | 20) & 7u);
    volatile LAS unsigned* nxt = (volatile LAS unsigned*)(lds + att::L_NEXT);
    int curx = myx;
    if (wv == 0 && lane_now() == 0) *nxt = __hip_atomic_fetch_add(ctr0 + 64 * curx, 1u, __ATOMIC_RELAXED, __HIP_MEMORY_SCOPE_AGENT);
    __syncthreads();
    for (;;) {
        const int u = __builtin_amdgcn_readfirstlane((int)*nxt);
        if (u >= 256) {
            __syncthreads();
            if (wv == 0 && lane_now() == 0) {
                unsigned c[8];
#pragma unroll
                for (int j = 0; j < 8; ++j) c[j] = __hip_atomic_load(ctr0 + 64 * j, __ATOMIC_RELAXED, __HIP_MEMORY_SCOPE_AGENT);
                int pick = -1;
#pragma unroll
                for (int k = 7; k >= 1; --k) { const int x = (curx + k) & 7; unsigned cx = 0u;
#pragma unroll
                    for (int j = 0; j < 8; ++j) cx = (j == x) ? c[j] : cx;
                    if (cx < 256u) pick = x; }
                nxt[1] = (unsigned)pick;
                nxt[0] = pick >= 0 ? __hip_atomic_fetch_add(ctr0 + 64 * pick, 1u, __ATOMIC_RELAXED, __HIP_MEMORY_SCOPE_AGENT) : 0u;
            }
            __syncthreads();
            const int pk = __builtin_amdgcn_readfirstlane((int)nxt[1]);
            if (pk < 0) break;
            curx = pk;
            continue;
        }
        unsigned* ctr = ctr0 + 64 * curx;
        int mode, qb, bh;
        { const int g = u >> 5, w = u & 31, hh = 4 * g + (w & 3); qb = 7 - (w >> 2);
          if (hh < 12) { mode = 0; bh = curx * 12 + hh; } else if (hh < 22) { mode = 2; bh = curx * 10 + (hh - 12); } else { mode = 1; bh = curx * 10 + (hh - 22); } }
        att::AP P;
        if (mode == 0) {
            const int b = bh / 6, h = bh % 6; const size_t rb = (size_t)b * SEQ;
            P.Q = QA + rb * QAP + h * 96; P.qp = QAP;
            P.K = KVA + rb * QAP + h * 64; P.kp = QAP;
            P.K2 = Z + rb * NZ + ZC_KPE; P.k2p = NZ;
            P.V = KVA + rb * QAP + 384 + h * 64; P.vp = QAP;
            P.gate = Z + rb * NZ + ZC_GATE + h * 64; P.out = MIX + rb * DM + h * 64; P.kb = nullptr; P.ctr = ctr;
            fa::attn_unit<0, 8>(P, qb, lds, wv);
        } else if (mode == 1) {
            const int b = bh / 5, h = bh % 5; const size_t rb = (size_t)b * SEQ;
            P.Q = Z + rb * NZ + ZC_BQ + h * 64; P.qp = NZ;
            P.K = Z + rb * NZ + ZC_BK + h * 64; P.kp = NZ; P.K2 = nullptr; P.k2p = 0;
            P.V = Z + rb * NZ + ZC_BV + h * 64; P.vp = NZ;
            P.gate = Z + rb * NZ + ZC_GATE + 384 + h * 64; P.out = MIX + rb * DM + 384 + h * 64; P.kb = a.relb + ((size_t)l * 5 + h) * 257; P.ctr = ctr;
            fa::attn_unit<1, 8>(P, qb, lds, wv);
        } else {
            const int b = bh / 5, h = bh % 5; const size_t rb = (size_t)b * SEQ;
            P.Q = Z + rb * NZ + ZC_CQ2 + h * 64; P.qp = NZ;
            P.K = Z + rb * NZ + ZC_CK + h * 64; P.kp = NZ; P.K2 = nullptr; P.k2p = 0;
            P.V = Z + rb * NZ + ZC_CV + h * 64; P.vp = NZ;
            P.gate = Z + rb * NZ + ZC_GATE + 704 + h * 64; P.out = MIX + rb * DM + 704 + h * 64; P.kb = Gt + (size_t)bh * SEQ; P.ctr = ctr;
            fa::attn_unit<2, 8>(P, qb, lds, wv);
        }
    }
    __syncthreads();
}

__device__ __forceinline__ void phase_final(const Args& a, const int wv, const int bid) {
    const int lane = lane_now(), wave = wv;
    const int gw = bid * 8 + wave, NGW = gridDim.x * 8;
    f32x4 G[4];
#pragma unroll
    for (int j = 0; j < 4; ++j) G[j] = *(const f32x4*)(a.final_g + 4 * lane + 256 * j);
    for (int row = gw; row < NTOK; row += NGW) {
        f32x4* xr = (f32x4*)(a.out + (size_t)row * DM) + lane;
        f32x4 v[4]; float s = 0.f;
#pragma unroll
        for (int j = 0; j < 4; ++j) { v[j] = xr[64 * j]; s += (v[j].x * v[j].x + v[j].y * v[j].y) + (v[j].z * v[j].z + v[j].w * v[j].w); }
        const float rstd = 1.0f / sqrtf(wave_sum(s, lane) * (1.f / DM) + EPS);
#pragma unroll
        for (int j = 0; j < 4; ++j) xr[64 * j] = v[j] * rstd * G[j];
    }
}


#define XB_TMO      128
#define XB_XCNT(j)  (256  + 64 * (j))
#define XB_XSUB(j)  (1280 + 64 * (j))
#define XB_XGEN(j)  (2304 + 64 * (j))
#define XB_TOP      3328
#define XB_TOPGEN   3392
#define XCD_BAR_WORDS 3456
#define XB_SPIN_CAP (1u << 18)
__device__ __forceinline__ unsigned xb_ld(unsigned* p)              { return __hip_atomic_load(p, __ATOMIC_RELAXED, __HIP_MEMORY_SCOPE_AGENT); }
__device__ __forceinline__ unsigned xb_add(unsigned* p, unsigned v) { return __hip_atomic_fetch_add(p, v, __ATOMIC_RELAXED, __HIP_MEMORY_SCOPE_AGENT); }
__device__ __forceinline__ unsigned xb_xcc_id() { return (unsigned)__builtin_amdgcn_s_getreg((3 << 11) | 20) & 0xFu; }
#define XB_SPIN(cond, bar) do { unsigned _sp = 0; while (cond) { __builtin_amdgcn_s_sleep(4); \
    if ((++_sp & 255u) == 0u) { if (xb_ld(&(bar)[XB_TMO])) break; if (_sp > XB_SPIN_CAP) { atomicAdd(&(bar)[XB_TMO], 1u); break; } } } } while (0)
struct XcdBarrier { unsigned* bar; unsigned x; volatile LAS unsigned* st; };
__device__ __forceinline__ void xcd_barrier_complete(unsigned* bar, unsigned x, unsigned& nloc, unsigned& nx) {
    const unsigned G = gridDim.x * gridDim.y * gridDim.z;
    unsigned sum, cnt, mine, sp = 0u;
    for (;;) {
        sum = 0u; cnt = 0u; mine = 0u;
#pragma unroll
        for (unsigned j = 0; j < 16; ++j) { const unsigned c = xb_ld(&bar[XB_XCNT(j)]); sum += c; cnt += (c > 0u) ? 1u : 0u; mine = (j == x) ? c : mine; }
        if (sum == G) break;
        __builtin_amdgcn_s_sleep(1);
        if ((++sp & 255u) == 0u) { if (xb_ld(&bar[XB_TMO])) break; if (sp > XB_SPIN_CAP) { atomicAdd(&bar[XB_TMO], 1u); break; } }
    }
    nloc = mine > 0u ? mine : 1u; nx = cnt > 0u ? cnt : 1u;
}
__device__ __forceinline__ void xcd_barrier(const XcdBarrier& b, const bool first) {
    asm volatile("s_waitcnt vmcnt(0)" ::: "memory");
    __syncthreads();
    if (first) {
        unsigned* bar = b.bar;
        __builtin_amdgcn_s_waitcnt(0);
        unsigned nloc = b.st[0], nx = b.st[1];
        if (nloc == 0u) { xcd_barrier_complete(bar, b.x, nloc, nx); b.st[0] = nloc; b.st[1] = nx; }
        const unsigned old = xb_add(&bar[XB_XSUB(b.x)], 1u);
        const unsigned gen = old / nloc;
        if (old + 1u == (gen + 1u) * nloc) {
            __builtin_amdgcn_fence(__ATOMIC_RELEASE, "agent");
            asm volatile("s_waitcnt vmcnt(0)" ::: "memory");
            const unsigned og = xb_add(&bar[XB_TOP], 1u);
            const unsigned tg = og / nx;
            if (og + 1u == (tg + 1u) * nx) xb_add(&bar[XB_TOPGEN], 1u);
            else XB_SPIN(xb_ld(&bar[XB_TOPGEN]) == tg, bar);
            __builtin_amdgcn_fence(__ATOMIC_ACQUIRE, "agent");
            xb_add(&bar[XB_XGEN(b.x)], 1u);
            asm volatile("s_waitcnt vmcnt(0)" ::: "memory");
        } else {
            XB_SPIN(xb_ld(&bar[XB_XGEN(b.x)]) == gen, bar);
            __builtin_amdgcn_fence(__ATOMIC_ACQUIRE, "agent");
            asm volatile("s_waitcnt vmcnt(0)" ::: "memory");
        }
    }
    __syncthreads();
}

#ifndef ONLY
#define ONLY -1
#endif
#define EN(n) (ONLY < 0 || ONLY == (n))
#ifndef DBLMASK
#define DBLMASK 0
#endif
#define PH_IN(k) (lo <= (k) && (k) < hi)
#define SEAM(k) do { if constexpr (COOP) { if (lo <= (k) && (k) + 1 < hi) xcd_barrier(xb, wv == 0 && lane_now() == 0); } } while (0)
#define BAR() do { if constexpr (COOP) xcd_barrier(xb, wv == 0 && lane_now() == 0); } while (0)

template <bool COOP, int L>
__device__ __forceinline__ void layer_phases(const Args& a, LAS unsigned char* lds, const int wv, const int bid, const int lo, const int hi, const XcdBarrier& xb) {
    constexpr int P = (L == 0) ? 2 : 6;
    const float* mod = (const float*)(a.ws + WS_MOD);
    if (L == 0) { if (PH_IN(1) && EN(1)) phase_norm(a, 0, a.x, wv, bid); SEAM(1); }
    if (PH_IN(P + 0) && EN(2)) {
        const bool side_first = ((bid >> 3) & 1) == 0;
        if (side_first) side37(a, L, (const bf16_t*)(a.ws + (L == 0 ? WS_H : WS_HN)), lds, wv, bid);
        pg8::Gemm g{(const bf16_t*)(a.ws + (L == 0 ? WS_H : WS_HN)), (const bf16_t*)(a.ws + WS_WIN) + (size_t)L * NZG * 1024, NTOK, NZG, 1024, 1024, 1024};
        pg8::StaticOrder S; S.init(NTOK, NZG, gridDim.x, bid);
        pg8::EpiZ E{(bf16_t*)(a.ws + WS_Z), (const float*)(a.ws + WS_CS), (float*)(a.ws + WS_LF), a.fgb + L * 5, (float*)(a.ws + WS_RQ), lds + 131072 + 1024};
        pg8::gemm_phase<pg8::EpiZ>(lds, pg8::Prob1{g, S}, E, wv);
        if (!side_first) side37(a, L, (const bf16_t*)(a.ws + (L == 0 ? WS_H : WS_HN)), lds, wv, bid);
    }
    SEAM(P + 0);
    if (PH_IN(P + 1) && EN(4)) {
        phase_stats(a, wv, bid);
        {
            pg8::Gemm g0{(const bf16_t*)(a.ws + WS_Z) + ZC_CQ, (const bf16_t*)(a.ws + WS_WUQ) + (size_t)L * 768 * 384, NTOK, 768, 384, NZ, 384};
            pg8::Gemm g1{(const bf16_t*)(a.ws + WS_Z) + ZC_CKV, (const bf16_t*)(a.ws + WS_WUKV) + (size_t)L * 768 * 384, NTOK, 768, 256, NZ, 384};
            pg8::StaticOrder S; S.init(NTOK, 768, gridDim.x, bid);
            pg8::EpiUp E{pg8::EpiQ{(bf16_t*)(a.ws + WS_QA), (const float*)(a.ws + WS_CS), (const float*)(a.ws + WS_RQ)}, pg8::EpiKV{(bf16_t*)(a.ws + WS_KVA), (const float*)(a.ws + WS_RQ)}};
            pg8::gemm_phase<pg8::EpiUp>(lds, pg8::Prob2{g0, g1, S}, E, wv);
        }
    }
    SEAM(P + 1);
    if (PH_IN(P + 2) && EN(5)) phase_attn(a, L, lds, wv, bid, 0);
#ifdef ATT2
    if (PH_IN(P + 2) && EN(5)) phase_attn(a, L, lds, wv, bid, 1);
#endif
    SEAM(P + 2);
    if (PH_IN(P + 3) && EN(6)) {
        pg8::Gemm g{(const bf16_t*)(a.ws + WS_H), (const bf16_t*)(a.ws + WS_WOUT) + (size_t)L * 1024 * 1024, NTOK, 1024, 1024, 1024, 1024};
        pg8::StaticOrder S; S.init(NTOK, 1024, gridDim.x, bid);
        unsigned* cnt = (unsigned*)(a.ws + WS_CTL) + 16384 + L * 8192;
        float* xbuf = (float*)(a.ws + WS_X) + (size_t)L * NTOK * 4;
        if (L == 0) {
            pg8::EpiOutN<false> E{a.x, a.out, mod + 2048, a.norm_g + 1024, mod + (size_t)16 * 3072, (bf16_t*)(a.ws + WS_HN), (float*)(a.ws + WS_RQ), xbuf, cnt, lds + 131072 + 1024};
            pg8::gemm_phase<pg8::EpiOutN<false>>(lds, pg8::Prob1{g, S}, E, wv);
        } else {
            pg8::EpiOutN<true> E{a.out, a.out, mod + (size_t)16 * 3072 + 2048, a.final_g, nullptr, nullptr, nullptr, xbuf, cnt, lds + 131072 + 1024};
            pg8::gemm_phase<pg8::EpiOutN<true>>(lds, pg8::Prob1{g, S}, E, wv);
        }
    }
    if (L == 0) SEAM(P + 3);
}

template <bool COOP>
__global__ void __launch_bounds__(512, 2) fwd(Args a) {
    extern __shared__ __attribute__((aligned(16))) unsigned char lds_raw[];
    LAS unsigned char* lds = (LAS unsigned char*)lds_raw;
    const int wv = __builtin_amdgcn_readfirstlane(threadIdx.x >> 6);
    const int bid = blockIdx.x, lo = a.ph_lo, hi = a.ph_hi;
    XcdBarrier xb; xb.bar = (unsigned*)(a.ws + WS_CTL) + 1024; xb.x = xb_xcc_id(); xb.st = (volatile LAS unsigned*)(lds + 131072 + 64);
    if constexpr (COOP) {
        if (threadIdx.x == 0) { xb.st[0] = 0u; xb.st[1] = 0u; (void)xb_add(&xb.bar[XB_XCNT(xb.x)], 1u); }
        __syncthreads();
    }
    if (PH_IN(0) && EN(0)) phase0(a, lds, wv, bid);
    SEAM(0);
    layer_phases<COOP, 0>(a, lds, wv, bid, lo, hi, xb);
    layer_phases<COOP, 1>(a, lds, wv, bid, lo, hi, xb);
}

extern "C" void kernel_launch(void* const* d_in, const int* in_sizes, int n_in, void* d_out, int out_size, void* d_ws, size_t ws_size, hipStream_t stream) {
    static int grid = 0;
    if (grid == 0) {
        if (n_in != 15 || in_sizes[0] != NTOK * DM || out_size != NTOK * DM || ws_size < WS_END) { fprintf(stderr, "kernel_launch: unexpected shapes (n_in %d, ws %zu)\n", n_in, ws_size); grid = -1; return; }
        int dev = 0, cus = 0, per_cu = 0;
        hipGetDevice(&dev); hipDeviceGetAttribute(&cus, hipDeviceAttributeMultiprocessorCount, dev);
        hipFuncSetAttribute((const void*)fwd<true>, hipFuncAttributeMaxDynamicSharedMemorySize, LDS_BYTES);
        hipFuncSetAttribute((const void*)fwd<false>, hipFuncAttributeMaxDynamicSharedMemorySize, LDS_BYTES);
        hipOccupancyMaxActiveBlocksPerMultiprocessor(&per_cu, (const void*)fwd<true>, 512, LDS_BYTES);
        (void)hipGetLastError();
        if (per_cu < 1) fprintf(stderr, "kernel_launch: occupancy query reports %d blocks per CU\n", per_cu);
        grid = cus > 256 ? 256 : cus;
        if (grid != 256) fprintf(stderr, "kernel_launch: %d CUs; this kernel is laid out for 256\n", cus);
    }
    if (grid < 0) return;
    Args a{};
    a.x = (const float*)d_in[0]; a.c = (const float*)d_in[1]; a.pos = (const int*)d_in[2]; a.w_ada = (const float*)d_in[3]; a.b_ada = (const float*)d_in[4];
    a.norm_g = (const float*)d_in[5]; a.w_in = (const float*)d_in[6]; a.qng = (const float*)d_in[7]; a.w_uq = (const float*)d_in[8]; a.kvng = (const float*)d_in[9];
    a.w_ukv = (const float*)d_in[10]; a.relb = (const float*)d_in[11]; a.fgb = (const float*)d_in[12]; a.w_out = (const float*)d_in[13]; a.final_g = (const float*)d_in[14];
    a.out = (float*)d_out; a.ws = (unsigned char*)d_ws;
    if (hipMemsetAsync((char*)d_ws + WS_CTL, 0, 196608, stream) != hipSuccess) { fprintf(stderr, "kernel_launch: memset failed\n"); return; }
#if ONE_LAUNCH
    a.ph_lo = 0; a.ph_hi = NPHASE;
    void* args[] = {&a};
    hipError_t e = hipLaunchCooperativeKernel((const void*)fwd<true>, dim3(grid), dim3(512), args, LDS_BYTES, stream);
    if (e != hipSuccess) fprintf(stderr, "cooperative launch failed: %s\n", hipGetErrorString(e));
#else
    for (int ph = 0; ph < NPHASE; ++ph) {
        a.ph_lo = ph; a.ph_hi = ph + 1;
        hipLaunchKernelGGL(fwd<false>, dim3(grid), dim3(512), LDS_BYTES, stream, a);
    }
#endif
}
```

```cpp
#include <hip/hip_runtime.h>
#include <hip/hip_cooperative_groups.h>
#include <cstdio>
#include <cstdint>
namespace cg = cooperative_groups;

#ifndef ONE_LAUNCH
#define ONE_LAUNCH 1
#endif

#define LAS __attribute__((address_space(3)))
typedef unsigned short bf16_t;
typedef short bf16x8 __attribute__((ext_vector_type(8)));
typedef short s16x4 __attribute__((ext_vector_type(4)));
typedef float f32x2 __attribute__((ext_vector_type(2)));
typedef float f32x4 __attribute__((ext_vector_type(4)));
typedef float f32x16 __attribute__((ext_vector_type(16)));
typedef unsigned u32x2 __attribute__((ext_vector_type(2)));
typedef unsigned u32x4 __attribute__((ext_vector_type(4)));
typedef __bf16 bf16x2_t __attribute__((ext_vector_type(2)));

constexpr int DM = 1024, NB = 16, SEQ = 2048, NTOK = NB * SEQ;
constexpr int NIN = 3621, NZ = 3840, NZG = 3584;
constexpr int ZPAD = 32;
constexpr int ZC_CQ = 0, ZC_CKV = 384, ZC_KPE = 640, ZC_GATE = 672 + ZPAD, ZC_BQ = 1696 + ZPAD, ZC_BK = 2016 + ZPAD, ZC_BV = 2336 + ZPAD, ZC_CQ2 = 2656 + ZPAD, ZC_CK = 2976 + ZPAD, ZC_CV = 3296 + ZPAD, ZC_CF = 3616 + ZPAD;
constexpr int QAP = 768;
constexpr float LOG2E = 1.4426950408889634f;
constexpr float EPS = 1e-6f;

constexpr size_t MiB = 1u << 20;
constexpr size_t WS_CTL = 0;
constexpr size_t WS_MOD = 1 * MiB;
constexpr size_t WS_CS = 2 * MiB;
constexpr size_t WS_RQ = 6 * MiB;
constexpr size_t WS_RKV = 6 * MiB + 256 * 1024;
constexpr size_t WS_LF = 7 * MiB;
constexpr size_t WS_G = 8 * MiB;
constexpr size_t WS_WIN = 10 * MiB;
constexpr size_t WS_WUQ = 25 * MiB;
constexpr size_t WS_WUKV = 26 * MiB + 512 * 1024;
constexpr size_t WS_W37 = 26 * MiB + 256 * 1024;
constexpr size_t WS_WOUT = 28 * MiB;
constexpr size_t WS_H = 32 * MiB;
constexpr size_t WS_QA = 96 * MiB;
constexpr size_t WS_KVA = 144 * MiB;
constexpr size_t WS_Z = 192 * MiB;
constexpr size_t WS_HN = 432 * MiB;
constexpr size_t WS_X = 9 * MiB;
constexpr size_t WS_END = 496 * MiB;

constexpr int LDS_BYTES = 147456;
constexpr int NPHASE = 10;

__device__ __forceinline__ unsigned cvtpk(float lo, float hi) { f32x2 v = {lo, hi}; bf16x2_t b = __builtin_convertvector(v, bf16x2_t); return __builtin_bit_cast(unsigned, b); }
__device__ __forceinline__ float bf_lo(unsigned u) { return __builtin_bit_cast(float, u << 16); }
__device__ __forceinline__ float bf_hi(unsigned u) { return __builtin_bit_cast(float, u & 0xffff0000u); }
__device__ __forceinline__ float shfl_xor_l(float v, int o, int lane) { return __builtin_bit_cast(float, __builtin_amdgcn_ds_bpermute((lane ^ o) << 2, __builtin_bit_cast(int, v))); }
__device__ __forceinline__ float shfl_up_l(float v, int o, int lane) { const int src = lane >= o ? lane - o : lane; return __builtin_bit_cast(float, __builtin_amdgcn_ds_bpermute(src << 2, __builtin_bit_cast(int, v))); }
__device__ __forceinline__ int lane_now() { int l; asm volatile("v_mbcnt_lo_u32_b32 %0, -1, 0\n\tv_mbcnt_hi_u32_b32 %0, -1, %0" : "=v"(l)); return l; }
__device__ __forceinline__ float wave_sum(float v, int lane) {
#pragma unroll
    for (int o = 1; o < 64; o <<= 1) v += shfl_xor_l(v, o, lane);
    return v;
}

namespace pg8 {
constexpr int BM = 256, BK = 64, HALF = 128, HTB = HALF * BK * 2, STAGE_BYTES = 8 * HTB, NXCD = 8, WGM = 4;
__device__ __forceinline__ int lds_byte(int r, int c) { return (r >> 3) * 1024 + (r & 7) * 128 + ((((c >> 3) ^ (r >> 1)) & 7) << 4) + (c & 7) * 2; }
__device__ __forceinline__ void stage_rc(int b, int& R, int& C) { const int st = b / 1024, sb = b % 1024; R = st * 8 + sb / 128; const int slot = (sb % 128) / 16; C = ((slot ^ (R >> 1)) & 7) * 8 + (sb % 16) / 2; }
__device__ __forceinline__ int perm32(int rho) { const int n = rho >> 4, i = rho & 15; return 8 * (i >> 2) + 4 * n + (i & 3); }

struct Unit { int pm, pn, kind; };
struct Gemm { const bf16_t* A; const bf16_t* Bt; int M, N, K, lda, ldb; };

struct StaticOrder {
    int nM, nN, nwg, G, c;
    __device__ void init(int M, int N, int G_, int c_) { nM = M / BM; nN = N / BM; nwg = nM * nN; G = G_; c = c_; }
    __device__ bool next(int i, Unit& u) const { const long L = (long)i * G + c; if (L >= nwg) return false; u.kind = 0; map((int)L, u); return true; }
    __device__ void map(int L, Unit& u) const {
        int wgid = L; { const int q = nwg / NXCD, r = nwg % NXCD, xcd = wgid % NXCD, off = wgid / NXCD; wgid = (xcd < r ? xcd * (q + 1) : r * (q + 1) + (xcd - r) * q) + off; }
        const int nig = WGM * nN, gid = wgid / nig, fm = gid * WGM, gsz = (nM - fm) < WGM ? (nM - fm) : WGM;
        u.pm = fm + ((wgid % nig) % gsz); u.pn = (wgid % nig) / gsz;
    }
};
struct Prob1 {
    Gemm g; StaticOrder S;
    __device__ bool next(int i, Unit& u) const { return S.next(i, u); }
    __device__ const char* a_tile(const Unit& u) const { return (const char*)g.A + (size_t)u.pm * BM * g.lda * 2; }
    __device__ const char* b_tile(const Unit& u) const { return (const char*)g.Bt + (size_t)u.pn * BM * g.ldb * 2; }
    __device__ int nt(const Unit&) const { return g.K / BK; }
    __device__ int lda() const { return g.lda; }
    __device__ int ldb() const { return g.ldb; }
};
struct Prob2 {
    Gemm g0, g1; StaticOrder S;
    __device__ bool next(int i, Unit& u) const { const long L = (long)i * S.G + S.c; if (L >= 2 * S.nwg) return false; u.kind = L >= S.nwg ? 1 : 0; S.map((int)(L - u.kind * S.nwg), u); return true; }
    __device__ const char* a_tile(const Unit& u) const { return (const char*)(u.kind ? g1.A : g0.A) + (size_t)u.pm * BM * g0.lda * 2; }
    __device__ const char* b_tile(const Unit& u) const { return (const char*)(u.kind ? g1.Bt : g0.Bt) + (size_t)u.pn * BM * g0.ldb * 2; }
    __device__ int nt(const Unit& u) const { return (u.kind ? g1.K : g0.K) / BK; }
    __device__ int lda() const { return g0.lda; }
    __device__ int ldb() const { return g0.ldb; }
};

template <class Epi, class Prob>
__device__ __forceinline__ void gemm_phase(LAS unsigned char* lds, const Prob& S, const Epi& E, const int wv) {
    const int lane = lane_now(), wid = wv, tid = wv * 64 + lane, wr = wid >> 2, wc = wid & 3, fr = lane & 15, fq = lane >> 4;
    unsigned voffA[2], voffB[2];
#pragma unroll
    for (int i = 0; i < 2; ++i) { int R, C; stage_rc(tid * 16 + i * 8192, R, C); const int Rb = Epi::PERM ? ((R & ~31) + perm32(R & 31)) : R;
        voffA[i] = (unsigned)(R * S.lda() + C) * 2u; voffB[i] = (unsigned)(Rb * S.ldb() + C) * 2u; }
    const size_t kstep = (size_t)(BK * 2);
    const size_t hstepA = (size_t)HALF * S.lda() * 2, hstepB = (size_t)HALF * S.ldb() * 2;
    const unsigned ldsw = (unsigned)wid * 1024u;
    const int aoff = lds_byte(wr * 64 + fr, fq * 8), boff = lds_byte(wc * 32 + fr, fq * 8);
#define PG8_SA(b, h) (((b) * 2 + (h)) * HTB)
#define PG8_SB(b, h) ((4 + (b) * 2 + (h)) * HTB)
#define PG8_STAGE(bufoff, gbase, voff) do { const char* _g = (const char*)(gbase); asm volatile("" : "+s"(_g)); _Pragma("unroll") for (int _i = 0; _i < 2; ++_i) \
        __builtin_amdgcn_global_load_lds((const unsigned*)(_g + (voff)[_i]), (LAS unsigned*)(lds + (bufoff) + ldsw + _i * 8192), 16, 0, 0); } while (0)
#define PG8_LDA(dst, b, h) do { _Pragma("unroll") for (int m = 0; m < 4; ++m) _Pragma("unroll") for (int k = 0; k < 2; ++k) dst[m][k] = *(const LAS bf16x8*)(lds + PG8_SA(b, h) + (k ? (aoff ^ 64) : aoff) + m * 2048); } while (0)
#define PG8_LDB(dst, b, h) do { _Pragma("unroll") for (int n = 0; n < 2; ++n) _Pragma("unroll") for (int k = 0; k < 2; ++k) dst[n][k] = *(const LAS bf16x8*)(lds + PG8_SB(b, h) + (k ? (boff ^ 64) : boff) + n * 2048); } while (0)
#define PG8_MMA(ai, bj, At, Bt) do { __builtin_amdgcn_s_setprio(1); _Pragma("unroll") for (int m = 0; m < 4; ++m) _Pragma("unroll") for (int n = 0; n < 2; ++n) _Pragma("unroll") for (int k = 0; k < 2; ++k) \
        acc[ai][bj][m][n] = __builtin_amdgcn_mfma_f32_16x16x32_bf16(Bt[n][k], At[m][k], acc[ai][bj][m][n], 0, 0, 0); __builtin_amdgcn_s_setprio(0); } while (0)
#define PG8_WAIT_V(n) asm volatile("s_waitcnt vmcnt(" #n ")" ::: "memory")
#define PG8_WAIT_L(n) asm volatile("s_waitcnt lgkmcnt(" #n ")" ::: "memory")
#define PG8_BAR __builtin_amdgcn_s_barrier()
#define PG8_SCHED __builtin_amdgcn_sched_barrier(0)
    Unit cur, nxt; int ui = 0;
    if (!S.next(0, cur)) return;
    f32x4 acc[2][2][4][2];
#pragma unroll
    for (int a = 0; a < 2; ++a)
#pragma unroll
        for (int b = 0; b < 2; ++b)
#pragma unroll
            for (int m = 0; m < 4; ++m)
#pragma unroll
                for (int n = 0; n < 2; ++n) acc[a][b][m][n] = (f32x4){0.f, 0.f, 0.f, 0.f};
    bf16x8 At[4][2], B0[2][2], B1[2][2];
    const char* cA = S.a_tile(cur); const char* cB = S.b_tile(cur);
    int nt = S.nt(cur);
    PG8_STAGE(PG8_SB(0, 0), cB, voffB); PG8_STAGE(PG8_SB(0, 1), cB + hstepB, voffB); PG8_STAGE(PG8_SA(0, 0), cA, voffA); PG8_STAGE(PG8_SA(0, 1), cA + hstepA, voffA);
    if (wr == 1) PG8_BAR;
    PG8_WAIT_V(2); PG8_BAR;
    PG8_STAGE(PG8_SB(1, 0), cB + kstep, voffB); PG8_STAGE(PG8_SA(1, 0), cA + kstep, voffA); PG8_STAGE(PG8_SB(1, 1), cB + hstepB + kstep, voffB);
    PG8_WAIT_V(6); PG8_BAR;
    for (;;) {
        const bool has_next = S.next(ui + 1, nxt);
        const char* nA = has_next ? S.a_tile(nxt) : cA; const char* nB = has_next ? S.b_tile(nxt) : cB;
        for (int t = 0; t < nt; t += 2) {
            const bool last = (t == nt - 2);
            const char* a1 = cA + (size_t)(t + 1) * kstep;
            const char* a2 = last ? nA : cA + (size_t)(t + 2) * kstep; const char* b2 = last ? nB : cB + (size_t)(t + 2) * kstep;
            const char* a3 = a2 + kstep; const char* b3 = b2 + kstep;
            PG8_LDB(B0, 0, 0); PG8_LDB(B1, 0, 1); PG8_SCHED; PG8_LDA(At, 0, 0); PG8_STAGE(PG8_SA(1, 1), a1 + hstepA, voffA);
            PG8_WAIT_V(8); PG8_WAIT_L(0); PG8_BAR; PG8_MMA(0, 0, At, B0); PG8_MMA(0, 1, At, B1); PG8_BAR; PG8_SCHED;
            PG8_LDA(At, 0, 1); PG8_STAGE(PG8_SB(0, 0), b2, voffB); PG8_STAGE(PG8_SB(0, 1), b2 + hstepB, voffB); PG8_STAGE(PG8_SA(0, 0), a2, voffA);
            PG8_WAIT_V(8); PG8_WAIT_L(0); PG8_BAR; PG8_MMA(1, 0, At, B0); PG8_MMA(1, 1, At, B1); PG8_BAR; PG8_SCHED;
            PG8_LDB(B0, 1, 0); PG8_LDB(B1, 1, 1); PG8_SCHED; PG8_LDA(At, 1, 0); PG8_STAGE(PG8_SA(0, 1), a2 + hstepA, voffA);
            PG8_WAIT_V(8); PG8_WAIT_L(0); PG8_BAR; PG8_MMA(0, 0, At, B0); PG8_MMA(0, 1, At, B1); PG8_BAR; PG8_SCHED;
            PG8_LDA(At, 1, 1); PG8_STAGE(PG8_SB(1, 0), b3, voffB); PG8_STAGE(PG8_SB(1, 1), b3 + hstepB, voffB); PG8_STAGE(PG8_SA(1, 0), a3, voffA);
            PG8_WAIT_V(8); PG8_WAIT_L(0); PG8_BAR; PG8_MMA(1, 0, At, B0); PG8_MMA(1, 1, At, B1); PG8_BAR; PG8_SCHED;
        }
        if (wr == 0) PG8_BAR;
        { const int le = lane_now();
          E(acc, cur, wid >> 2, wid & 3, le & 15, le >> 4); }
        if (!has_next) break;
#pragma unroll
        for (int a = 0; a < 2; ++a)
#pragma unroll
            for (int b = 0; b < 2; ++b)
#pragma unroll
                for (int m = 0; m < 4; ++m)
#pragma unroll
                    for (int n = 0; n < 2; ++n) acc[a][b][m][n] = (f32x4){0.f, 0.f, 0.f, 0.f};
        cur = nxt; cA = nA; cB = nB; ++ui; nt = S.nt(cur);
        if (wr == 1) PG8_BAR;
    }
    PG8_WAIT_V(0);
    PG8_BAR;
#undef PG8_SA
#undef PG8_SB
#undef PG8_STAGE
#undef PG8_LDA
#undef PG8_LDB
#undef PG8_MMA
#undef PG8_WAIT_V
#undef PG8_WAIT_L
#undef PG8_BAR
#undef PG8_SCHED
}

struct EpiZ {
    static constexpr bool PERM = true;
    bf16_t* Z; const float* cs; float* LF; const float* fb; float* ssq; LAS unsigned char* xl;
    __device__ __forceinline__ void operator()(const f32x4 (&acc)[2][2][4][2], const Unit& u, int wr, int wc, int fr, int fq) const {
        const int row0 = u.pm * BM + wr * 64 + fr;
        if (u.pn <= 2) {
            const int lane = fr + 16 * fq;
            LAS f32x2* Pp = (LAS f32x2*)xl;
#pragma unroll
            for (int ai = 0; ai < 2; ++ai)
#pragma unroll
                for (int m = 0; m < 4; ++m) {
                    float sq = 0.f, sk = 0.f;
#pragma unroll
                    for (int bj = 0; bj < 2; ++bj) {
                        const int colg = u.pn * BM + bj * HALF + wc * 32 + 8 * fq;
                        const f32x4 a = acc[ai][bj][m][0], b = acc[ai][bj][m][1];
                        const float t = (a[0] * a[0] + a[1] * a[1]) + (a[2] * a[2] + a[3] * a[3]) + (b[0] * b[0] + b[1] * b[1]) + (b[2] * b[2] + b[3] * b[3]);
                        if (colg < ZC_CKV) sq += t; else if (colg < ZC_KPE) sk += t;
                    }
                    sq += shfl_xor_l(sq, 16, lane); sq += shfl_xor_l(sq, 32, lane);
                    sk += shfl_xor_l(sk, 16, lane); sk += shfl_xor_l(sk, 32, lane);
                    if (fq == 0) Pp[(ai * HALF + wr * 64 + m * 16 + fr) * 4 + wc] = (f32x2){sq, sk};
                }
            asm volatile("s_waitcnt lgkmcnt(0)" ::: "memory"); __builtin_amdgcn_s_barrier(); asm volatile("" ::: "memory");
            const int tid = (wr * 4 + wc) * 64 + lane;
            if (tid < 256) {
                const f32x2 a = Pp[tid * 4 + 0], b = Pp[tid * 4 + 1], c = Pp[tid * 4 + 2], d = Pp[tid * 4 + 3];
                float* dst = ssq + (size_t)(u.pm * BM + tid) * 2;
                if (u.pn <= 1) __hip_atomic_fetch_add(dst, (a[0] + b[0]) + (c[0] + d[0]), __ATOMIC_RELAXED, __HIP_MEMORY_SCOPE_AGENT);
                if (u.pn >= 1) __hip_atomic_fetch_add(dst + 1, (a[1] + b[1]) + (c[1] + d[1]), __ATOMIC_RELAXED, __HIP_MEMORY_SCOPE_AGENT);
            }
            asm volatile("" ::: "memory");
        }
#pragma unroll
        for (int bj = 0; bj < 2; ++bj) {
            const int colg = u.pn * BM + bj * HALF + wc * 32 + 8 * fq;
            const int zc = colg + (colg >= ZC_KPE ? 32 + ZPAD : 0);
            const bool gatecol = (zc >= ZC_GATE && zc < ZC_BQ);
            const bool kvcol = (zc >= ZC_BK && zc < ZC_CQ2) || (zc >= ZC_CK);
#pragma unroll
            for (int ai = 0; ai < 2; ++ai)
#pragma unroll
                for (int m = 0; m < 4; ++m) {
                    const int row = row0 + ai * HALF + m * 16;
                    f32x4 v0 = acc[ai][bj][m][0], v1 = acc[ai][bj][m][1];
                    if (gatecol) {
#pragma unroll
                        for (int i = 0; i < 4; ++i) { v0[i] = v0[i] * __builtin_amdgcn_rcpf(1.f + __builtin_amdgcn_exp2f(-LOG2E * v0[i])); v1[i] = v1[i] * __builtin_amdgcn_rcpf(1.f + __builtin_amdgcn_exp2f(-LOG2E * v1[i])); }
                    }
                    u32x4 w; w.x = cvtpk(v0[0], v0[1]); w.y = cvtpk(v0[2], v0[3]); w.z = cvtpk(v1[0], v1[1]); w.w = cvtpk(v1[2], v1[3]);
                    if (kvcol) *(u32x4*)(Z + (size_t)row * NZ + zc) = w; else __builtin_nontemporal_store(w, (u32x4*)(Z + (size_t)row * NZ + zc));
                    if (m == 3) asm volatile("" ::: "memory");
                }
        }
    }
};
struct EpiQ {
    static constexpr bool PERM = true;
    bf16_t* O; const float* cs; const float* rs;
    __device__ __forceinline__ void operator()(const f32x4 (&acc)[2][2][4][2], const Unit& u, int wr, int wc, int fr, int fq) const {
        const int row0 = u.pm * BM + wr * 64 + fr;
        float rr[8];
#pragma unroll
        for (int j = 0; j < 8; ++j) rr[j] = rs[(size_t)(row0 + (j >> 2) * HALF + (j & 3) * 16) * 2];
#pragma unroll
        for (int j = 0; j < 8; ++j) rr[j] = __builtin_amdgcn_rsqf(rr[j] * (1.f / 384.f) + EPS);
#pragma unroll
        for (int bj = 0; bj < 2; ++bj) {
            const int colg = u.pn * BM + bj * HALF + wc * 32 + 8 * fq;
            if (colg >= 576) continue;
            const int hd = colg % 96;
            const bool rope = hd >= 64;
            const int i0 = rope ? ((hd - 64) >> 1) : 0;
#pragma unroll
            for (int ai = 0; ai < 2; ++ai) {
                f32x4 co[4], si[4];
                if (rope) {
#pragma unroll
                    for (int m = 0; m < 4; ++m) { const size_t row = (size_t)(row0 + ai * HALF + m * 16); co[m] = *(const f32x4*)(cs + row * 32 + i0); si[m] = *(const f32x4*)(cs + row * 32 + 16 + i0); }
                }
#pragma unroll
                for (int m = 0; m < 4; ++m) {
                    const int row = row0 + ai * HALF + m * 16;
                    const float r = rr[ai * 4 + m];
                    f32x4 v0 = acc[ai][bj][m][0] * r, v1 = acc[ai][bj][m][1] * r;
                    if (rope) {
                        f32x4 a, b;
                        a[0] = v0[0] * co[m][0] - v0[1] * si[m][0]; a[1] = v0[0] * si[m][0] + v0[1] * co[m][0];
                        a[2] = v0[2] * co[m][1] - v0[3] * si[m][1]; a[3] = v0[2] * si[m][1] + v0[3] * co[m][1];
                        b[0] = v1[0] * co[m][2] - v1[1] * si[m][2]; b[1] = v1[0] * si[m][2] + v1[1] * co[m][2];
                        b[2] = v1[2] * co[m][3] - v1[3] * si[m][3]; b[3] = v1[2] * si[m][3] + v1[3] * co[m][3];
                        v0 = a; v1 = b;
                    }
                    u32x4 w; w.x = cvtpk(v0[0], v0[1]); w.y = cvtpk(v0[2], v0[3]); w.z = cvtpk(v1[0], v1[1]); w.w = cvtpk(v1[2], v1[3]);
                    *(u32x4*)(O + (size_t)row * QAP + colg) = w;
                }
                asm volatile("" ::: "memory");
            }
        }
    }
};
struct EpiKV {
    static constexpr bool PERM = true;
    bf16_t* O; const float* rs;
    __device__ __forceinline__ void operator()(const f32x4 (&acc)[2][2][4][2], const Unit& u, int wr, int wc, int fr, int fq) const {
        const int row0 = u.pm * BM + wr * 64 + fr;
        float rr[8];
#pragma unroll
        for (int j = 0; j < 8; ++j) rr[j] = rs[(size_t)(row0 + (j >> 2) * HALF + (j & 3) * 16) * 2 + 1];
#pragma unroll
        for (int j = 0; j < 8; ++j) rr[j] = __builtin_amdgcn_rsqf(rr[j] * (1.f / 256.f) + EPS);
#pragma unroll
        for (int bj = 0; bj < 2; ++bj) {
            const int colg = u.pn * BM + bj * HALF + wc * 32 + 8 * fq;
#pragma unroll
            for (int ai = 0; ai < 2; ++ai)
#pragma unroll
                for (int m = 0; m < 4; ++m) {
                    const int row = row0 + ai * HALF + m * 16;
                    const float r = rr[ai * 4 + m];
                    const f32x4 v0 = acc[ai][bj][m][0] * r, v1 = acc[ai][bj][m][1] * r;
                    u32x4 w; w.x = cvtpk(v0[0], v0[1]); w.y = cvtpk(v0[2], v0[3]); w.z = cvtpk(v1[0], v1[1]); w.w = cvtpk(v1[2], v1[3]);
                    *(u32x4*)(O + (size_t)row * QAP + colg) = w;
                    asm volatile("" ::: "memory");
                }
        }
    }
};
struct EpiUp {
    static constexpr bool PERM = true;
    EpiQ q; EpiKV kv;
    __device__ __forceinline__ void operator()(const f32x4 (&acc)[2][2][4][2], const Unit& u, int wr, int wc, int fr, int fq) const { if (u.kind == 0) q(acc, u, wr, wc, fr, fq); else kv(acc, u, wr, wc, fr, fq); }
};
struct EpiOut {
    static constexpr bool PERM = true;
    const float* xold; float* xnew; const float* gate;
    __device__ __forceinline__ void operator()(const f32x4 (&acc)[2][2][4][2], const Unit& u, int wr, int wc, int fr, int fq) const {
        const int row0 = u.pm * BM + wr * 64 + fr;
        const int b = (u.pm * BM) / SEQ;
#pragma unroll
        for (int bj = 0; bj < 2; ++bj) {
            const int colg = u.pn * BM + bj * HALF + wc * 32 + 8 * fq;
            const f32x4 g0 = *(const f32x4*)(gate + (size_t)b * 3072 + colg), g1 = *(const f32x4*)(gate + (size_t)b * 3072 + colg + 4);
#pragma unroll
            for (int ai = 0; ai < 2; ++ai)
#pragma unroll
                for (int m = 0; m < 4; ++m) {
                    const int row = row0 + ai * HALF + m * 16;
                    const size_t off = (size_t)row * DM + colg;
                    const f32x4 x0 = *(const f32x4*)(xold + off), x1 = *(const f32x4*)(xold + off + 4);
                    *(f32x4*)(xnew + off) = x0 + g0 * acc[ai][bj][m][0];
                    *(f32x4*)(xnew + off + 4) = x1 + g1 * acc[ai][bj][m][1];
                    if (m & 1) asm volatile("" ::: "memory");
                }
        }
    }
};

template <bool LAST>
struct EpiOutN {
    static constexpr bool PERM = true;
    const float* xold; float* xnew; const float* gate; const float* ng; const float* modn; bf16_t* H; float* ssq;
    float* xbuf; unsigned* cnt; LAS unsigned char* xl;
    __device__ __forceinline__ void operator()(f32x4 (&acc)[2][2][4][2], const Unit& u, int wr, int wc, int fr, int fq) const {
        const int lane = fr + 16 * fq, wid = wr * 4 + wc;
        const int row0 = u.pm * BM + wr * 64 + fr;
        const int b = (u.pm * BM) / SEQ;
        LAS float* Pp = (LAS float*)xl;
        LAS float* Sp = (LAS float*)(xl + 4096);
        volatile LAS unsigned* flag = (volatile LAS unsigned*)(xl + 5120);
#pragma unroll
        for (int bj = 0; bj < 2; ++bj) {
            const int colg = u.pn * BM + bj * HALF + wc * 32 + 8 * fq;
            const f32x4 g0 = *(const f32x4*)(gate + (size_t)b * 3072 + colg), g1 = *(const f32x4*)(gate + (size_t)b * 3072 + colg + 4);
#pragma unroll
            for (int ai = 0; ai < 2; ++ai) {
                f32x4 x0[4], x1[4];
#pragma unroll
                for (int m = 0; m < 4; ++m) {
                    const size_t r = (size_t)(row0 + ai * HALF + m * 16);
                    if (LAST) {
                        const u32x4 xb = __builtin_nontemporal_load((const u32x4*)((const bf16_t*)xold + r * (2 * DM) + colg));
                        x0[m] = (f32x4){bf_lo(xb.x), bf_hi(xb.x), bf_lo(xb.y), bf_hi(xb.y)}; x1[m] = (f32x4){bf_lo(xb.z), bf_hi(xb.z), bf_lo(xb.w), bf_hi(xb.w)};
                    } else { x0[m] = __builtin_nontemporal_load((const f32x4*)(xold + r * DM + colg)); x1[m] = __builtin_nontemporal_load((const f32x4*)(xold + r * DM + colg + 4)); }
                }
#pragma unroll
                for (int m = 0; m < 4; ++m) {
                    acc[ai][bj][m][0] = x0[m] + g0 * acc[ai][bj][m][0];
                    acc[ai][bj][m][1] = x1[m] + g1 * acc[ai][bj][m][1];
                    asm volatile("" : "+v"(acc[ai][bj][m][0]), "+v"(acc[ai][bj][m][1]));
                }
                asm volatile("" ::: "memory");
            }
        }
#pragma unroll
        for (int ai = 0; ai < 2; ++ai)
#pragma unroll
            for (int m = 0; m < 4; ++m) {
                float t = 0.f;
#pragma unroll
                for (int bj = 0; bj < 2; ++bj) { const f32x4 p = acc[ai][bj][m][0], q = acc[ai][bj][m][1];
                    t += (p[0] * p[0] + p[1] * p[1]) + (p[2] * p[2] + p[3] * p[3]) + (q[0] * q[0] + q[1] * q[1]) + (q[2] * q[2] + q[3] * q[3]); }
                t += shfl_xor_l(t, 16, lane); t += shfl_xor_l(t, 32, lane);
                if (fq == 0) Pp[(ai * HALF + wr * 64 + m * 16 + fr) * 4 + wc] = t;
            }
        asm volatile("s_waitcnt lgkmcnt(0)" ::: "memory"); __builtin_amdgcn_s_barrier(); asm volatile("" ::: "memory");
        const int row = wid * 32 + (lane & 31);
        if (lane < 32) {
            const f32x4 p = *(const LAS f32x4*)(Pp + row * 4);
            __hip_atomic_store(xbuf + (size_t)(u.pm * BM + row) * 4 + u.pn, (p[0] + p[1]) + (p[2] + p[3]), __ATOMIC_RELAXED, __HIP_MEMORY_SCOPE_AGENT);
        }
        asm volatile("s_waitcnt vmcnt(0)" ::: "memory");
        if (lane == 0) __hip_atomic_fetch_add(cnt + 64 * u.pm, 1u, __ATOMIC_RELAXED, __HIP_MEMORY_SCOPE_AGENT);
        if (!LAST) {
#pragma unroll
            for (int bj = 0; bj < 2; ++bj) {
                const int colg = u.pn * BM + bj * HALF + wc * 32 + 8 * fq;
#pragma unroll
                for (int ai = 0; ai < 2; ++ai)
#pragma unroll
                    for (int m = 0; m < 4; ++m) {
                        const int rt = ai * HALF + wr * 64 + m * 16 + fr;
                        const f32x4 v0 = acc[ai][bj][m][0], v1 = acc[ai][bj][m][1];
                        u32x4 xw; xw.x = cvtpk(v0[0], v0[1]); xw.y = cvtpk(v0[2], v0[3]); xw.z = cvtpk(v1[0], v1[1]); xw.w = cvtpk(v1[2], v1[3]);
                        *(u32x4*)((bf16_t*)xnew + (size_t)(u.pm * BM + rt) * (2 * DM) + colg) = xw;
                        if (m & 1) asm volatile("" ::: "memory");
                    }
            }
        }
        if (wid == 0) {
            bool dead = false; unsigned spins = 0u;
            for (;;) {
                if ((unsigned)__builtin_amdgcn_readfirstlane(__hip_atomic_load(cnt + 64 * u.pm, __ATOMIC_RELAXED, __HIP_MEMORY_SCOPE_AGENT)) >= 32u) break;
                if (++spins > (1u << 22)) { dead = true; break; }
                __builtin_amdgcn_s_sleep(2);
            }
            __builtin_amdgcn_fence(__ATOMIC_ACQUIRE, "agent");
            if (lane == 0) flag[0] = dead ? 1u : 0u;
        }
        asm volatile("s_waitcnt vmcnt(0) lgkmcnt(0)" ::: "memory"); __builtin_amdgcn_s_barrier(); asm volatile("" ::: "memory");
        const bool bad = flag[0] != 0u;
        if (lane < 32) {
            const float* slot = xbuf + (size_t)(u.pm * BM + row) * 4;
            float t = 0.f;
#pragma unroll
            for (int k = 0; k < 4; ++k) t += __hip_atomic_load(slot + k, __ATOMIC_RELAXED, __HIP_MEMORY_SCOPE_AGENT);
            Sp[row] = 1.0f / sqrtf(t * (1.f / DM) + EPS);
            if (!LAST && u.pn == 0) *(f32x2*)(ssq + (size_t)(u.pm * BM + row) * 2) = (f32x2){0.f, 0.f};
        }
        asm volatile("s_waitcnt vmcnt(0) lgkmcnt(0)" ::: "memory"); __builtin_amdgcn_s_barrier(); asm volatile("" ::: "memory");
        const float qnan = __builtin_nanf("");
#pragma unroll
        for (int bj = 0; bj < 2; ++bj) {
            const int colg = u.pn * BM + bj * HALF + wc * 32 + 8 * fq;
            f32x4 G0, G1, S0, S1;
            if (LAST) { G0 = *(const f32x4*)(ng + colg); G1 = *(const f32x4*)(ng + colg + 4); S0 = (f32x4){0.f, 0.f, 0.f, 0.f}; S1 = S0; }
            else {
                const float* mb = modn + (size_t)b * 3072;
                G0 = *(const f32x4*)(ng + colg) * (*(const f32x4*)(mb + 1024 + colg) + 1.0f); G1 = *(const f32x4*)(ng + colg + 4) * (*(const f32x4*)(mb + 1024 + colg + 4) + 1.0f);
                S0 = *(const f32x4*)(mb + colg); S1 = *(const f32x4*)(mb + colg + 4);
            }
#pragma unroll
            for (int ai = 0; ai < 2; ++ai)
#pragma unroll
                for (int m = 0; m < 4; ++m) {
                    const int rt = ai * HALF + wr * 64 + m * 16 + fr;
                    const float rs = Sp[rt];
                    const size_t off = (size_t)(u.pm * BM + rt) * DM + colg;
                    f32x4 v0 = acc[ai][bj][m][0], v1 = acc[ai][bj][m][1];
                    if (bad) { v0 = (f32x4){qnan, qnan, qnan, qnan}; v1 = v0; }
                    if (LAST) {
                        *(f32x4*)(xnew + off) = v0 * rs * G0; *(f32x4*)(xnew + off + 4) = v1 * rs * G1;
                    } else {
                        const f32x4 h0 = v0 * rs * G0 + S0, h1 = v1 * rs * G1 + S1;
                        u32x4 w; w.x = cvtpk(h0[0], h0[1]); w.y = cvtpk(h0[2], h0[3]); w.z = cvtpk(h1[0], h1[1]); w.w = cvtpk(h1[2], h1[3]);
                        *(u32x4*)(H + off) = w;
                    }
                    if (m & 1) asm volatile("" ::: "memory");
                }
        }
    }
};
}

namespace att {
constexpr int KSLOT = 12288, VSLOT = 8192, NSLOT = 4;
constexpr int L_K = 0, L_V = NSLOT * KSLOT, L_WS = L_V + NSLOT * VSLOT, L_OST = L_WS + 2048, L_TB = L_OST + 8 * 4096, L_GB = L_TB + 2048, L_END = L_GB + NSLOT * 8 * 256;
static_assert(L_END <= 131072, "attention LDS map");
constexpr float NEG = -1e30f;
constexpr float THR = 8.0f;

struct AP { const bf16_t* Q; int qp; const bf16_t* K; int kp; const bf16_t* K2; int k2p; const bf16_t* V; int vp; const bf16_t* gate; bf16_t* out; const float* kb; unsigned* ctr; };
constexpr int L_NEXT = 131072 + 128;

#define ATT_WAIT_V(n) asm volatile("s_waitcnt vmcnt(" #n ")" ::: "memory")

template <int MODE>
__device__ __forceinline__ void attn_unit(const AP P, const int qb, LAS unsigned char* lds, const int wv) {
    constexpr int DQK = (MODE == 0) ? 96 : 64, NQ = DQK / 16;
    constexpr int PG = (MODE == 1) ? 2 : 3;
    const int lane = lane_now(), r32 = lane & 31, hi = lane >> 5;
    const int wid = wv, tid = wv * 64 + lane;
    const int q0 = qb * 256;
    const int cw = 4 * qb + (wid >> 1);
    int t0 = 0; const int t1 = 4 * qb + 4;
    if (MODE == 1) t0 = (4 * qb - 8) > 0 ? (4 * qb - 8) : 0;
    const int qrel = 32 * (wid & 1) + r32;
    const bf16_t* ksrc = P.K + (size_t)lane * P.kp + wid * 8;
    const bf16_t* k2src = (MODE == 0) ? (P.K2 + (size_t)lane * P.k2p + (wid & 3) * 8) : nullptr;
    const bf16_t* vsrc = P.V + (size_t)(16 * (wid & 3) + (lane >> 2)) * P.vp + (wid >> 2) * 32 + (lane & 3) * 8;
    const float* gsrc = (MODE == 2) ? (P.kb + lane) : nullptr;
#define ATT_DMA_K(t) do { const int sl_ = ((t) - t0) & (NSLOT - 1); \
        __builtin_amdgcn_global_load_lds((const unsigned*)(ksrc + (size_t)(t) * 64 * P.kp), (LAS unsigned*)(lds + L_K + sl_ * KSLOT + wid * 1024), 16, 0, 0); \
        if (MODE == 0) __builtin_amdgcn_global_load_lds((const unsigned*)(k2src + (size_t)(t) * 64 * P.k2p), (LAS unsigned*)(lds + L_K + sl_ * KSLOT + 8192 + (wid & 3) * 1024), 16, 0, 0); } while (0)
#define ATT_DMA_V(t) do { const int sl_ = ((t) - t0) & (NSLOT - 1); \
        __builtin_amdgcn_global_load_lds((const unsigned*)(vsrc + (size_t)(t) * 64 * P.vp), (LAS unsigned*)(lds + L_V + sl_ * VSLOT + wid * 1024), 16, 0, 0); \
        if (MODE == 2) __builtin_amdgcn_global_load_lds((const unsigned*)(gsrc + (t) * 64), (LAS unsigned*)(lds + L_GB + (sl_ * 8 + wid) * 256), 4, 0, 0); } while (0)
#define ATT_VALID(t) (((t) <= cw) && (MODE != 1 || (t) >= cw - 8))
    ATT_DMA_K(t0); ATT_DMA_K(t0 + 1); ATT_DMA_K(t0 + 2); ATT_DMA_K(t0 + 3); ATT_DMA_V(t0); ATT_DMA_V(t0 + 1);
    bf16x8 qr[NQ];
    {
        const bf16_t* Qw = P.Q + (size_t)(q0 + wid * 32 + r32) * P.qp + hi * 8;
#pragma unroll
        for (int d0 = 0; d0 < NQ; ++d0) qr[d0] = *(const bf16x8*)(Qw + d0 * 16);
    }
    if (MODE == 1) { LAS float* tb = (LAS float*)(lds + L_TB); for (int i = tid; i < 257; i += 512) tb[i] = P.kb[i] * LOG2E; }
    float m_run = NEG, l_run = 0.f;
    f32x16 o0, o1;
#pragma unroll
    for (int r = 0; r < 16; ++r) { o0[r] = 0.f; o1[r] = 0.f; }
    LAS float* wsf = (LAS float*)(lds + L_WS) + wid * 64;
    const int vboff = ((lane >> 4) & 1) * 32 + (lane & 3) * 8 + (4 * hi + ((lane & 15) >> 2)) * 64;
    const LAS unsigned char* kbase = lds + L_K + hi * 1024 + r32 * 16;
    bf16x8 kf[2 * NQ];
    f32x16 sc0, sc1;
#define ATT_KLOAD(t) do { const LAS unsigned char* kp_ = kbase + (((t) - t0) & (NSLOT - 1)) * KSLOT; \
        _Pragma("unroll") for (int d0 = 0; d0 < NQ; ++d0) { kf[2 * d0] = *(const LAS bf16x8*)(kp_ + d0 * 2048); kf[2 * d0 + 1] = *(const LAS bf16x8*)(kp_ + d0 * 2048 + 512); } } while (0)
#define ATT_QK(d0_, d1_) do { _Pragma("unroll") for (int r = 0; r < 16; ++r) { d0_[r] = 0.f; d1_[r] = 0.f; } \
        _Pragma("unroll") for (int d0 = 0; d0 < NQ; ++d0) { d0_ = __builtin_amdgcn_mfma_f32_32x32x16_bf16(kf[2 * d0], qr[d0], d0_, 0, 0, 0); d1_ = __builtin_amdgcn_mfma_f32_32x32x16_bf16(kf[2 * d0 + 1], qr[d0], d1_, 0, 0, 0); } } while (0)
    ATT_WAIT_V(0);
    asm volatile("s_waitcnt lgkmcnt(0)" ::: "memory");
    __builtin_amdgcn_s_barrier();
    asm volatile("" ::: "memory");
    ATT_KLOAD(t0);
    ATT_QK(sc0, sc1);
    ATT_KLOAD(t0 + 1);
    for (int t = t0; t < t1; ++t) {
        const int cur = (t - t0) & (NSLOT - 1);
        {
            if (t + 3 < t1) { if (PG == 2) ATT_WAIT_V(2); else ATT_WAIT_V(3); } else ATT_WAIT_V(0);
            asm volatile("s_waitcnt lgkmcnt(0)" ::: "memory");
            __builtin_amdgcn_s_barrier();
            asm volatile("" ::: "memory");
        }
        if (t + 4 < t1) ATT_DMA_K(t + 4);
        if (t + 2 < t1) ATT_DMA_V(t + 2);
        const bool vcur = ATT_VALID(t), vnext = (t + 1 < t1) && ATT_VALID(t + 1);
        f32x16 sn0, sn1;
        if (vnext) ATT_QK(sn0, sn1);
        if (t + 2 < t1) ATT_KLOAD(t + 2);
        if (vcur) {
            f32x16 p0 = sc0, p1 = sc1;
            if (MODE == 2) {
                const LAS float* gp = (const LAS float*)(lds + L_GB + (cur * 8 + wid) * 256) + 4 * hi;
#pragma unroll
                for (int g4 = 0; g4 < 4; ++g4) {
                    const f32x4 a = *(const LAS f32x4*)(gp + 8 * g4), b = *(const LAS f32x4*)(gp + 32 + 8 * g4);
#pragma unroll
                    for (int i = 0; i < 4; ++i) { p0[4 * g4 + i] += a[i]; p1[4 * g4 + i] += b[i]; }
                }
                if (t == cw) {
#pragma unroll
                    for (int r = 0; r < 16; ++r) { const int kj = (r & 3) + 8 * (r >> 2) + 4 * hi; if (kj > qrel) p0[r] = NEG; if (kj + 32 > qrel) p1[r] = NEG; }
                }
            }
            if (MODE == 1) {
                const LAS float* tb = (const LAS float*)(lds + L_TB);
                const int mm = cw - t;
                if (mm >= 3) {
                    const float c = tb[256];
#pragma unroll
                    for (int r = 0; r < 16; ++r) { p0[r] += c; p1[r] += c; }
                } else {
                    const int base = 64 * mm + qrel - 4 * hi;
#pragma unroll
                    for (int r = 0; r < 16; ++r) {
                        const int c0 = (r & 3) + 8 * (r >> 2);
                        int i0 = base - c0; i0 = (i0 > 128 ? 128 : i0) + 128;
                        int i1 = base - c0 - 32; i1 = (i1 > 128 ? 128 : i1) + 128;
                        p0[r] += tb[i0]; p1[r] += tb[i1];
                    }
                }
            }
            float rm = fmaxf(p0[0], p1[0]);
#pragma unroll
            for (int r = 1; r < 16; ++r) rm = fmaxf(rm, fmaxf(p0[r], p1[r]));
            rm = fmaxf(rm, shfl_xor_l(rm, 32, lane));
            if (__any(rm > m_run + THR)) {
                const float mn = fmaxf(m_run, rm);
                const float f = __builtin_amdgcn_exp2f(m_run - mn);
                m_run = mn; l_run *= f;
                if (hi == 0) wsf[r32] = f;
                asm volatile("" ::: "memory");
#pragma unroll
                for (int g4 = 0; g4 < 4; ++g4) {
                    const f32x4 fv = *(const LAS f32x4*)(wsf + 8 * g4 + 4 * hi);
#pragma unroll
                    for (int i = 0; i < 4; ++i) { o0[4 * g4 + i] *= fv[i]; o1[4 * g4 + i] *= fv[i]; }
                }
            }
            float s = 0.f;
#pragma unroll
            for (int r = 0; r < 16; ++r) { p0[r] = __builtin_amdgcn_exp2f(p0[r] - m_run); p1[r] = __builtin_amdgcn_exp2f(p1[r] - m_run); s += p0[r] + p1[r]; }
            l_run += s;
            u32x4 pw[4];
            pw[0] = (u32x4){cvtpk(p0[0], p0[1]), cvtpk(p0[2], p0[3]), cvtpk(p0[4], p0[5]), cvtpk(p0[6], p0[7])};
            pw[1] = (u32x4){cvtpk(p0[8], p0[9]), cvtpk(p0[10], p0[11]), cvtpk(p0[12], p0[13]), cvtpk(p0[14], p0[15])};
            pw[2] = (u32x4){cvtpk(p1[0], p1[1]), cvtpk(p1[2], p1[3]), cvtpk(p1[4], p1[5]), cvtpk(p1[6], p1[7])};
            pw[3] = (u32x4){cvtpk(p1[8], p1[9]), cvtpk(p1[10], p1[11]), cvtpk(p1[12], p1[13]), cvtpk(p1[14], p1[15])};
            const unsigned vb = (unsigned)(uintptr_t)(lds + L_V + cur * VSLOT + vboff);
#pragma unroll
            for (int d0 = 0; d0 < 2; ++d0) {
                s16x4 lo[4], hh[4];
#pragma unroll
                for (int ks = 0; ks < 4; ++ks) {
                    asm volatile("ds_read_b64_tr_b16 %0, %1 offset:%c2" : "=&v"(lo[ks]) : "v"(vb), "i"(d0 * 4096 + ks * 1024) : "memory");
                    asm volatile("ds_read_b64_tr_b16 %0, %1 offset:%c2" : "=&v"(hh[ks]) : "v"(vb), "i"(d0 * 4096 + ks * 1024 + 512) : "memory");
                }
                asm volatile("s_waitcnt lgkmcnt(0)" ::: "memory"); __builtin_amdgcn_sched_barrier(0);
#pragma unroll
                for (int ks = 0; ks < 4; ++ks) {
                    const bf16x8 pa = __builtin_bit_cast(bf16x8, pw[ks]);
                    const bf16x8 vf = {lo[ks][0], lo[ks][1], lo[ks][2], lo[ks][3], hh[ks][0], hh[ks][1], hh[ks][2], hh[ks][3]};
                    if (d0 == 0) o0 = __builtin_amdgcn_mfma_f32_32x32x16_bf16(pa, vf, o0, 0, 0, 0);
                    else o1 = __builtin_amdgcn_mfma_f32_32x32x16_bf16(pa, vf, o1, 0, 0, 0);
                }
            }
        }
        if (vnext) { sc0 = sn0; sc1 = sn1; }
    }
    unsigned nxt_unit = 0u;
    if (tid == 0) nxt_unit = __hip_atomic_fetch_add(P.ctr, 1u, __ATOMIC_RELAXED, __HIP_MEMORY_SCOPE_AGENT);
    l_run += shfl_xor_l(l_run, 32, lane);
    if (hi == 0) wsf[32 + r32] = l_run;
    asm volatile("" ::: "memory");
    float rli[16];
#pragma unroll
    for (int g4 = 0; g4 < 4; ++g4) {
        const f32x4 lv = *(const LAS f32x4*)(wsf + 32 + 8 * g4 + 4 * hi);
#pragma unroll
        for (int i = 0; i < 4; ++i) rli[4 * g4 + i] = 1.0f / lv[i];
    }
    LAS bf16_t* stg = (LAS bf16_t*)(lds + L_OST) + wid * 2048;
#pragma unroll
    for (int r = 0; r < 16; ++r) {
        const int orow = (r & 3) + 8 * (r >> 2) + 4 * hi;
        stg[orow * 64 + r32] = (bf16_t)(cvtpk(o0[r] * rli[r], 0.f) & 0xffffu);
        stg[orow * 64 + 32 + r32] = (bf16_t)(cvtpk(o1[r] * rli[r], 0.f) & 0xffffu);
    }
    asm volatile("" ::: "memory");
#pragma unroll
    for (int i = 0; i < 4; ++i) {
        const int row = i * 8 + (lane >> 3), ch = lane & 7;
        const u32x4 v = *(const LAS u32x4*)(stg + row * 64 + ch * 8);
        const size_t grow = (size_t)(q0 + wid * 32 + row);
        const u32x4 gt = *(const u32x4*)(P.gate + grow * NZ + ch * 8);
        u32x4 w;
        w.x = cvtpk(bf_lo(v.x) * bf_lo(gt.x), bf_hi(v.x) * bf_hi(gt.x));
        w.y = cvtpk(bf_lo(v.y) * bf_lo(gt.y), bf_hi(v.y) * bf_hi(gt.y));
        w.z = cvtpk(bf_lo(v.z) * bf_lo(gt.z), bf_hi(v.z) * bf_hi(gt.z));
        w.w = cvtpk(bf_lo(v.w) * bf_lo(gt.w), bf_hi(v.w) * bf_hi(gt.w));
        *(u32x4*)(P.out + grow * DM + ch * 8) = w;
    }
    if (tid == 0) *(volatile LAS unsigned*)(lds + L_NEXT) = nxt_unit;
    __syncthreads();
#undef ATT_DMA_K
#undef ATT_DMA_V
#undef ATT_VALID
#undef ATT_KLOAD
#undef ATT_QK
}
}


namespace fa {
constexpr int NW = 8, QBLK = 32, KVBLK = 64;
constexpr int NSLOT = 3, SLOTB = 8192;
template <int MODE> struct Map {
    static constexpr int KSLOT = (MODE == 0) ? 12288 : 8192;
    static constexpr int LDS_K = 0, LDS_V = NSLOT * KSLOT, LDS_WS = LDS_V + NSLOT * SLOTB, LDS_OST = LDS_WS + NW * 64 * 4, LDS_TB = LDS_OST + NW * 4096, LDS_G = LDS_TB + 2048, LDS_END = LDS_G + 8192;
    static_assert(LDS_END <= 131072, "fast attention LDS map");
};
typedef LAS const unsigned char* lds_cptr;
#define SBAR() __builtin_amdgcn_sched_barrier(0)
__device__ __forceinline__ int crow(int r, int hi) { return (r & 3) + 8 * (r >> 2) + 4 * hi; }
__device__ __forceinline__ void glds16(const void* gsrc, unsigned lds_dst) { unsigned keep;
    asm volatile("s_mov_b32 %0, m0\n\ts_mov_b32 m0, %2\n\ts_nop 0\n\tglobal_load_lds_dwordx4 %1, off\n\ts_mov_b32 m0, %0" : "=&s"(keep) : "v"(gsrc), "s"(lds_dst) : "memory"); }
__device__ __forceinline__ void glds16s(const void* sbase, unsigned voff, unsigned lds_dst) { unsigned keep;
    asm volatile("s_mov_b32 %0, m0\n\ts_mov_b32 m0, %3\n\ts_nop 0\n\tglobal_load_lds_dwordx4 %1, %2\n\ts_mov_b32 m0, %0" : "=&s"(keep) : "v"(voff), "s"(sbase), "s"(lds_dst) : "memory"); }
__device__ __forceinline__ float max3f(float a, float b, float c) { float r; asm("v_max3_f32 %0, %1, %2, %3" : "=v"(r) : "v"(a), "v"(b), "v"(c)); return r; }
__device__ __forceinline__ float max2f(float a, float b) { float r; asm("v_max_f32_e32 %0, %1, %2" : "=v"(r) : "v"(a), "v"(b)); return r; }
__device__ __forceinline__ float fadd_s(float a, float b) { float r; asm("v_add_f32_e32 %0, %1, %2" : "=v"(r) : "v"(a), "v"(b)); return r; }
__device__ __forceinline__ float fsub_s(float a, float b) { float r; asm("v_sub_f32_e32 %0, %1, %2" : "=v"(r) : "v"(a), "v"(b)); return r; }
#define WAIT_BAR(N) asm volatile("s_waitcnt vmcnt(" #N ") lgkmcnt(0)\n\ts_barrier" ::: "memory")
__device__ __forceinline__ void kx_init(int* kx, int r32, int hi) {
    const int a0 = (r32 >> 3) * 1024 + (r32 & 7) * 128, sw = (r32 >> 1) & 7;
#pragma unroll
    for (int d0 = 0; d0 < 4; ++d0) kx[d0] = a0 + (((2 * d0 + hi) ^ sw) << 4);
}
template <int NQ>
__device__ __forceinline__ void qkt(f32x16& p0, f32x16& p1, lds_cptr Kslot, const bf16x8* qr, const f32x16& negm, int r32, int hi, const int* kx) {
    lds_cptr kb = Kslot + hi * 1024 + r32 * 16;
#pragma unroll
    for (int d0 = 0; d0 < NQ; ++d0) {
        const bf16x8 b0 = (d0 < 4) ? *(const LAS bf16x8*)(Kslot + kx[d0 & 3]) : *(const LAS bf16x8*)(kb + d0 * 2048);
        const bf16x8 b1 = (d0 < 4) ? *(const LAS bf16x8*)(Kslot + kx[d0 & 3] + 4096) : *(const LAS bf16x8*)(kb + d0 * 2048 + 512);
        if (d0 == 0) { p0 = __builtin_amdgcn_mfma_f32_32x32x16_bf16(b0, qr[0], negm, 0, 0, 0); p1 = __builtin_amdgcn_mfma_f32_32x32x16_bf16(b1, qr[0], negm, 0, 0, 0); }
        else { p0 = __builtin_amdgcn_mfma_f32_32x32x16_bf16(b0, qr[d0], p0, 0, 0, 0); p1 = __builtin_amdgcn_mfma_f32_32x32x16_bf16(b1, qr[d0], p1, 0, 0, 0); } }
}
__device__ __forceinline__ void kload2(bf16x8* kf, lds_cptr kslot, int j, const int* kx) { kf[2 * j] = *(const LAS bf16x8*)(kslot + kx[j]); kf[2 * j + 1] = *(const LAS bf16x8*)(kslot + kx[j] + 4096); }
__device__ __forceinline__ void kload8(bf16x8* kf, lds_cptr kslot, const int* kx) {
#pragma unroll
    for (int j = 0; j < 4; ++j) kload2(kf, kslot, j, kx);
}
__device__ __forceinline__ s16x4 vtr(lds_cptr p) { return __builtin_bit_cast(s16x4, __builtin_amdgcn_ds_read_tr16_b64_v4i16((LAS s16x4*)p)); }
__device__ __forceinline__ float rowmax(const f32x16& p0, const f32x16& p1) {
    float a = max3f(p0[0], p0[1], p1[0]), b = max3f(p0[2], p0[3], p1[1]); a = max3f(a, p1[2], p1[3]);
#pragma unroll
    for (int r = 4; r < 16; r += 4) { a = max3f(a, p0[r], p0[r + 1]); b = max3f(b, p0[r + 2], p0[r + 3]); a = max3f(a, p1[r], p1[r + 1]); b = max3f(b, p1[r + 2], p1[r + 3]); }
    const float m = max2f(a, b);
    auto rr = __builtin_amdgcn_permlane32_swap(__float_as_uint(m), __float_as_uint(m), false, false);
    return max2f(__uint_as_float(rr[0]), __uint_as_float(rr[1]));
}
__device__ __forceinline__ void pv(f32x16* o, int vb, bf16x8 pa0, bf16x8 pa1, bf16x8 pa2, bf16x8 pa3) {
#pragma unroll
    for (int d0 = 0; d0 < 2; ++d0) { s16x4 lo[4], hi[4];
#pragma unroll
        for (int ks = 0; ks < 4; ++ks) {
            asm volatile("ds_read_b64_tr_b16 %0,%1 offset:%c2" : "=&v"(lo[ks]) : "v"(vb), "i"(d0 * 4096 + ks * 1024) : "memory");
            asm volatile("ds_read_b64_tr_b16 %0,%1 offset:%c2" : "=&v"(hi[ks]) : "v"(vb), "i"(d0 * 4096 + ks * 1024 + 512) : "memory"); }
        asm volatile("s_waitcnt lgkmcnt(0)" ::: "memory"); SBAR();
#define PK(k) (bf16x8){lo[k][0], lo[k][1], lo[k][2], lo[k][3], hi[k][0], hi[k][1], hi[k][2], hi[k][3]}
        o[d0] = __builtin_amdgcn_mfma_f32_32x32x16_bf16(pa0, PK(0), o[d0], 0, 0, 0);
        o[d0] = __builtin_amdgcn_mfma_f32_32x32x16_bf16(pa1, PK(1), o[d0], 0, 0, 0);
        o[d0] = __builtin_amdgcn_mfma_f32_32x32x16_bf16(pa2, PK(2), o[d0], 0, 0, 0);
        o[d0] = __builtin_amdgcn_mfma_f32_32x32x16_bf16(pa3, PK(3), o[d0], 0, 0, 0);
#undef PK
    }
}
template <int MODE>
__device__ __forceinline__ void bias_mask(f32x16& p0, f32x16& p1, int ta, int qb, int cw, int qrelu, int qrel64, int hi, const LAS float* tab) {
    if (MODE == 0) {
        if (ta > cw) {
            asm volatile("" ::: "memory");
            const float NEGI = -INFINITY;
#pragma unroll
            for (int r = 0; r < 16; ++r) { p0[r] = NEGI; p1[r] = NEGI; }
        }
    } else if (MODE == 2) {
        const LAS float* gp = tab + 64 * ta + 4 * hi;
#pragma unroll
        for (int g4 = 0; g4 < 4; ++g4) {
            const f32x4 a = *(const LAS f32x4*)(gp + 8 * g4), b = *(const LAS f32x4*)(gp + 32 + 8 * g4);
#pragma unroll
            for (int i = 0; i < 4; ++i) { p0[4 * g4 + i] += a[i]; p1[4 * g4 + i] += b[i]; }
            if (g4 == 1) { asm volatile("" : "+v"(p0), "+v"(p1) :: "memory"); }
        }
        const int jb = ta - 4 * qb;
        if (jb >= 0) {
            const float NEGI = -INFINITY; const int kb = 64 * jb + 4 * hi;
#pragma unroll
            for (int r = 0; r < 16; ++r) { const int kv = kb + (r & 3) + 8 * (r >> 2); if (kv > qrelu) p0[r] = NEGI; if (kv + 32 > qrelu) p1[r] = NEGI; }
        }
    } else {
        const int mm = cw - ta;
        if (mm < 0 || mm > 8) {
            const float NEGI = -INFINITY;
#pragma unroll
            for (int r = 0; r < 16; ++r) { p0[r] = NEGI; p1[r] = NEGI; }
        } else if (mm >= 3) {
            const float c = tab[256];
#pragma unroll
            for (int r = 0; r < 16; ++r) { p0[r] += c; p1[r] += c; }
        } else {
            const int base = 64 * mm + qrel64 - 4 * hi;
            const LAS float* tp = tab + (base + 128 - 59);
#pragma unroll
            for (int r = 0; r < 16; ++r) {
                const int c0 = (r & 3) + 8 * (r >> 2);
                p0[r] += tp[59 - c0]; p1[r] += tp[27 - c0];
            }
        }
    }
}

template <int MODE, int THRL>
__device__ __forceinline__ void attn_unit(const att::AP P, const int qb, LAS unsigned char* lds, const int wv) {
    constexpr int NQ = (MODE == 0) ? 6 : 4;
    constexpr int LDS_K = Map<MODE>::LDS_K, LDS_V = Map<MODE>::LDS_V, LDS_WS = Map<MODE>::LDS_WS, LDS_OST = Map<MODE>::LDS_OST, LDS_TB = Map<MODE>::LDS_TB, LDS_G = Map<MODE>::LDS_G;
    const int lane = lane_now(), r32 = lane & 31, hi = lane >> 5;
    const int wid = wv, tid = wv * 64 + lane;
    const int q0 = qb * 256;
    const int cw = 4 * qb + (wid >> 1);
    int t0 = 0; const int t1 = 4 * qb + 4;
    if (MODE == 1) t0 = (4 * qb - 8) > 0 ? (4 * qb - 8) : 0;
    const int NT = t1 - t0;
#define KOFF(sl) ((MODE == 0) ? ((sl) + ((sl) >> 1)) : (sl))
    const int qrelu = wid * QBLK + r32;
    const int qrel64 = 32 * (wid & 1) + r32;
    LAS float* tab = (LAS float*)(lds + (MODE == 2 ? LDS_G : LDS_TB));
    const bf16_t* Qw = P.Q + (size_t)(q0 + wid * QBLK) * P.qp;
    const bf16_t* Kh = P.K + (size_t)(t1 - 1) * KVBLK * P.kp; const bf16_t* Vh = P.V + (size_t)(t1 - 1) * KVBLK * P.vp;
    const unsigned lds0 = (unsigned)(uintptr_t)lds;
    LAS float* wsf = (LAS float*)(lds + LDS_WS) + wid * 64;
    const unsigned kvo = (unsigned)((8 * wid + (lane >> 3)) * P.kp + (((lane & 7) ^ (((wid & 1) << 2) | (lane >> 4))) * 8)) * 2u, vvo = (unsigned)((16 * (wid & 3) + (lane >> 2)) * P.vp + (wid >> 2) * 32 + (lane & 3) * 8) * 2u;
    const unsigned kdst = lds0 + LDS_K + wid * 1024, vdst = lds0 + LDS_V + wid * 1024;
    const bf16_t* K2h = (MODE == 0) ? (P.K2 + (size_t)(t1 - 1) * KVBLK * P.k2p) : nullptr; const unsigned k2vo = (MODE == 0) ? (unsigned)(lane * P.k2p + (wid & 3) * 8) * 2u : 0u;
    const unsigned k2dst = lds0 + LDS_K + 8192 + (wid & 3) * 1024;
#define DMA_K(t, slot) glds16s(Kh - (size_t)(t) * KVBLK * P.kp, kvo, (unsigned)__builtin_amdgcn_readfirstlane(kdst + KOFF(slot)))
#define DMA_K2(t, slot) glds16s(K2h - (size_t)(t) * KVBLK * P.k2p, k2vo, (unsigned)__builtin_amdgcn_readfirstlane(k2dst + KOFF(slot)))
#define DMA_V(t, slot) glds16s(Vh - (size_t)(t) * KVBLK * P.vp, vvo, (unsigned)__builtin_amdgcn_readfirstlane(vdst + (slot)))
    const int vb0 = (int)(lds0 + LDS_V) + ((lane >> 4) & 1) * 32 + (lane & 3) * 8 + (4 * hi + ((lane & 15) >> 2)) * 64;
    lds_cptr Kbase = lds + LDS_K; bf16x8 kf[8];
    int kx[4]; kx_init(kx, r32, hi);
    lds_cptr kp0 = lds + LDS_K + hi * 1024 + r32 * 16; lds_cptr vp0 = lds + LDS_V + ((lane >> 4) & 1) * 32 + (lane & 3) * 8 + (4 * hi + ((lane & 15) >> 2)) * 64;
    DMA_K(0, 0); if (MODE == 0) DMA_K2(0, 0); DMA_V(0, 0); DMA_K(1, SLOTB); if (MODE == 0) DMA_K2(1, SLOTB);
    bf16x8 qr[NQ];
#pragma unroll
    for (int d0 = 0; d0 < NQ; ++d0) qr[d0] = *(const bf16x8*)(Qw + (size_t)r32 * P.qp + d0 * 16 + hi * 8);
    if (MODE == 2) { if (4 * tid < t1 * 64) { const f32x4 g = *(const f32x4*)(P.kb + 4 * tid); *(LAS f32x4*)(tab + 4 * tid) = g; } }
    else if (MODE == 1) { if (tid < 320) tab[tid] = P.kb[tid < 256 ? tid : 256] * LOG2E; }
    float mhat = 0.f, l_reg = 0.f; f32x16 o[2];
#pragma unroll
    for (int r = 0; r < 16; ++r) { o[0][r] = 0.f; o[1][r] = 0.f; }
    f32x16 negm;
#pragma unroll
    for (int r = 0; r < 16; ++r) negm[r] = 0.f;
    asm volatile("" : "+v"(negm));
#define BMASK(P0, P1, t, BAND) bias_mask<MODE>(P0, P1, t1 - 1 - (t), qb, cw, qrelu, qrel64, hi, tab)
    bool resc = false;
#define START(P0, P1) do { const float rm = rowmax(P0, P1); resc = false; \
    { const float dl = __builtin_fmaxf(rm, -1.0e4f); mhat = fadd_s(mhat, dl); \
      _Pragma("unroll") for (int r = 0; r < 16; ++r) { P0[r] = fsub_s(P0[r], dl); P1[r] = fsub_s(P1[r], dl); } \
      _Pragma("unroll") for (int r = 0; r < 16; ++r) negm[r] = -mhat; asm volatile("" : "+v"(negm)); } \
    _Pragma("unroll") for (int r = 0; r < 16; ++r) P0[r] = __builtin_amdgcn_exp2f(P0[r]); } while (0)
#define RESC() do { if (resc) { asm volatile("s_waitcnt lgkmcnt(0)" ::: "memory"); \
      _Pragma("unroll") for (int d_ = 0; d_ < 2; ++d_) _Pragma("unroll") for (int r = 0; r < 16; ++r) o[d_][r] *= wsf[crow(r, hi)]; } } while (0)
    f32x16 pA0, pA1, pB0, pB1;
    int sl_prev = 0, sl_cur = 0, sl_next = SLOTB;
#define ROT() do { sl_prev = sl_cur; sl_cur = sl_next; sl_next = (sl_next == (NSLOT - 1) * SLOTB) ? 0 : sl_next + SLOTB; } while (0)
    DMA_K(2, 2 * SLOTB);
    if (MODE == 0) WAIT_BAR(4); else WAIT_BAR(3);
    qkt<NQ>(pA0, pA1, Kbase, qr, negm, r32, hi, kx); asm volatile("s_nop 15\n\ts_nop 7" : "+v"(pA0), "+v"(pA1)); BMASK(pA0, pA1, 0, true);
    START(pA0, pA1);
#pragma unroll
    for (int r = 0; r < 16; ++r) pA1[r] = __builtin_amdgcn_exp2f(pA1[r]);
    WAIT_BAR(0);
    DMA_K(3, 0); if (MODE == 0) DMA_K2(2, 2 * SLOTB); DMA_V(1, SLOTB);
    ROT();
    kload8(kf, Kbase + KOFF(sl_cur), kx);
    if (MODE == 0) WAIT_BAR(3); else WAIT_BAR(2);
    s16x4 vlo[8], vhi[8]; u32x4 pw0, pw1, pw2, pw3;
#define PKW(P, B) cvtpk(P[B], P[B + 1])
#define PAF(k) __builtin_bit_cast(bf16x8, pw##k)
#define VFR(i) (bf16x8){vlo[i][0], vlo[i][1], vlo[i][2], vlo[i][3], vhi[i][0], vhi[i][1], vhi[i][2], vhi[i][3]}
#define PIN(x) asm volatile("" : "+v"(x))
#define MX3(a, b, c) __builtin_fmaxf(__builtin_fmaxf((a), (b)), (c))
#define GAPA(MF, A0, A1, A2, A3, W0, W1, PW) do { MF; sacc += A0; sacc += A1; sacc += A2; sacc += A3; PIN(sacc); W0; W1; PIN(PW); SBAR(); } while (0)
#define EX(v) __builtin_amdgcn_exp2f(v)
#define GAPB(MF, X, B) do { MF; X[B] = EX(X[B]); X[B + 1] = EX(X[B + 1]); X[B + 2] = EX(X[B + 2]); X[B + 3] = EX(X[B + 3]); PIN(X); SBAR(); } while (0)
#define VRD(i) do { vlo[i] = vtr(vp_ + (((i) >> 2) * 4096 + ((i) & 3) * 1024)); vhi[i] = vtr(vp_ + (((i) >> 2) * 4096 + ((i) & 3) * 1024 + 512)); } while (0)
#define KRD(G, j) do { if (G) { kload2(kf, Kbase + KOFF(sl_next), j, kx); SBAR(); } } while (0)
#define STEP(C0, C1, P0, P1, t, GK, GK2, GV, GL, BAND) do { SBAR(); \
    lds_cptr vp_ = vp0 + sl_prev; \
    bf16x8 kr0, kr1, kr2, kr3; \
    if (MODE == 0) { lds_cptr kq_ = kp0 + KOFF(sl_cur) + 8192; kr0 = *(const LAS bf16x8*)(kq_); kr1 = *(const LAS bf16x8*)(kq_ + 512); kr2 = *(const LAS bf16x8*)(kq_ + 2048); kr3 = *(const LAS bf16x8*)(kq_ + 2560); SBAR(); } \
    VRD(0); SBAR(); float sacc = (P0[0] + P0[1]); \
    GAPA(C0 = __builtin_amdgcn_mfma_f32_32x32x16_bf16(kf[0], qr[0], negm, 0, 0, 0), P0[2], P0[3], P0[4], P0[5],     pw0[0] = PKW(P0, 0), pw0[1] = PKW(P0, 2), pw0); \
    VRD(4); SBAR(); GAPA(C1 = __builtin_amdgcn_mfma_f32_32x32x16_bf16(kf[1], qr[0], negm, 0, 0, 0), P0[6], P0[7], P0[8], P0[9],     pw0[2] = PKW(P0, 4), pw0[3] = PKW(P0, 6), pw0); \
    VRD(1); SBAR(); GAPA(C0 = __builtin_amdgcn_mfma_f32_32x32x16_bf16(kf[2], qr[1], C0, 0, 0, 0),   P0[10], P0[11], P0[12], P0[13], pw1[0] = PKW(P0, 8), pw1[1] = PKW(P0, 10), pw1); \
    VRD(5); SBAR(); GAPA(C1 = __builtin_amdgcn_mfma_f32_32x32x16_bf16(kf[3], qr[1], C1, 0, 0, 0),   P0[14], P0[15], P1[0], P1[1],   pw1[2] = PKW(P0, 12), pw1[3] = PKW(P0, 14), pw1); \
    VRD(2); SBAR(); GAPA(C0 = __builtin_amdgcn_mfma_f32_32x32x16_bf16(kf[4], qr[2], C0, 0, 0, 0),   P1[2], P1[3], P1[4], P1[5],     pw2[0] = PKW(P1, 0), pw2[1] = PKW(P1, 2), pw2); \
    VRD(6); SBAR(); GAPA(C1 = __builtin_amdgcn_mfma_f32_32x32x16_bf16(kf[5], qr[2], C1, 0, 0, 0),   P1[6], P1[7], P1[8], P1[9],     pw2[2] = PKW(P1, 4), pw2[3] = PKW(P1, 6), pw2); \
    VRD(3); SBAR(); GAPA(C0 = __builtin_amdgcn_mfma_f32_32x32x16_bf16(kf[6], qr[3], C0, 0, 0, 0),   P1[10], P1[11], P1[12], P1[13], pw3[0] = PKW(P1, 8), pw3[1] = PKW(P1, 10), pw3); \
    VRD(7); SBAR(); GAPA(C1 = __builtin_amdgcn_mfma_f32_32x32x16_bf16(kf[7], qr[3], C1, 0, 0, 0),   P1[14], P1[15], 0.f, 0.f,       pw3[2] = PKW(P1, 12), pw3[3] = PKW(P1, 14), pw3); \
    if (MODE == 0) { \
        C0 = __builtin_amdgcn_mfma_f32_32x32x16_bf16(kr0, qr[NQ - 2], C0, 0, 0, 0); C1 = __builtin_amdgcn_mfma_f32_32x32x16_bf16(kr1, qr[NQ - 2], C1, 0, 0, 0); \
        C0 = __builtin_amdgcn_mfma_f32_32x32x16_bf16(kr2, qr[NQ - 1], C0, 0, 0, 0); C1 = __builtin_amdgcn_mfma_f32_32x32x16_bf16(kr3, qr[NQ - 1], C1, 0, 0, 0); SBAR(); } \
    l_reg += sacc; \
    if (GK) { DMA_K((t) + 3, sl_cur); } if (MODE == 0 && (GK2)) { DMA_K2((t) + 2, sl_prev); } if (GV) { DMA_V((t) + 1, sl_next); } \
    BMASK(C0, C1, t, BAND); \
    { float a = MX3(C0[0], C0[1], C1[0]), b = MX3(C0[2], C0[3], C1[1]); a = MX3(a, C1[2], C1[3]); \
      _Pragma("unroll") for (int r = 4; r < 16; r += 4) { a = MX3(a, C0[r], C0[r + 1]); b = MX3(b, C0[r + 2], C0[r + 3]); a = MX3(a, C1[r], C1[r + 1]); b = MX3(b, C1[r + 2], C1[r + 3]); } \
      float rm = __builtin_fmaxf(a, b); { auto rr = __builtin_amdgcn_permlane32_swap(__float_as_uint(rm), __float_as_uint(rm), false, false); rm = __builtin_fmaxf(__uint_as_float(rr[0]), __uint_as_float(rr[1])); } \
      resc = false; \
      if (__builtin_expect(__any(rm > (float)THRL), 0)) { const float dl = __builtin_fmaxf(rm, 0.f); mhat += dl; \
        _Pragma("unroll") for (int r = 0; r < 16; ++r) { C0[r] -= dl; C1[r] -= dl; } \
        _Pragma("unroll") for (int r = 0; r < 16; ++r) negm[r] = -mhat; asm volatile("" : "+v"(negm)); \
        const float f = __builtin_amdgcn_exp2f(-dl); l_reg *= f; if (hi == 0) wsf[r32] = f; resc = true; } } \
    SBAR(); \
    GAPB(o[0] = __builtin_amdgcn_mfma_f32_32x32x16_bf16(PAF(0), VFR(0), o[0], 0, 0, 0), C0, 0); \
    GAPB(o[1] = __builtin_amdgcn_mfma_f32_32x32x16_bf16(PAF(0), VFR(4), o[1], 0, 0, 0), C0, 4); \
    KRD(GL, 0); GAPB(o[0] = __builtin_amdgcn_mfma_f32_32x32x16_bf16(PAF(1), VFR(1), o[0], 0, 0, 0), C0, 8); \
    KRD(GL, 1); GAPB(o[1] = __builtin_amdgcn_mfma_f32_32x32x16_bf16(PAF(1), VFR(5), o[1], 0, 0, 0), C0, 12); \
    KRD(GL, 2); GAPB(o[0] = __builtin_amdgcn_mfma_f32_32x32x16_bf16(PAF(2), VFR(2), o[0], 0, 0, 0), C1, 0); \
    KRD(GL, 3); GAPB(o[1] = __builtin_amdgcn_mfma_f32_32x32x16_bf16(PAF(2), VFR(6), o[1], 0, 0, 0), C1, 4); \
    GAPB(o[0] = __builtin_amdgcn_mfma_f32_32x32x16_bf16(PAF(3), VFR(3), o[0], 0, 0, 0), C1, 8); \
    GAPB(o[1] = __builtin_amdgcn_mfma_f32_32x32x16_bf16(PAF(3), VFR(7), o[1], 0, 0, 0), C1, 12); \
    } while (0)
    int t = 1;
#define ENDW(tt) do { if ((tt) + 3 < NT) { if (MODE == 0) WAIT_BAR(3); else WAIT_BAR(2); } else if ((tt) + 2 < NT) { if (MODE == 0) WAIT_BAR(2); else WAIT_BAR(1); } else { WAIT_BAR(0); } } while (0)
    for (; t + 1 < NT; t += 2) {
        STEP(pB0, pB1, pA0, pA1, t, (t + 3 < NT), (t + 2 < NT), (t + 1 < NT), (t + 1 < NT), true);         ENDW(t);     RESC(); ROT();
        STEP(pA0, pA1, pB0, pB1, t + 1, (t + 4 < NT), (t + 3 < NT), (t + 2 < NT), (t + 2 < NT), true);     ENDW(t + 1); RESC(); ROT();
    }
    STEP(pB0, pB1, pA0, pA1, NT - 1, false, false, false, false, true); RESC();
    u32x4 gtv[4];
#pragma unroll
    for (int i = 0; i < 4; ++i) gtv[i] = __builtin_nontemporal_load((const u32x4*)(P.gate + (size_t)(q0 + wid * QBLK + i * 8 + (lane >> 3)) * NZ + (lane & 7) * 8));
    { float sacc = pB0[0] + pB0[1];
#pragma unroll
      for (int r = 2; r < 16; ++r) sacc += pB0[r];
#pragma unroll
      for (int r = 0; r < 16; ++r) sacc += pB1[r];
      l_reg += sacc;
      pw0 = (u32x4){PKW(pB0, 0), PKW(pB0, 2), PKW(pB0, 4), PKW(pB0, 6)}; pw1 = (u32x4){PKW(pB0, 8), PKW(pB0, 10), PKW(pB0, 12), PKW(pB0, 14)};
      pw2 = (u32x4){PKW(pB1, 0), PKW(pB1, 2), PKW(pB1, 4), PKW(pB1, 6)}; pw3 = (u32x4){PKW(pB1, 8), PKW(pB1, 10), PKW(pB1, 12), PKW(pB1, 14)};
      SBAR(); pv(o, vb0 + sl_cur, PAF(0), PAF(1), PAF(2), PAF(3)); }
#undef PKW
#undef PAF
#undef VFR
#undef PIN
#undef MX3
#undef GAPA
#undef GAPB
#undef EX
#undef VRD
#undef KRD
#undef STEP
#undef ENDW
    unsigned nxt_unit = 0u;
    if (tid == 0) nxt_unit = __hip_atomic_fetch_add(P.ctr, 1u, __ATOMIC_RELAXED, __HIP_MEMORY_SCOPE_AGENT);
    { auto rr = __builtin_amdgcn_permlane32_swap(__float_as_uint(l_reg), __float_as_uint(l_reg), false, false); l_reg = __uint_as_float(rr[0]) + __uint_as_float(rr[1]); }
    if (hi == 0) wsf[32 + r32] = l_reg; asm volatile("s_waitcnt lgkmcnt(0)" ::: "memory");
    float rli[16];
#pragma unroll
    for (int r = 0; r < 16; ++r) rli[r] = __builtin_amdgcn_rcpf(wsf[32 + crow(r, hi)]);
    {
        LAS bf16_t* stg = (LAS bf16_t*)(lds + LDS_OST) + wid * 2048;
#pragma unroll
        for (int r = 0; r < 16; ++r) { const int orow = crow(r, hi);
#pragma unroll
            for (int d0 = 0; d0 < 2; ++d0) stg[orow * 64 + d0 * 32 + r32] = (bf16_t)(cvtpk(o[d0][r] * rli[r], 0.f) & 0xffffu); }
        asm volatile("s_waitcnt lgkmcnt(0)" ::: "memory");
#pragma unroll
        for (int i = 0; i < 4; ++i) { const int row = i * 8 + (lane >> 3), ch = lane & 7; const u32x4 v = *(const LAS u32x4*)(stg + row * 64 + ch * 8);
            const size_t grow = (size_t)(q0 + wid * QBLK + row);
            const u32x4 gt = gtv[i];
            u32x4 w;
            w.x = cvtpk(bf_lo(v.x) * bf_lo(gt.x), bf_hi(v.x) * bf_hi(gt.x));
            w.y = cvtpk(bf_lo(v.y) * bf_lo(gt.y), bf_hi(v.y) * bf_hi(gt.y));
            w.z = cvtpk(bf_lo(v.z) * bf_lo(gt.z), bf_hi(v.z) * bf_hi(gt.z));
            w.w = cvtpk(bf_lo(v.w) * bf_lo(gt.w), bf_hi(v.w) * bf_hi(gt.w));
            *(u32x4*)(P.out + grow * DM + ch * 8) = w; }
    }
    if (tid == 0) *(volatile LAS unsigned*)(lds + att::L_NEXT) = nxt_unit;
    asm volatile("s_waitcnt lgkmcnt(0)\n\ts_barrier" ::: "memory");
#undef DMA_K
#undef DMA_K2
#undef DMA_V
#undef BMASK
#undef START
#undef RESC
#undef ROT
#undef KOFF
}
#undef SBAR
#undef WAIT_BAR
}

struct Args {
    const float* x; const float* c; const int* pos; const float* w_ada; const float* b_ada; const float* norm_g; const float* w_in;
    const float* qng; const float* w_uq; const float* kvng; const float* w_ukv; const float* relb; const float* fgb; const float* w_out; const float* final_g;
    float* out; unsigned char* ws; int ph_lo, ph_hi;
};

__device__ __forceinline__ int src_col(int kind, int n, float& sc) {
    sc = 1.f;
    if (kind == 4) { if (n < 32) { kind = 0; n = ZC_KPE + n; } else if (n < 37) { kind = 0; n = (ZC_CF - ZPAD) + (n - 32); } else return -1; }
    else if (kind == 0) { n = n + (n >= ZC_KPE ? 32 : 0); }
    if (kind == 0) {
        if (n < ZC_KPE) return n;
        if (n < (ZC_GATE - ZPAD)) { const int i = (n - ZC_KPE) >> 1, odd = (n - ZC_KPE) & 1; return 640 + i + 16 * odd; }
        if (n < 1056) return n;
        if (n < 1376) return 2016 + (n - 1056);
        if (n < (ZC_BQ - ZPAD)) return 3301 + (n - 1376);
        if (n < (ZC_BK - ZPAD)) { sc = 0.125f * LOG2E; return 1056 + (n - (ZC_BQ - ZPAD)); }
        if (n < (ZC_BV - ZPAD)) return 1376 + (n - (ZC_BK - ZPAD));
        if (n < (ZC_CQ2 - ZPAD)) return 1696 + (n - (ZC_BV - ZPAD));
        if (n < (ZC_CK - ZPAD)) { sc = 0.125f * LOG2E; return 2336 + (n - (ZC_CQ2 - ZPAD)); }
        if (n < (ZC_CV - ZPAD)) return 2656 + (n - (ZC_CK - ZPAD));
        if (n < (ZC_CF - ZPAD)) return 2976 + (n - (ZC_CV - ZPAD));
        if (n < (ZC_CF - ZPAD) + 5) return 3296 + (n - (ZC_CF - ZPAD));
        return -1;
    } else if (kind == 1) {
        if (n >= 576) return -1;
        sc = 0.10206207261596577f * LOG2E;
        const int h = n / 96, d = n % 96;
        if (d < 64) return n;
        const int i = (d - 64) >> 1, odd = (d - 64) & 1; return h * 96 + 64 + i + 16 * odd;
    } else if (kind == 2) {
        if (n < 384) { const int h = n >> 6, d = n & 63; return h * 128 + d; }
        const int m = n - 384, h = m >> 6, d = m & 63; return h * 128 + 64 + d;
    }
    return n;
}
__device__ __forceinline__ void transpose_item(const float* W, int N, int K, bf16_t* WT, LAS float* scr, int kind, const float* rowscale, int item, int nblk, int lane, int pitch = 0) {
    if (pitch == 0) pitch = K;
    const int kb = item / nblk, nb = item % nblk, k0 = 64 * kb, n0 = 32 * nb;
    float csc; const int sc = src_col(kind, n0 + (lane & 31), csc);
    float v[32], rsc[32];
    const float* wp = W + (size_t)(k0 + (lane >> 5)) * N + (sc >= 0 ? sc : 0);
#pragma unroll
    for (int i = 0; i < 32; ++i) v[i] = __builtin_nontemporal_load(wp + (size_t)(2 * i) * N);
    if (rowscale) {
#pragma unroll
        for (int i = 0; i < 32; ++i) rsc[i] = rowscale[k0 + 2 * i + (lane >> 5)];
    } else {
#pragma unroll
        for (int i = 0; i < 32; ++i) rsc[i] = 1.f;
    }
    if (sc < 0) csc = 0.f;
#pragma unroll
    for (int i = 0; i < 32; ++i) scr[(2 * i + (lane >> 5)) * 33 + (lane & 31)] = v[i] * csc * rsc[i];
    __builtin_amdgcn_s_waitcnt(0xc07f);
    asm volatile("" ::: "memory");
    const int c = lane & 7;
#pragma unroll
    for (int j = 0; j < 4; ++j) {
        const int n = (lane >> 3) + 8 * j; const LAS float* s = scr + (8 * c) * 33 + n;
        u32x4 o; o.x = cvtpk(s[0 * 33], s[1 * 33]); o.y = cvtpk(s[2 * 33], s[3 * 33]); o.z = cvtpk(s[4 * 33], s[5 * 33]); o.w = cvtpk(s[6 * 33], s[7 * 33]);
        *(u32x4*)(WT + (size_t)(n0 + n) * pitch + k0 + 8 * c) = o;
    }
    __builtin_amdgcn_s_waitcnt(0xc07f);
    asm volatile("" ::: "memory");
}

__device__ __forceinline__ void phase0(const Args& a, LAS unsigned char* lds, const int wv, const int bid) {
    const int lane = lane_now(), wave = wv, tid = wv * 64 + lane;
    float* mod = (float*)(a.ws + WS_MOD);
    if (bid < 192) {
        LAS float* cact = (LAS float*)lds;
        for (int i = tid; i < 16 * 1024; i += 512) { const int b = i >> 10, k = i & 1023; const float v = a.c[i]; cact[k * 16 + b] = v / (1.f + __expf(-v)); }
        __syncthreads();
        const int q = bid, l = q / 96, j0 = (q % 96) * 32, ks = wave * 2 + (lane >> 5), jc = lane & 31;
        float acc[16];
#pragma unroll
        for (int b = 0; b < 16; ++b) acc[b] = 0.f;
        const float* w = a.w_ada + (size_t)l * 1024 * 3072 + (size_t)(ks * 64) * 3072 + j0 + jc;
#pragma unroll 8
        for (int kk = 0; kk < 64; ++kk) {
            const float wv = __builtin_nontemporal_load(w + (size_t)kk * 3072);
            const LAS f32x4* cp = (const LAS f32x4*)(cact + (ks * 64 + kk) * 16);
            const f32x4 c0 = cp[0], c1 = cp[1], c2 = cp[2], c3 = cp[3];
#pragma unroll
            for (int i = 0; i < 4; ++i) { acc[i] += wv * c0[i]; acc[4 + i] += wv * c1[i]; acc[8 + i] += wv * c2[i]; acc[12 + i] += wv * c3[i]; }
        }
        LAS float* part = (LAS float*)(lds + 65536);
#pragma unroll
        for (int b = 0; b < 16; ++b) part[(ks * 16 + b) * 32 + jc] = acc[b];
        __syncthreads();
        {
            const int b = tid >> 5, jj = tid & 31; float sacc = a.b_ada[l * 3072 + j0 + jj];
#pragma unroll
            for (int k2 = 0; k2 < 16; ++k2) sacc += part[(k2 * 16 + b) * 32 + jj];
            mod[((size_t)l * 16 + b) * 3072 + j0 + jj] = sacc;
        }
        __syncthreads();
    }
    {
        LAS float* scr = (LAS float*)(lds + wave * 8448);
        const int gw = bid * 8 + wave, NGW = gridDim.x * 8;
        constexpr int I_IN = 16 * 112, I_37 = 16 * 2, I_UQ = 6 * 24, I_UKV = 4 * 24, I_OUT = 16 * 32, I_L = I_IN + I_37 + I_UQ + I_UKV + I_OUT;
        for (int it = gw; it < 2 * I_L; it += NGW) {
            const int l = it / I_L; int r = it % I_L;
            if (r < I_IN) { transpose_item(a.w_in + (size_t)l * 1024 * NIN, NIN, 1024, (bf16_t*)(a.ws + WS_WIN) + (size_t)l * NZG * 1024, scr, 0, nullptr, r, 112, lane); continue; } r -= I_IN;
            if (r < I_37) { transpose_item(a.w_in + (size_t)l * 1024 * NIN, NIN, 1024, (bf16_t*)(a.ws + WS_W37) + (size_t)l * 64 * 1024, scr, 4, nullptr, r, 2, lane); continue; } r -= I_37;
            if (r < I_UQ) { transpose_item(a.w_uq + (size_t)l * 384 * 576, 576, 384, (bf16_t*)(a.ws + WS_WUQ) + (size_t)l * 768 * 384, scr, 1, a.qng + l * 384, r, 24, lane); continue; } r -= I_UQ;
            if (r < I_UKV) { transpose_item(a.w_ukv + (size_t)l * 256 * 768, 768, 256, (bf16_t*)(a.ws + WS_WUKV) + (size_t)l * 768 * 384, scr, 2, a.kvng + l * 256, r, 24, lane, 384); continue; } r -= I_UKV;
            transpose_item(a.w_out + (size_t)l * 1024 * 1024, 1024, 1024, (bf16_t*)(a.ws + WS_WOUT) + (size_t)l * 1024 * 1024, scr, 3, nullptr, r, 32, lane);
        }
    }
    {
        float* cs = (float*)(a.ws + WS_CS);
        const int gt = bid * 512 + tid, NGT = gridDim.x * 512;
        for (int i = gt; i < NTOK * 16; i += NGT) {
            const int tok = i >> 4, j = i & 15;
            const float inv = exp2f(-(float)j * (13.287712379549449f / 16.f));
            const float ang = (float)a.pos[tok] * inv;
            double r = (double)ang; r -= 6.283185307179586 * rint(r * 0.15915494309189535);
            cs[(size_t)tok * 32 + j] = cosf((float)r); cs[(size_t)tok * 32 + 16 + j] = sinf((float)r);
        }
    }
}


__device__ __forceinline__ void side37(const Args& a, const int L, const bf16_t* H, LAS unsigned char* lds, const int wv, const int bid) {
    const int lane = lane_now(), lr = lane & 15, fq = lane >> 4, tid = wv * 64 + lane;
    const int row = bid * 128 + wv * 16 + lr;
    const bf16_t* hp = H + (size_t)row * 1024 + 8 * fq;
    bf16x8 hf[32];
#pragma unroll
    for (int k = 0; k < 32; ++k) hf[k] = *(const bf16x8*)(hp + 32 * k);
    {
        const bf16_t* wsrc = (const bf16_t*)(a.ws + WS_W37) + (size_t)L * 64 * 1024;
#pragma unroll
        for (int j = 0; j < 12; ++j) { const int i = tid + 512 * j, r = i >> 7, ch = i & 127;
            const u32x4 v = *(const u32x4*)(wsrc + (size_t)r * 1024 + ch * 8); *(LAS u32x4*)(lds + r * 2064 + ch * 16) = v; }
    }
    __syncthreads();
    f32x4 acc0 = {0.f, 0.f, 0.f, 0.f}, acc1 = acc0, acc2 = acc0;
    const LAS unsigned char* wl = lds + lr * 2064 + fq * 16;
#pragma unroll
    for (int k = 0; k < 32; ++k) {
        const bf16x8 w0 = *(const LAS bf16x8*)(wl + k * 64), w1 = *(const LAS bf16x8*)(wl + 16 * 2064 + k * 64), w2 = *(const LAS bf16x8*)(wl + 32 * 2064 + k * 64);
        acc0 = __builtin_amdgcn_mfma_f32_16x16x32_bf16(w0, hf[k], acc0, 0, 0, 0);
        acc1 = __builtin_amdgcn_mfma_f32_16x16x32_bf16(w1, hf[k], acc1, 0, 0, 0);
        acc2 = __builtin_amdgcn_mfma_f32_16x16x32_bf16(w2, hf[k], acc2, 0, 0, 0);
    }
    __syncthreads();
    bf16_t* Z = (bf16_t*)(a.ws + WS_Z);
    const float* cs = (const float*)(a.ws + WS_CS) + (size_t)row * 32;
#pragma unroll
    for (int n = 0; n < 2; ++n) {
        const f32x4 v = n == 0 ? acc0 : acc1;
        const int i0 = 8 * n + 2 * fq;
        const f32x2 co = *(const f32x2*)(cs + i0), si = *(const f32x2*)(cs + 16 + i0);
        u32x2 w;
        w.x = cvtpk(v[0] * co[0] - v[1] * si[0], v[0] * si[0] + v[1] * co[0]);
        w.y = cvtpk(v[2] * co[1] - v[3] * si[1], v[2] * si[1] + v[3] * co[1]);
        *(u32x2*)(Z + (size_t)row * NZ + ZC_KPE + 16 * n + 4 * fq) = w;
    }
    if (fq < 2) {
        float* LF = (float*)(a.ws + WS_LF) + (size_t)row * 8;
        const float* fb = a.fgb + L * 5;
        const int nh = fq == 0 ? 4 : 1;
#pragma unroll
        for (int i = 0; i < 4; ++i) if (i < nh) { const float t = acc2[i] + fb[4 * fq + i]; LF[4 * fq + i] = fminf(t, 0.f) - log1pf(__expf(-fabsf(t))); }
    }
}

__device__ __forceinline__ void phase_norm(const Args& a, int l, const float* xin, const int wv, const int bid) {
    const int lane = lane_now(), wave = wv;
    const int gw = bid * 8 + wave, NGW = gridDim.x * 8, wpb = NGW / NB;
    const int b = gw / wpb, wi = gw % wpb;
    if (b >= NB) return;
    const float* mod = (const float*)(a.ws + WS_MOD) + ((size_t)l * 16 + b) * 3072;
    bf16_t* H = (bf16_t*)(a.ws + WS_H);
    f32x4 G[4], SH[4];
#pragma unroll
    for (int j = 0; j < 4; ++j) {
        const int col = 4 * lane + 256 * j;
        const f32x4 g = *(const f32x4*)(a.norm_g + l * 1024 + col), sc = *(const f32x4*)(mod + 1024 + col);
        G[j] = g * (sc + 1.0f); SH[j] = *(const f32x4*)(mod + col);
    }
    for (int row = wi; row < SEQ; row += wpb) {
        const size_t tok = (size_t)b * SEQ + row;
        const f32x4* xr = (const f32x4*)(xin + tok * DM) + lane;
        f32x4 v[4]; float s = 0.f;
#pragma unroll
        for (int j = 0; j < 4; ++j) { v[j] = __builtin_nontemporal_load(xr + 64 * j); s += (v[j].x * v[j].x + v[j].y * v[j].y) + (v[j].z * v[j].z + v[j].w * v[j].w); }
        const float rstd = 1.0f / sqrtf(wave_sum(s, lane) * (1.f / DM) + EPS);
        if (lane == 0) *(f32x2*)((float*)(a.ws + WS_RQ) + tok * 2) = (f32x2){0.f, 0.f};
        u32x2* o8 = (u32x2*)(H + tok * DM) + lane;
#pragma unroll
        for (int j = 0; j < 4; ++j) { const f32x4 h = v[j] * rstd * G[j] + SH[j]; u32x2 w; w.x = cvtpk(h.x, h.y); w.y = cvtpk(h.z, h.w); o8[64 * j] = w; }
    }
}

__device__ __forceinline__ void phase_stats(const Args& a, const int wv, const int bid) {
    const int lane = lane_now(), wave = wv;
    const int gw = bid * 8 + wave;
    if (gw < 80) {
        const int b = gw / 5, h = gw % 5;
        const float* LF = (const float*)(a.ws + WS_LF) + ((size_t)b * SEQ + lane * 32) * 8 + h;
        float* Gp = (float*)(a.ws + WS_G) + (size_t)gw * SEQ + lane * 32;
        float v[32]; float run = 0.f;
#pragma unroll
        for (int i = 0; i < 32; ++i) { run += LF[i * 8]; v[i] = run; }
        float incl = run;
#pragma unroll
        for (int o = 1; o < 64; o <<= 1) { const float t = shfl_up_l(incl, o, lane); if (lane >= o) incl += t; }
        const float excl = incl - run;
#pragma unroll
        for (int i = 0; i < 32; ++i) Gp[i] = -(excl + v[i]) * LOG2E;
    }
}

__device__ __forceinline__ void phase_attn(const Args& a, int l, LAS unsigned char* lds, const int wv, const int bid, const int crep) {
    const bf16_t* Z = (const bf16_t*)(a.ws + WS_Z);
    const bf16_t* QA = (const bf16_t*)(a.ws + WS_QA);
    const bf16_t* KVA = (const bf16_t*)(a.ws + WS_KVA);
    bf16_t* MIX = (bf16_t*)(a.ws + WS_H);
    const float* Gt = (const float*)(a.ws + WS_G);
    unsigned* ctr0 = (unsigned*)(a.ws + WS_CTL) + 8192 + 64 * (l * 8) + 1024 * crep;
    const int myx = (int)((unsigned)__builtin_amdgcn_s_getreg((3 << 11) | 20) & 7u);
    volatile LAS unsigned* nxt = (volatile LAS unsigned*)(lds + att::L_NEXT);
    int curx = myx;
    if (wv == 0 && lane_now() == 0) *nxt = __hip_atomic_fetch_add(ctr0 + 64 * curx, 1u, __ATOMIC_RELAXED, __HIP_MEMORY_SCOPE_AGENT);
    __syncthreads();
    for (;;) {
        const int u = __builtin_amdgcn_readfirstlane((int)*nxt);
        if (u >= 256) {
            __syncthreads();
            if (wv == 0 && lane_now() == 0) {
                unsigned c[8];
#pragma unroll
                for (int j = 0; j < 8; ++j) c[j] = __hip_atomic_load(ctr0 + 64 * j, __ATOMIC_RELAXED, __HIP_MEMORY_SCOPE_AGENT);
                int pick = -1;
#pragma unroll
                for (int k = 7; k >= 1; --k) { const int x = (curx + k) & 7; unsigned cx = 0u;
#pragma unroll
                    for (int j = 0; j < 8; ++j) cx = (j == x) ? c[j] : cx;
                    if (cx < 256u) pick = x; }
                nxt[1] = (unsigned)pick;
                nxt[0] = pick >= 0 ? __hip_atomic_fetch_add(ctr0 + 64 * pick, 1u, __ATOMIC_RELAXED, __HIP_MEMORY_SCOPE_AGENT) : 0u;
            }
            __syncthreads();
            const int pk = __builtin_amdgcn_readfirstlane((int)nxt[1]);
            if (pk < 0) break;
            curx = pk;
            continue;
        }
        unsigned* ctr = ctr0 + 64 * curx;
        int mode, qb, bh;
        { const int g = u >> 5, w = u & 31, hh = 4 * g + (w & 3); qb = 7 - (w >> 2);
          if (hh < 12) { mode = 0; bh = curx * 12 + hh; } else if (hh < 22) { mode = 2; bh = curx * 10 + (hh - 12); } else { mode = 1; bh = curx * 10 + (hh - 22); } }
        att::AP P;
        if (mode == 0) {
            const int b = bh / 6, h = bh % 6; const size_t rb = (size_t)b * SEQ;
            P.Q = QA + rb * QAP + h * 96; P.qp = QAP;
            P.K = KVA + rb * QAP + h * 64; P.kp = QAP;
            P.K2 = Z + rb * NZ + ZC_KPE; P.k2p = NZ;
            P.V = KVA + rb * QAP + 384 + h * 64; P.vp = QAP;
            P.gate = Z + rb * NZ + ZC_GATE + h * 64; P.out = MIX + rb * DM + h * 64; P.kb = nullptr; P.ctr = ctr;
            fa::attn_unit<0, 8>(P, qb, lds, wv);
        } else if (mode == 1) {
            const int b = bh / 5, h = bh % 5; const size_t rb = (size_t)b * SEQ;
            P.Q = Z + rb * NZ + ZC_BQ + h * 64; P.qp = NZ;
            P.K = Z + rb * NZ + ZC_BK + h * 64; P.kp = NZ; P.K2 = nullptr; P.k2p = 0;
            P.V = Z + rb * NZ + ZC_BV + h * 64; P.vp = NZ;
            P.gate = Z + rb * NZ + ZC_GATE + 384 + h * 64; P.out = MIX + rb * DM + 384 + h * 64; P.kb = a.relb + ((size_t)l * 5 + h) * 257; P.ctr = ctr;
            fa::attn_unit<1, 8>(P, qb, lds, wv);
        } else {
            const int b = bh / 5, h = bh % 5; const size_t rb = (size_t)b * SEQ;
            P.Q = Z + rb * NZ + ZC_CQ2 + h * 64; P.qp = NZ;
            P.K = Z + rb * NZ + ZC_CK + h * 64; P.kp = NZ; P.K2 = nullptr; P.k2p = 0;
            P.V = Z + rb * NZ + ZC_CV + h * 64; P.vp = NZ;
            P.gate = Z + rb * NZ + ZC_GATE + 704 + h * 64; P.out = MIX + rb * DM + 704 + h * 64; P.kb = Gt + (size_t)bh * SEQ; P.ctr = ctr;
            fa::attn_unit<2, 8>(P, qb, lds, wv);
        }
    }
    __syncthreads();
}

__device__ __forceinline__ void phase_final(const Args& a, const int wv, const int bid) {
    const int lane = lane_now(), wave = wv;
    const int gw = bid * 8 + wave, NGW = gridDim.x * 8;
    f32x4 G[4];
#pragma unroll
    for (int j = 0; j < 4; ++j) G[j] = *(const f32x4*)(a.final_g + 4 * lane + 256 * j);
    for (int row = gw; row < NTOK; row += NGW) {
        f32x4* xr = (f32x4*)(a.out + (size_t)row * DM) + lane;
        f32x4 v[4]; float s = 0.f;
#pragma unroll
        for (int j = 0; j < 4; ++j) { v[j] = xr[64 * j]; s += (v[j].x * v[j].x + v[j].y * v[j].y) + (v[j].z * v[j].z + v[j].w * v[j].w); }
        const float rstd = 1.0f / sqrtf(wave_sum(s, lane) * (1.f / DM) + EPS);
#pragma unroll
        for (int j = 0; j < 4; ++j) xr[64 * j] = v[j] * rstd * G[j];
    }
}


#define XB_TMO      128
#define XB_XCNT(j)  (256  + 64 * (j))
#define XB_XSUB(j)  (1280 + 64 * (j))
#define XB_XGEN(j)  (2304 + 64 * (j))
#define XB_TOP      3328
#define XB_TOPGEN   3392
#define XCD_BAR_WORDS 3456
#define XB_SPIN_CAP (1u << 18)
__device__ __forceinline__ unsigned xb_ld(unsigned* p)              { return __hip_atomic_load(p, __ATOMIC_RELAXED, __HIP_MEMORY_SCOPE_AGENT); }
__device__ __forceinline__ unsigned xb_add(unsigned* p, unsigned v) { return __hip_atomic_fetch_add(p, v, __ATOMIC_RELAXED, __HIP_MEMORY_SCOPE_AGENT); }
__device__ __forceinline__ unsigned xb_xcc_id() { return (unsigned)__builtin_amdgcn_s_getreg((3 << 11) | 20) & 0xFu; }
#define XB_SPIN(cond, bar) do { unsigned _sp = 0; while (cond) { __builtin_amdgcn_s_sleep(4); \
    if ((++_sp & 255u) == 0u) { if (xb_ld(&(bar)[XB_TMO])) break; if (_sp > XB_SPIN_CAP) { atomicAdd(&(bar)[XB_TMO], 1u); break; } } } } while (0)
struct XcdBarrier { unsigned* bar; unsigned x; volatile LAS unsigned* st; };
__device__ __forceinline__ void xcd_barrier_complete(unsigned* bar, unsigned x, unsigned& nloc, unsigned& nx) {
    const unsigned G = gridDim.x * gridDim.y * gridDim.z;
    unsigned sum, cnt, mine, sp = 0u;
    for (;;) {
        sum = 0u; cnt = 0u; mine = 0u;
#pragma unroll
        for (unsigned j = 0; j < 16; ++j) { const unsigned c = xb_ld(&bar[XB_XCNT(j)]); sum += c; cnt += (c > 0u) ? 1u : 0u; mine = (j == x) ? c : mine; }
        if (sum == G) break;
        __builtin_amdgcn_s_sleep(1);
        if ((++sp & 255u) == 0u) { if (xb_ld(&bar[XB_TMO])) break; if (sp > XB_SPIN_CAP) { atomicAdd(&bar[XB_TMO], 1u); break; } }
    }
    nloc = mine > 0u ? mine : 1u; nx = cnt > 0u ? cnt : 1u;
}
__device__ __forceinline__ void xcd_barrier(const XcdBarrier& b, const bool first) {
    asm volatile("s_waitcnt vmcnt(0)" ::: "memory");
    __syncthreads();
    if (first) {
        unsigned* bar = b.bar;
        __builtin_amdgcn_s_waitcnt(0);
        unsigned nloc = b.st[0], nx = b.st[1];
        if (nloc == 0u) { xcd_barrier_complete(bar, b.x, nloc, nx); b.st[0] = nloc; b.st[1] = nx; }
        const unsigned old = xb_add(&bar[XB_XSUB(b.x)], 1u);
        const unsigned gen = old / nloc;
        if (old + 1u == (gen + 1u) * nloc) {
            __builtin_amdgcn_fence(__ATOMIC_RELEASE, "agent");
            asm volatile("s_waitcnt vmcnt(0)" ::: "memory");
            const unsigned og = xb_add(&bar[XB_TOP], 1u);
            const unsigned tg = og / nx;
            if (og + 1u == (tg + 1u) * nx) xb_add(&bar[XB_TOPGEN], 1u);
            else XB_SPIN(xb_ld(&bar[XB_TOPGEN]) == tg, bar);
            __builtin_amdgcn_fence(__ATOMIC_ACQUIRE, "agent");
            xb_add(&bar[XB_XGEN(b.x)], 1u);
            asm volatile("s_waitcnt vmcnt(0)" ::: "memory");
        } else {
            XB_SPIN(xb_ld(&bar[XB_XGEN(b.x)]) == gen, bar);
            __builtin_amdgcn_fence(__ATOMIC_ACQUIRE, "agent");
            asm volatile("s_waitcnt vmcnt(0)" ::: "memory");
        }
    }
    __syncthreads();
}

#ifndef ONLY
#define ONLY -1
#endif
#define EN(n) (ONLY < 0 || ONLY == (n))
#ifndef DBLMASK
#define DBLMASK 0
#endif
#define PH_IN(k) (lo <= (k) && (k) < hi)
#define SEAM(k) do { if constexpr (COOP) { if (lo <= (k) && (k) + 1 < hi) xcd_barrier(xb, wv == 0 && lane_now() == 0); } } while (0)
#define BAR() do { if constexpr (COOP) xcd_barrier(xb, wv == 0 && lane_now() == 0); } while (0)

template <bool COOP, int L>
__device__ __forceinline__ void layer_phases(const Args& a, LAS unsigned char* lds, const int wv, const int bid, const int lo, const int hi, const XcdBarrier& xb) {
    constexpr int P = (L == 0) ? 2 : 6;
    const float* mod = (const float*)(a.ws + WS_MOD);
    if (L == 0) { if (PH_IN(1) && EN(1)) phase_norm(a, 0, a.x, wv, bid); SEAM(1); }
    if (PH_IN(P + 0) && EN(2)) {
        const bool side_first = ((bid >> 3) & 1) == 0;
        if (side_first) side37(a, L, (const bf16_t*)(a.ws + (L == 0 ? WS_H : WS_HN)), lds, wv, bid);
        pg8::Gemm g{(const bf16_t*)(a.ws + (L == 0 ? WS_H : WS_HN)), (const bf16_t*)(a.ws + WS_WIN) + (size_t)L * NZG * 1024, NTOK, NZG, 1024, 1024, 1024};
        pg8::StaticOrder S; S.init(NTOK, NZG, gridDim.x, bid);
        pg8::EpiZ E{(bf16_t*)(a.ws + WS_Z), (const float*)(a.ws + WS_CS), (float*)(a.ws + WS_LF), a.fgb + L * 5, (float*)(a.ws + WS_RQ), lds + 131072 + 1024};
        pg8::gemm_phase<pg8::EpiZ>(lds, pg8::Prob1{g, S}, E, wv);
        if (!side_first) side37(a, L, (const bf16_t*)(a.ws + (L == 0 ? WS_H : WS_HN)), lds, wv, bid);
    }
    SEAM(P + 0);
    if (PH_IN(P + 1) && EN(4)) {
        phase_stats(a, wv, bid);
        {
            pg8::Gemm g0{(const bf16_t*)(a.ws + WS_Z) + ZC_CQ, (const bf16_t*)(a.ws + WS_WUQ) + (size_t)L * 768 * 384, NTOK, 768, 384, NZ, 384};
            pg8::Gemm g1{(const bf16_t*)(a.ws + WS_Z) + ZC_CKV, (const bf16_t*)(a.ws + WS_WUKV) + (size_t)L * 768 * 384, NTOK, 768, 256, NZ, 384};
            pg8::StaticOrder S; S.init(NTOK, 768, gridDim.x, bid);
            pg8::EpiUp E{pg8::EpiQ{(bf16_t*)(a.ws + WS_QA), (const float*)(a.ws + WS_CS), (const float*)(a.ws + WS_RQ)}, pg8::EpiKV{(bf16_t*)(a.ws + WS_KVA), (const float*)(a.ws + WS_RQ)}};
            pg8::gemm_phase<pg8::EpiUp>(lds, pg8::Prob2{g0, g1, S}, E, wv);
        }
    }
    SEAM(P + 1);
    if (PH_IN(P + 2) && EN(5)) phase_attn(a, L, lds, wv, bid, 0);
#ifdef ATT2
    if (PH_IN(P + 2) && EN(5)) phase_attn(a, L, lds, wv, bid, 1);
#endif
    SEAM(P + 2);
    if (PH_IN(P + 3) && EN(6)) {
        pg8::Gemm g{(const bf16_t*)(a.ws + WS_H), (const bf16_t*)(a.ws + WS_WOUT) + (size_t)L * 1024 * 1024, NTOK, 1024, 1024, 1024, 1024};
        pg8::StaticOrder S; S.init(NTOK, 1024, gridDim.x, bid);
        unsigned* cnt = (unsigned*)(a.ws + WS_CTL) + 16384 + L * 8192;
        float* xbuf = (float*)(a.ws + WS_X) + (size_t)L * NTOK * 4;
        if (L == 0) {
            pg8::EpiOutN<false> E{a.x, a.out, mod + 2048, a.norm_g + 1024, mod + (size_t)16 * 3072, (bf16_t*)(a.ws + WS_HN), (float*)(a.ws + WS_RQ), xbuf, cnt, lds + 131072 + 1024};
            pg8::gemm_phase<pg8::EpiOutN<false>>(lds, pg8::Prob1{g, S}, E, wv);
        } else {
            pg8::EpiOutN<true> E{a.out, a.out, mod + (size_t)16 * 3072 + 2048, a.final_g, nullptr, nullptr, nullptr, xbuf, cnt, lds + 131072 + 1024};
            pg8::gemm_phase<pg8::EpiOutN<true>>(lds, pg8::Prob1{g, S}, E, wv);
        }
    }
    if (L == 0) SEAM(P + 3);
}

template <bool COOP>
__global__ void __launch_bounds__(512, 2) fwd(Args a) {
    extern __shared__ __attribute__((aligned(16))) unsigned char lds_raw[];
    LAS unsigned char* lds = (LAS unsigned char*)lds_raw;
    const int wv = __builtin_amdgcn_readfirstlane(threadIdx.x >> 6);
    const int bid = blockIdx.x, lo = a.ph_lo, hi = a.ph_hi;
    XcdBarrier xb; xb.bar = (unsigned*)(a.ws + WS_CTL) + 1024; xb.x = xb_xcc_id(); xb.st = (volatile LAS unsigned*)(lds + 131072 + 64);
    if constexpr (COOP) {
        if (threadIdx.x == 0) { xb.st[0] = 0u; xb.st[1] = 0u; (void)xb_add(&xb.bar[XB_XCNT(xb.x)], 1u); }
        __syncthreads();
    }
    if (PH_IN(0) && EN(0)) phase0(a, lds, wv, bid);
    SEAM(0);
    layer_phases<COOP, 0>(a, lds, wv, bid, lo, hi, xb);
    layer_phases<COOP, 1>(a, lds, wv, bid, lo, hi, xb);
}

extern "C" void kernel_launch(void* const* d_in, const int* in_sizes, int n_in, void* d_out, int out_size, void* d_ws, size_t ws_size, hipStream_t stream) {
    static int grid = 0;
    if (grid == 0) {
        if (n_in != 15 || in_sizes[0] != NTOK * DM || out_size != NTOK * DM || ws_size < WS_END) { fprintf(stderr, "kernel_launch: unexpected shapes (n_in %d, ws %zu)\n", n_in, ws_size); grid = -1; return; }
        int dev = 0, cus = 0, per_cu = 0;
        hipGetDevice(&dev); hipDeviceGetAttribute(&cus, hipDeviceAttributeMultiprocessorCount, dev);
        hipFuncSetAttribute((const void*)fwd<true>, hipFuncAttributeMaxDynamicSharedMemorySize, LDS_BYTES);
        hipFuncSetAttribute((const void*)fwd<false>, hipFuncAttributeMaxDynamicSharedMemorySize, LDS_BYTES);
        hipOccupancyMaxActiveBlocksPerMultiprocessor(&per_cu, (const void*)fwd<true>, 512, LDS_BYTES);
        (void)hipGetLastError();
        if (per_cu < 1) fprintf(stderr, "kernel_launch: occupancy query reports %d blocks per CU\n", per_cu);
        grid = cus > 256 ? 256 : cus;
        if (grid != 256) fprintf(stderr, "kernel_launch: %d CUs; this kernel is laid out for 256\n", cus);
    }
    if (grid < 0) return;
    Args a{};
    a.x = (const float*)d_in[0]; a.c = (const float*)d_in[1]; a.pos = (const int*)d_in[2]; a.w_ada = (const float*)d_in[3]; a.b_ada = (const float*)d_in[4];
    a.norm_g = (const float*)d_in[5]; a.w_in = (const float*)d_in[6]; a.qng = (const float*)d_in[7]; a.w_uq = (const float*)d_in[8]; a.kvng = (const float*)d_in[9];
    a.w_ukv = (const float*)d_in[10]; a.relb = (const float*)d_in[11]; a.fgb = (const float*)d_in[12]; a.w_out = (const float*)d_in[13]; a.final_g = (const float*)d_in[14];
    a.out = (float*)d_out; a.ws = (unsigned char*)d_ws;
    if (hipMemsetAsync((char*)d_ws + WS_CTL, 0, 196608, stream) != hipSuccess) { fprintf(stderr, "kernel_launch: memset failed\n"); return; }
#if ONE_LAUNCH
    a.ph_lo = 0; a.ph_hi = NPHASE;
    void* args[] = {&a};
    hipError_t e = hipLaunchCooperativeKernel((const void*)fwd<true>, dim3(grid), dim3(512), args, LDS_BYTES, stream);
    if (e != hipSuccess) fprintf(stderr, "cooperative launch failed: %s\n", hipGetErrorString(e));
#else
    for (int ph = 0; ph < NPHASE; ++ph) {
        a.ph_lo = ph; a.ph_hi = ph + 1;
        hipLaunchKernelGGL(fwd<false>, dim3(grid), dim3(512), LDS_BYTES, stream, a);
    }
#endif
}
```
